# Optimizing an MI355X kernel written in HIP

```python
import math, functools
import jax, jax.numpy as jnp
from jax import lax
import numpy as np

D_MODEL = 2048
BATCH = 4
SEQ = 4096
DEPTH = 2

GRID_W = 64
CTX_LEN = 256
HEAD_DIM = 128
MIX_WIDTH = D_MODEL
MIX_HEADS = MIX_WIDTH // HEAD_DIM
NA_HEADS = MIX_HEADS // 4
GQA_HEADS = MIX_HEADS // 2
GQA_KV_HEADS = GQA_HEADS // 4
GQA_GROUP = GQA_HEADS // GQA_KV_HEADS
DIFF_HEADS = MIX_HEADS // 4
DIFF_QK_DIM = HEAD_DIM // 2
NA_ROWS_MAX = 8
NA_COLS = 16
Q_BLOCK = 128
ROPE_THETA = 10000.0
D_FF = int(2.75 * D_MODEL)
N_EXPERTS = 8
TOP_K = 2
N_DENSE = (DEPTH + 1) // 2
N_MOE = DEPTH // 2
EPS = 1e-6
SPLIT_SIZES = (NA_HEADS * HEAD_DIM, NA_HEADS * HEAD_DIM, NA_HEADS * HEAD_DIM,
               GQA_HEADS * HEAD_DIM, GQA_KV_HEADS * HEAD_DIM, GQA_KV_HEADS * HEAD_DIM,
               DIFF_HEADS * 2 * DIFF_QK_DIM, DIFF_HEADS * 2 * DIFF_QK_DIM, DIFF_HEADS * HEAD_DIM)
IN_WIDTH = sum(SPLIT_SIZES)
SPLIT_POINTS = [int(i) for i in np.cumsum(SPLIT_SIZES)[:-1]]

kernel_name = "hybrid_dit_na_gqa_diff_moe"


def rms_norm(x, g):
    xf = x.astype(jnp.float32)
    y = xf * lax.rsqrt(jnp.mean(xf * xf, axis=-1, keepdims=True) + EPS)
    return (y * g.astype(jnp.float32)).astype(x.dtype)


def adaln(cvec, w, b):
    m = jax.nn.silu(cvec) @ w + b
    return jnp.split(m[..., None, :], 6, axis=-1)


def modulate(h, shift, scale):
    return h * (1.0 + scale) + shift


def rope_1d(x, pos):
    half = x.shape[-1] // 2
    inv_freq = ROPE_THETA ** (-jnp.arange(half, dtype=jnp.float32) / half)
    ang = pos.astype(jnp.float32)[:, None] * inv_freq
    ang = ang.reshape((1, pos.shape[0]) + (1,) * (x.ndim - 3) + (half,))
    cos, sin = jnp.cos(ang), jnp.sin(ang)
    xf = x.astype(jnp.float32)
    x1, x2 = xf[..., :half], xf[..., half:]
    return jnp.concatenate([x1 * cos - x2 * sin, x2 * cos + x1 * sin], axis=-1).astype(x.dtype)


def axial_rope(x, row_pos, col_pos):
    d2 = x.shape[-1] // 2
    return jnp.concatenate([rope_1d(x[..., :d2], row_pos), rope_1d(x[..., d2:], col_pos)], axis=-1)


def sweep_query_blocks(fn, q):
    bsz, lq = q.shape[:2]
    nb = lq // Q_BLOCK
    qb = jnp.moveaxis(q.reshape((bsz, nb, Q_BLOCK) + q.shape[2:]), 1, 0)
    ob = lax.map(fn, qb)
    return jnp.moveaxis(ob, 0, 1).reshape((bsz, lq) + ob.shape[3:])


def gqa_attend(q, k, v):
    s = jnp.einsum('bqkgd,bskd->bkgqs', q, k) * (q.shape[-1] ** -0.5)
    p = jax.nn.softmax(s.astype(jnp.float32), axis=-1).astype(v.dtype)
    return jnp.einsum('bkgqs,bskd->bqkgd', p, v)


def diff_attend(q, k, v, lam):
    s = jnp.einsum('bqhid,bshid->bhiqs', q, k) * (q.shape[-1] ** -0.5)
    p = jax.nn.softmax(s.astype(jnp.float32), axis=-1)
    a = (p[:, :, 0] - lam * p[:, :, 1]).astype(v.dtype)
    return jnp.einsum('bhqs,bshd->bqhd', a, v)


def neighbourhood_attention(q, k, v, k_ctx, v_ctx, rpb):
    bsz, L, H, d = q.shape
    rows = L // GRID_W
    win_r = min(NA_ROWS_MAX, rows)
    qg = q.reshape(bsz, rows, GRID_W, H, d)
    kg = k.reshape(bsz, rows, GRID_W, H, d)
    vg = v.reshape(bsz, rows, GRID_W, H, d)
    r = jnp.arange(rows)
    row_start = jnp.clip(r - win_r // 2, 0, rows - win_r)
    key_rows = row_start[:, None] + jnp.arange(win_r)[None, :]
    k_band = kg[:, key_rows]
    v_band = vg[:, key_rows]
    col = jnp.arange(GRID_W)
    col_start = jnp.clip(col - NA_COLS // 2, 0, GRID_W - NA_COLS)
    col_ok = (col[None, :] >= col_start[:, None]) & (col[None, :] < col_start[:, None] + NA_COLS)
    dr = key_rows - r[:, None]
    dc = jnp.clip(col[None, :] - col[:, None], -(NA_COLS - 1), NA_COLS - 1)
    bias = rpb[:, dr[:, None, :, None] + NA_ROWS_MAX - 1,
               dc[None, :, None, :] + NA_COLS - 1]
    scale = d ** -0.5
    s = jnp.einsum('brqhd,brkwhd->bhrqkw', qg, k_band).astype(jnp.float32) * scale + bias.astype(jnp.float32)
    s = jnp.where(col_ok[:, None, :], s, -jnp.inf)
    s = s.reshape(bsz, H, rows, GRID_W, win_r * GRID_W)
    s_ctx = jnp.einsum('brqhd,bchd->bhrqc', qg, k_ctx).astype(jnp.float32) * scale
    p = jax.nn.softmax(jnp.concatenate([s, s_ctx], axis=-1), axis=-1).astype(v.dtype)
    p_band = p[..., :win_r * GRID_W].reshape(bsz, H, rows, GRID_W, win_r, GRID_W)
    p_ctx = p[..., win_r * GRID_W:]
    out = (jnp.einsum('bhrqkw,brkwhd->brqhd', p_band, v_band)
           + jnp.einsum('bhrqc,bchd->brqhd', p_ctx, v_ctx))
    return out.reshape(bsz, L, H, d)


def split_heads(p):
    bsz, n = p.shape[:2]
    aq, ak, av, bq, bk, bv, cq, ck, cv = jnp.split(p, SPLIT_POINTS, axis=-1)
    return (aq.reshape(bsz, n, NA_HEADS, HEAD_DIM),
            ak.reshape(bsz, n, NA_HEADS, HEAD_DIM),
            av.reshape(bsz, n, NA_HEADS, HEAD_DIM),
            bq.reshape(bsz, n, GQA_KV_HEADS, GQA_GROUP, HEAD_DIM),
            bk.reshape(bsz, n, GQA_KV_HEADS, HEAD_DIM),
            bv.reshape(bsz, n, GQA_KV_HEADS, HEAD_DIM),
            cq.reshape(bsz, n, DIFF_HEADS, 2, DIFF_QK_DIM),
            ck.reshape(bsz, n, DIFF_HEADS, 2, DIFF_QK_DIM),
            cv.reshape(bsz, n, DIFF_HEADS, HEAD_DIM))


def hybrid_mixer(h, h_ctx, row_pos, col_pos, w_in, w_out, rpb, q_norm, k_norm,
                 lq1, lk1, lq2, lk2, subln, lambda_init, with_ctx_out):
    bsz, L, _ = h.shape
    cn = h_ctx.shape[1]
    aq, ak, av, bq, bk, bv, cq, ck, cv = split_heads(h @ w_in)
    aqc, akc, avc, bqc, bkc, bvc, cqc, ckc, cvc = split_heads(h_ctx @ w_in)
    bq = axial_rope(rms_norm(bq, q_norm), row_pos, col_pos)
    bk = axial_rope(rms_norm(bk, k_norm), row_pos, col_pos)
    bkc = rms_norm(bkc, k_norm)
    cq = axial_rope(cq, row_pos, col_pos)
    ck = axial_rope(ck, row_pos, col_pos)
    lam = (jnp.exp(jnp.sum(lq1.astype(jnp.float32) * lk1.astype(jnp.float32)))
           - jnp.exp(jnp.sum(lq2.astype(jnp.float32) * lk2.astype(jnp.float32))) + lambda_init)
    oa = neighbourhood_attention(aq, ak, av, akc, avc, rpb)
    kb_all = jnp.concatenate([bk, bkc], axis=1)
    vb_all = jnp.concatenate([bv, bvc], axis=1)
    ob = sweep_query_blocks(lambda qb: gqa_attend(qb, kb_all, vb_all), bq)
    kc_all = jnp.concatenate([ck, ckc], axis=1)
    vc_all = jnp.concatenate([cv, cvc], axis=1)
    oc = sweep_query_blocks(lambda qb: diff_attend(qb, kc_all, vc_all, lam), cq)
    oc = rms_norm(oc, subln) * (1.0 - lambda_init)
    out = jnp.concatenate([oa.reshape(bsz, L, -1), ob.reshape(bsz, L, -1), oc.reshape(bsz, L, -1)], axis=-1) @ w_out
    out_ctx = None
    if with_ctx_out:
        oac = gqa_attend(aqc[:, :, :, None, :], akc, avc)
        obc = gqa_attend(rms_norm(bqc, q_norm), bkc, bvc)
        occ = rms_norm(diff_attend(cqc, ckc, cvc, lam), subln) * (1.0 - lambda_init)
        out_ctx = jnp.concatenate([oac.reshape(bsz, cn, -1), obc.reshape(bsz, cn, -1), occ.reshape(bsz, cn, -1)], axis=-1) @ w_out
    return out, out_ctx


def swiglu(h, w1, w3, w2):
    return (jax.nn.silu(h @ w1) * (h @ w3)) @ w2


def moe_swiglu(h, router, w1, w3, w2):
    logits = (h @ router).astype(jnp.float32)
    top_v, top_i = lax.top_k(logits, TOP_K)
    top_g = jax.nn.softmax(top_v, axis=-1)
    gates = jnp.sum(jax.nn.one_hot(top_i, N_EXPERTS, dtype=jnp.float32) * top_g[..., None], axis=-2)
    out = jnp.zeros(h.shape[:-1] + (w2.shape[-1],), h.dtype)
    for e in range(N_EXPERTS):
        out = out + gates[..., e:e + 1].astype(h.dtype) * swiglu(h, w1[e], w3[e], w2[e])
    return out


def setup_inputs(seed: int = 0) -> dict:
    key = jax.random.key(seed)
    ks = jax.random.split(key, 32)

    def nrm(k, shape, scale):
        return scale * jax.random.normal(k, shape, jnp.float32)

    return {
        "x": nrm(ks[0], (BATCH, SEQ, D_MODEL), 1.0),
        "c": nrm(ks[1], (BATCH, D_MODEL), 1.0),
        "ctx": nrm(ks[2], (BATCH, CTX_LEN, D_MODEL), 1.0),
        "c_ctx": nrm(ks[3], (D_MODEL,), 1.0),
        "w_mod": nrm(ks[4], (DEPTH, D_MODEL, 6 * D_MODEL), 0.5 * D_MODEL ** -0.5),
        "b_mod": nrm(ks[5], (DEPTH, 6 * D_MODEL), 0.02),
        "g_mix_pre": 1.0 + nrm(ks[6], (DEPTH, D_MODEL), 0.1),
        "g_mix_post": 1.0 + nrm(ks[7], (DEPTH, D_MODEL), 0.1),
        "g_ffn_pre": 1.0 + nrm(ks[8], (DEPTH, D_MODEL), 0.1),
        "g_ffn_post": 1.0 + nrm(ks[9], (DEPTH, D_MODEL), 0.1),
        "w_in": nrm(ks[10], (DEPTH, D_MODEL, IN_WIDTH), D_MODEL ** -0.5),
        "w_out": nrm(ks[11], (DEPTH, MIX_WIDTH, D_MODEL), MIX_WIDTH ** -0.5),
        "na_rpb": nrm(ks[12], (DEPTH, NA_HEADS, 2 * NA_ROWS_MAX - 1, 2 * NA_COLS - 1), 0.5),
        "gqa_q_norm": 1.0 + nrm(ks[13], (DEPTH, HEAD_DIM), 0.1),
        "gqa_k_norm": 1.0 + nrm(ks[14], (DEPTH, HEAD_DIM), 0.1),
        "diff_lambda_q1": nrm(ks[15], (DEPTH, DIFF_QK_DIM), 0.1),
        "diff_lambda_k1": nrm(ks[16], (DEPTH, DIFF_QK_DIM), 0.1),
        "diff_lambda_q2": nrm(ks[17], (DEPTH, DIFF_QK_DIM), 0.1),
        "diff_lambda_k2": nrm(ks[18], (DEPTH, DIFF_QK_DIM), 0.1),
        "diff_subln": 1.0 + nrm(ks[19], (DEPTH, HEAD_DIM), 0.1),
        "ffn_w1": nrm(ks[20], (N_DENSE, D_MODEL, D_FF), D_MODEL ** -0.5),
        "ffn_w3": nrm(ks[21], (N_DENSE, D_MODEL, D_FF), D_MODEL ** -0.5),
        "ffn_w2": nrm(ks[22], (N_DENSE, D_FF, D_MODEL), D_FF ** -0.5),
        "moe_router": nrm(ks[23], (N_MOE, D_MODEL, N_EXPERTS), D_MODEL ** -0.5),
        "moe_w1": nrm(ks[24], (N_MOE, N_EXPERTS, D_MODEL, D_FF), D_MODEL ** -0.5),
        "moe_w3": nrm(ks[25], (N_MOE, N_EXPERTS, D_MODEL, D_FF), D_MODEL ** -0.5),
        "moe_w2": nrm(ks[26], (N_MOE, N_EXPERTS, D_FF, D_MODEL), D_FF ** -0.5),
    }


def reference(x, c, ctx, c_ctx, w_mod, b_mod, g_mix_pre, g_mix_post, g_ffn_pre, g_ffn_post,
              w_in, w_out, na_rpb, gqa_q_norm, gqa_k_norm, diff_lambda_q1, diff_lambda_k1,
              diff_lambda_q2, diff_lambda_k2, diff_subln, ffn_w1, ffn_w3, ffn_w2,
              moe_router, moe_w1, moe_w3, moe_w2):
    L = x.shape[1]
    pos = jnp.arange(L)
    row_pos = pos // GRID_W
    col_pos = pos % GRID_W
    x_ctx = ctx
    for l in range(DEPTH):
        last = l == DEPTH - 1
        lambda_init = 0.8 - 0.6 * math.exp(-0.3 * l)
        sh1, sc1, gt1, sh2, sc2, gt2 = adaln(c, w_mod[l], b_mod[l])
        csh1, csc1, cgt1, csh2, csc2, cgt2 = adaln(c_ctx, w_mod[l], b_mod[l])
        h = modulate(rms_norm(x, g_mix_pre[l]), sh1, sc1)
        h_ctx = modulate(rms_norm(x_ctx, g_mix_pre[l]), csh1, csc1)
        o, o_ctx = hybrid_mixer(h, h_ctx, row_pos, col_pos, w_in[l], w_out[l], na_rpb[l],
                                gqa_q_norm[l], gqa_k_norm[l], diff_lambda_q1[l], diff_lambda_k1[l],
                                diff_lambda_q2[l], diff_lambda_k2[l], diff_subln[l], lambda_init,
                                not last)
        x = x + gt1 * rms_norm(o, g_mix_post[l])
        if l % 2 == 0:
            ffn = functools.partial(swiglu, w1=ffn_w1[l // 2], w3=ffn_w3[l // 2], w2=ffn_w2[l // 2])
        else:
            ffn = functools.partial(moe_swiglu, router=moe_router[l // 2], w1=moe_w1[l // 2],
                                    w3=moe_w3[l // 2], w2=moe_w2[l // 2])
        h2 = modulate(rms_norm(x, g_ffn_pre[l]), sh2, sc2)
        x = x + gt2 * rms_norm(ffn(h2), g_ffn_post[l])
        if not last:
            x_ctx = x_ctx + cgt1 * rms_norm(o_ctx, g_mix_post[l])
            h2c = modulate(rms_norm(x_ctx, g_ffn_pre[l]), csh2, csc2)
            x_ctx = x_ctx + cgt2 * rms_norm(ffn(h2c), g_ffn_post[l])
    return x
```

```cpp
#include <hip/hip_runtime.h>
#include <stdint.h>
#include <stdio.h>

#define GAS __attribute__((address_space(1)))
#define LAS __attribute__((address_space(3)))
typedef unsigned short bf16_t;
typedef short bf16x8 __attribute__((ext_vector_type(8)));
typedef float f32x4 __attribute__((ext_vector_type(4)));
typedef float f32x2 __attribute__((ext_vector_type(2)));
typedef unsigned u32x4 __attribute__((ext_vector_type(4)));
typedef unsigned u32x2 __attribute__((ext_vector_type(2)));

constexpr int D = 2048, NB = 4, SEQ = 4096, CTX = 256, TPB = SEQ + CTX, NR = NB * TPB;
constexpr int INW = 4608, DFF = 5632, NE = 8, MODW = 6 * D, NTOK = NB * SEQ;
constexpr int MAXSLOT = 34816;
constexpr float EPS = 1e-6f;
constexpr int NWAVES = 8, NTHREADS = 512;
constexpr int LDS_BYTES = 147456;

constexpr size_t MiB = 1u << 20;
constexpr size_t WS_CTL = 0, CTL_ZERO_BYTES = 1 * MiB;
constexpr size_t WS_MOD = 1 * MiB;
constexpr size_t WS_TOPK = 2 * MiB;
constexpr size_t WS_SLOT = WS_TOPK + 512 * 1024;
constexpr size_t WS_IDX = WS_SLOT + 256 * 1024;
constexpr size_t WS_WIN = 4 * MiB;
constexpr size_t WS_WOUT = 40 * MiB;
constexpr size_t WS_W13 = 56 * MiB;
constexpr size_t WS_W2 = 100 * MiB;
constexpr size_t WS_MW13 = 122 * MiB;
constexpr size_t WS_MW2 = 474 * MiB;
constexpr size_t WS_X = 650 * MiB;
constexpr size_t WS_H = 786 * MiB;
constexpr size_t WS_Y = 854 * MiB;
constexpr size_t WS_R1 = 990 * MiB;
constexpr size_t WS_QKV = WS_R1, WS_VT = WS_R1 + 153 * MiB, WS_ATT = WS_R1 + 170 * MiB, WS_O = WS_R1 + 238 * MiB, WS_ACT = WS_R1;
constexpr size_t WS_END = WS_R1 + (size_t)MAXSLOT * DFF * 2;
static_assert((size_t)NR * INW * 2 <= 153 * MiB && (size_t)16 * 128 * TPB * 2 <= 17 * MiB && (size_t)NR * D * 2 <= 68 * MiB, "R1 map");
constexpr int CW_BAR = 4096;
constexpr int CW_CNT = 16384;
constexpr int CW_CUR = 16384 + 64;

__device__ __forceinline__ unsigned cvt_pk_bf16(float lo, float hi) { unsigned r; asm("v_cvt_pk_bf16_f32 %0, %1, %2" : "=v"(r) : "v"(lo), "v"(hi)); return r; }
__device__ __forceinline__ float bf_lo(unsigned w) { return __uint_as_float(w << 16); }
__device__ __forceinline__ float bf_hi(unsigned w) { return __uint_as_float(w & 0xffff0000u); }
__device__ __forceinline__ float bf2f(bf16_t b) { return __uint_as_float(((unsigned)b) << 16); }
__device__ __forceinline__ bf16_t f2bf(float f) { return (bf16_t)(cvt_pk_bf16(f, 0.f) & 0xffffu); }
__device__ __forceinline__ float wave_sum(float v) {
#pragma unroll
    for (int o = 1; o < 64; o <<= 1) v += __shfl_xor(v, o);
    return v;
}
__device__ __forceinline__ float wave_max(float v) {
#pragma unroll
    for (int o = 1; o < 64; o <<= 1) v = fmaxf(v, __shfl_xor(v, o));
    return v;
}
#define LDS_WAIT() asm volatile("s_waitcnt lgkmcnt(0)" ::: "memory")

#define XB_TMO      128
#define XB_XCNT(j)  (256  + 64 * (j))
#define XB_XSUB(j)  (1280 + 64 * (j))
#define XB_XGEN(j)  (2304 + 64 * (j))
#define XB_TOP      3328
#define XB_TOPGEN   3392
#define XCD_BAR_WORDS 3456
#define XB_SPIN_CAP (1u << 18)
__device__ __forceinline__ unsigned xb_ld(unsigned* p)              { return __hip_atomic_load(p, __ATOMIC_RELAXED, __HIP_MEMORY_SCOPE_AGENT); }
__device__ __forceinline__ unsigned xb_add(unsigned* p, unsigned v) { return __hip_atomic_fetch_add(p, v, __ATOMIC_RELAXED, __HIP_MEMORY_SCOPE_AGENT); }
__device__ __forceinline__ unsigned xb_xcc_id() { return (unsigned)__builtin_amdgcn_s_getreg((3 << 11) | 20) & 0xFu; }
#define XB_SPIN(cond, bar) do { unsigned _sp = 0; while (cond) { __builtin_amdgcn_s_sleep(1); \
    if ((++_sp & 255u) == 0u) { if (xb_ld(&(bar)[XB_TMO])) break; if (_sp > XB_SPIN_CAP) { atomicAdd(&(bar)[XB_TMO], 1u); break; } } } } while (0)
struct XcdBarrier { unsigned* bar; unsigned x; volatile LAS unsigned* st; };
__device__ __forceinline__ XcdBarrier xcd_barrier_post(unsigned* bar, volatile LAS unsigned* st) {
    XcdBarrier b; b.bar = bar; b.x = xb_xcc_id(); b.st = st;
    if (threadIdx.x == 0) (void)xb_add(&bar[XB_XCNT(b.x)], 1u);
    return b;
}
__device__ __forceinline__ void xcd_barrier_complete(unsigned* bar, unsigned x, unsigned& nloc, unsigned& nx) {
    const unsigned G = gridDim.x * gridDim.y * gridDim.z;
    unsigned sum, cnt, mine, sp = 0u;
    for (;;) {
        sum = 0u; cnt = 0u; mine = 0u;
#pragma unroll
        for (unsigned j = 0; j < 16; ++j) { const unsigned c = xb_ld(&bar[XB_XCNT(j)]); sum += c; cnt += (c > 0u) ? 1u : 0u; mine = (j == x) ? c : mine; }
        if (sum == G) break;
        __builtin_amdgcn_s_sleep(1);
        if ((++sp & 255u) == 0u) { if (xb_ld(&bar[XB_TMO])) break; if (sp > XB_SPIN_CAP) { atomicAdd(&bar[XB_TMO], 1u); break; } }
    }
    nloc = mine > 0u ? mine : 1u; nx = cnt > 0u ? cnt : 1u;
}
__device__ __forceinline__ void xcd_barrier(const XcdBarrier& b) {
    asm volatile("s_waitcnt vmcnt(0)" ::: "memory");
    __syncthreads();
    if (threadIdx.x == 0) {
        unsigned* bar = b.bar;
        __builtin_amdgcn_s_waitcnt(0);
        unsigned nloc = b.st[0], nx = b.st[1];
        if (nloc == 0u) { xcd_barrier_complete(bar, b.x, nloc, nx); b.st[0] = nloc; b.st[1] = nx; }
        const unsigned old = xb_add(&bar[XB_XSUB(b.x)], 1u);
        const unsigned gen = old / nloc;
        if (old + 1u == (gen + 1u) * nloc) {
            __builtin_amdgcn_fence(__ATOMIC_RELEASE, "agent");
            asm volatile("s_waitcnt vmcnt(0)" ::: "memory");
            const unsigned og = xb_add(&bar[XB_TOP], 1u);
            const unsigned tg = og / nx;
            if (og + 1u == (tg + 1u) * nx) xb_add(&bar[XB_TOPGEN], 1u);
            else XB_SPIN(xb_ld(&bar[XB_TOPGEN]) == tg, bar);
            __builtin_amdgcn_fence(__ATOMIC_ACQUIRE, "agent");
            xb_add(&bar[XB_XGEN(b.x)], 1u);
            asm volatile("s_waitcnt vmcnt(0)" ::: "memory");
        } else {
            XB_SPIN(xb_ld(&bar[XB_XGEN(b.x)]) == gen, bar);
            __builtin_amdgcn_fence(__ATOMIC_ACQUIRE, "agent");
            asm volatile("s_waitcnt vmcnt(0)" ::: "memory");
        }
    }
    __syncthreads();
}

struct Args { const float* in[27]; float* out; unsigned char* ws; int lo, hi; };
enum { I_X = 0, I_C, I_CTX, I_CCTX, I_WMOD, I_BMOD, I_GMIXPRE, I_GMIXPOST, I_GFFNPRE, I_GFFNPOST, I_WIN, I_WOUT, I_RPB, I_QNORM, I_KNORM,
       I_LQ1, I_LK1, I_LQ2, I_LK2, I_SUBLN, I_FW1, I_FW3, I_FW2, I_ROUTER, I_MW1, I_MW3, I_MW2 };

__device__ __forceinline__ void transpose_item(const float* W, int K, int N, bf16_t* WT, int item, int mode, LAS float* scr, int lane) {
    const int nblk = N / 32, kb = item / nblk, nb = item % nblk, k0 = 64 * kb, n0 = 32 * nb;
#pragma unroll 8
    for (int i = 0; i < 32; ++i) { const int kk = 2 * i + (lane >> 5); scr[kk * 33 + (lane & 31)] = W[(size_t)(k0 + kk) * N + n0 + (lane & 31)]; }
    LDS_WAIT(); asm volatile("" ::: "memory");
    const int c = lane & 7;
    const int drow0 = mode == 0 ? n0 : (256 * (n0 >> 7) + (n0 & 127) + (mode == 2 ? 128 : 0));
#pragma unroll
    for (int j = 0; j < 4; ++j) { const int n = (lane >> 3) + 8 * j; const LAS float* s = scr + (8 * c) * 33 + n;
        u32x4 o; o.x = cvt_pk_bf16(s[0 * 33], s[1 * 33]); o.y = cvt_pk_bf16(s[2 * 33], s[3 * 33]); o.z = cvt_pk_bf16(s[4 * 33], s[5 * 33]); o.w = cvt_pk_bf16(s[6 * 33], s[7 * 33]);
        *(u32x4*)(WT + (size_t)(drow0 + n) * K + k0 + 8 * c) = o; }
    LDS_WAIT(); asm volatile("" ::: "memory");
}
__device__ __forceinline__ void phase_convert(const Args& a, LAS unsigned char* lds, int gw, int ngw, int wave, int lane) {
    LAS float* scr = (LAS float*)(lds + wave * 16384);
    unsigned char* ws = a.ws;
    constexpr int I_IN = 32 * 144, I_OUT = 32 * 64, I_F = 5632;
    constexpr int NITEMS = 2 * I_IN + 2 * I_OUT + 27 * I_F;
    for (int it = gw; it < NITEMS; it += ngw) {
        int r = it;
        if (r < 2 * I_IN) { const int l = r / I_IN; transpose_item(a.in[I_WIN] + (size_t)l * D * INW, D, INW, (bf16_t*)(ws + WS_WIN) + (size_t)l * INW * D, r % I_IN, 0, scr, lane); continue; }
        r -= 2 * I_IN;
        if (r < 2 * I_OUT) { const int l = r / I_OUT; transpose_item(a.in[I_WOUT] + (size_t)l * D * D, D, D, (bf16_t*)(ws + WS_WOUT) + (size_t)l * D * D, r % I_OUT, 0, scr, lane); continue; }
        r -= 2 * I_OUT;
        const int m = r / I_F, q = r % I_F;
        if (m == 0) transpose_item(a.in[I_FW1], D, DFF, (bf16_t*)(ws + WS_W13), q, 1, scr, lane);
        else if (m == 1) transpose_item(a.in[I_FW3], D, DFF, (bf16_t*)(ws + WS_W13), q, 2, scr, lane);
        else if (m == 2) transpose_item(a.in[I_FW2], DFF, D, (bf16_t*)(ws + WS_W2), q, 0, scr, lane);
        else if (m < 11) { const int e = m - 3; transpose_item(a.in[I_MW1] + (size_t)e * D * DFF, D, DFF, (bf16_t*)(ws + WS_MW13) + (size_t)e * 2 * DFF * D, q, 1, scr, lane); }
        else if (m < 19) { const int e = m - 11; transpose_item(a.in[I_MW3] + (size_t)e * D * DFF, D, DFF, (bf16_t*)(ws + WS_MW13) + (size_t)e * 2 * DFF * D, q, 2, scr, lane); }
        else { const int e = m - 19; transpose_item(a.in[I_MW2] + (size_t)e * DFF * D, DFF, D, (bf16_t*)(ws + WS_MW2) + (size_t)e * D * DFF, q, 0, scr, lane); }
    }
}
__device__ __forceinline__ void phase_adaln(const Args& a, LAS unsigned char* lds, int tid, int wave, int lane) {
    LAS float* sc = (LAS float*)lds;
    LAS float* red = (LAS float*)(lds + 5 * 2048 * 4);
    float* MOD = (float*)(a.ws + WS_MOD);
    for (int task = blockIdx.x; task < 192; task += gridDim.x) {
        const int l = task / 96, j0 = (task % 96) * 128;
        for (int i = tid; i < 5 * 2048; i += NTHREADS) { const int v = i >> 11, k = i & 2047; const float c = v < 4 ? a.in[I_C][v * D + k] : a.in[I_CCTX][k]; sc[i] = c / (1.f + __expf(-c)); }
        __syncthreads();
        float acc[5][2];
#pragma unroll
        for (int v = 0; v < 5; ++v) { acc[v][0] = 0.f; acc[v][1] = 0.f; }
        const float* wp = a.in[I_WMOD] + ((size_t)l * D + wave * 256) * MODW + j0 + 2 * lane;
        for (int k = 0; k < 256; ++k) { const f32x2 w = *(const f32x2*)(wp + (size_t)k * MODW);
#pragma unroll
            for (int v = 0; v < 5; ++v) { const float s = sc[v * 2048 + wave * 256 + k]; acc[v][0] += s * w.x; acc[v][1] += s * w.y; } }
#pragma unroll
        for (int v = 0; v < 5; ++v) { red[(wave * 5 + v) * 128 + 2 * lane] = acc[v][0]; red[(wave * 5 + v) * 128 + 2 * lane + 1] = acc[v][1]; }
        __syncthreads();
        for (int i = tid; i < 640; i += NTHREADS) { const int v = i >> 7, j = i & 127; float s = a.in[I_BMOD][l * MODW + j0 + j];
#pragma unroll
            for (int w = 0; w < 8; ++w) s += red[(w * 5 + v) * 128 + j];
            MOD[(size_t)(l * 5 + v) * MODW + j0 + j] = s; }
        __syncthreads();
    }
}

__device__ __forceinline__ void ld_row_f32(const float* p, int lane, f32x4 (&v)[8]) {
#pragma unroll
    for (int j = 0; j < 8; ++j) v[j] = *(const f32x4*)(p + 4 * lane + 256 * j);
}
__device__ __forceinline__ void ld_row_bf16(const bf16_t* p, int lane, f32x4 (&v)[8]) {
#pragma unroll
    for (int j = 0; j < 8; ++j) { const u32x2 w = *(const u32x2*)(p + 4 * lane + 256 * j); v[j] = (f32x4){bf_lo(w.x), bf_hi(w.x), bf_lo(w.y), bf_hi(w.y)}; }
}
__device__ __forceinline__ void st_row_f32(float* p, int lane, const f32x4 (&v)[8]) {
#pragma unroll
    for (int j = 0; j < 8; ++j) *(f32x4*)(p + 4 * lane + 256 * j) = v[j];
}
__device__ __forceinline__ void st_row_bf16(bf16_t* p, int lane, const f32x4 (&v)[8]) {
#pragma unroll
    for (int j = 0; j < 8; ++j) { u32x2 w; w.x = cvt_pk_bf16(v[j].x, v[j].y); w.y = cvt_pk_bf16(v[j].z, v[j].w); *(u32x2*)(p + 4 * lane + 256 * j) = w; }
}
__device__ __forceinline__ float row_rstd(const f32x4 (&v)[8]) {
    float s = 0.f;
#pragma unroll
    for (int j = 0; j < 8; ++j) s += (v[j].x * v[j].x + v[j].y * v[j].y) + (v[j].z * v[j].z + v[j].w * v[j].w);
    return rsqrtf(wave_sum(s) * (1.f / D) + EPS);
}
__device__ __forceinline__ void norm_mod_store(const f32x4 (&x)[8], const float* g, const float* sh, const float* sc, bf16_t* hrow, int lane, f32x4 (&h)[8]) {
    const float r = row_rstd(x);
#pragma unroll
    for (int j = 0; j < 8; ++j) { const int c = 4 * lane + 256 * j; const f32x4 gv = *(const f32x4*)(g + c), sv = *(const f32x4*)(sc + c), hv = *(const f32x4*)(sh + c);
        h[j] = (x[j] * r * gv) * (sv + 1.f) + hv; }
    st_row_bf16(hrow, lane, h);
}
__device__ __forceinline__ void phase_row_entry(const Args& a, int gw, int ngw, int lane) {
    float* X = (float*)(a.ws + WS_X); bf16_t* H = (bf16_t*)(a.ws + WS_H); const float* MOD = (const float*)(a.ws + WS_MOD);
    for (int row = gw; row < NR; row += ngw) {
        const int b = row / TPB, t = row % TPB; const bool lat = t < SEQ; const int v = lat ? b : 4;
        const float* src = lat ? a.in[I_X] + ((size_t)b * SEQ + t) * D : a.in[I_CTX] + ((size_t)b * CTX + (t - SEQ)) * D;
        f32x4 x[8], h[8]; ld_row_f32(src, lane, x); st_row_f32(X + (size_t)row * D, lane, x);
        const float* mv = MOD + (size_t)(0 * 5 + v) * MODW;
        norm_mod_store(x, a.in[I_GMIXPRE], mv + 0 * D, mv + 1 * D, H + (size_t)row * D, lane, h);
    }
}
template <int L> __device__ __forceinline__ void phase_row_mid(const Args& a, LAS unsigned char* lds, int gw, int ngw, int tid, int lane) {
    float* X = (float*)(a.ws + WS_X); bf16_t* H = (bf16_t*)(a.ws + WS_H); const float* MOD = (const float*)(a.ws + WS_MOD); const bf16_t* O = (const bf16_t*)(a.ws + WS_O);
    LAS unsigned* lcnt = (LAS unsigned*)lds;
    if (L == 1) { if (tid < 8) lcnt[tid] = 0u; __syncthreads(); }
    for (int row = gw; row < NR; row += ngw) {
        const int b = row / TPB, t = row % TPB; const bool lat = t < SEQ; const int v = lat ? b : 4;
        if (L == 1 && !lat) continue;
        const float* mv = MOD + (size_t)(L * 5 + v) * MODW;
        f32x4 o[8], x[8], h[8]; ld_row_bf16(O + (size_t)row * D, lane, o); ld_row_f32(X + (size_t)row * D, lane, x);
        const float r1 = row_rstd(o);
#pragma unroll
        for (int j = 0; j < 8; ++j) { const int c = 4 * lane + 256 * j; const f32x4 gv = *(const f32x4*)(a.in[I_GMIXPOST] + L * D + c), gt = *(const f32x4*)(mv + 2 * D + c);
            x[j] = x[j] + gt * (o[j] * r1 * gv); }
        st_row_f32(X + (size_t)row * D, lane, x);
        norm_mod_store(x, a.in[I_GFFNPRE] + L * D, mv + 3 * D, mv + 4 * D, H + (size_t)row * D, lane, h);
        if (L == 1) {
            float lg[8];
#pragma unroll
            for (int e = 0; e < 8; ++e) lg[e] = 0.f;
#pragma unroll
            for (int j = 0; j < 8; ++j) { const float* rp = a.in[I_ROUTER] + (size_t)(4 * lane + 256 * j) * NE;
#pragma unroll
                for (int q = 0; q < 4; ++q) { const f32x4 r0 = *(const f32x4*)(rp + q * 8), r1v = *(const f32x4*)(rp + q * 8 + 4); const float hv = h[j][q];
                    lg[0] += hv * r0.x; lg[1] += hv * r0.y; lg[2] += hv * r0.z; lg[3] += hv * r0.w; lg[4] += hv * r1v.x; lg[5] += hv * r1v.y; lg[6] += hv * r1v.z; lg[7] += hv * r1v.w; } }
#pragma unroll
            for (int e = 0; e < 8; ++e) lg[e] = wave_sum(lg[e]);
            int i1 = 0; float v1 = lg[0];
#pragma unroll
            for (int e = 1; e < 8; ++e) if (lg[e] > v1) { v1 = lg[e]; i1 = e; }
            int i2 = -1; float v2 = -3.0e38f;
#pragma unroll
            for (int e = 0; e < 8; ++e) if (e != i1 && lg[e] > v2) { v2 = lg[e]; i2 = e; }
            const float e2 = __expf(v2 - v1), g1 = 1.f / (1.f + e2), g2 = e2 / (1.f + e2);
            if (lane == 0) { const int tok = b * SEQ + t; int* tk = (int*)(a.ws + WS_TOPK) + (size_t)tok * 4; tk[0] = i1; tk[1] = i2; ((float*)tk)[2] = g1; ((float*)tk)[3] = g2;
                atomicAdd((unsigned*)&lcnt[i1], 1u); atomicAdd((unsigned*)&lcnt[i2], 1u); }
        }
    }
    if (L == 1) { __syncthreads(); if (tid < 8) { const unsigned c = lcnt[tid]; if (c) __hip_atomic_fetch_add((unsigned*)(a.ws + WS_CTL) + CW_CNT + tid, c, __ATOMIC_RELAXED, __HIP_MEMORY_SCOPE_AGENT); } __syncthreads(); }
}
__device__ __forceinline__ void moe_offsets(const Args& a, LAS int* toff  , int tid) {
    if (tid == 0) { int acc = 0;
        for (int e = 0; e < 8; ++e) { toff[e] = acc; const unsigned c = __hip_atomic_load((unsigned*)(a.ws + WS_CTL) + CW_CNT + e, __ATOMIC_RELAXED, __HIP_MEMORY_SCOPE_AGENT); acc += (int)((c + 255u) >> 8); }
        toff[8] = acc; }
    __syncthreads();
}
__device__ __forceinline__ void phase_moe_slots(const Args& a, LAS unsigned char* lds, int gw, int tid, int lane) {
    LAS int* toff = (LAS int*)lds; moe_offsets(a, toff, tid);
    unsigned* ctl = (unsigned*)(a.ws + WS_CTL); int* IDX = (int*)(a.ws + WS_IDX); int* SLOT = (int*)(a.ws + WS_SLOT); const int* TOPK = (const int*)(a.ws + WS_TOPK);
    if (gw < NTOK / 64) {
        const int tok = gw * 64 + lane, b = tok / SEQ, t = tok % SEQ, row = b * TPB + t; const int e1 = TOPK[tok * 4], e2 = TOPK[tok * 4 + 1];
#pragma unroll
        for (int e = 0; e < 8; ++e) { const bool sel = (e1 == e) || (e2 == e); const unsigned long long m = __ballot(sel); const int n = __popcll(m);
            unsigned base = 0; if (lane == 0 && n) base = __hip_atomic_fetch_add(ctl + CW_CUR + e, (unsigned)n, __ATOMIC_RELAXED, __HIP_MEMORY_SCOPE_AGENT);
            base = __shfl(base, 0);
            if (sel) { const int slot = toff[e] * 256 + (int)base + __popcll(m & ((1ull << lane) - 1ull)); IDX[slot] = row; SLOT[tok * 2 + (e1 == e ? 0 : 1)] = slot; } }
    }
    if (blockIdx.x == gridDim.x - 1) {
        for (int e = 0; e < 8; ++e) { const int c = (int)__hip_atomic_load(ctl + CW_CNT + e, __ATOMIC_RELAXED, __HIP_MEMORY_SCOPE_AGENT); const int end = (toff[e + 1] - toff[e]) * 256;
            for (int i = c + tid; i < end; i += NTHREADS) IDX[toff[e] * 256 + i] = 0; }
    }
    __syncthreads();
}
template <int L> __device__ __forceinline__ void phase_row_end(const Args& a, int gw, int ngw, int lane) {
    float* X = (float*)(a.ws + WS_X); bf16_t* H = (bf16_t*)(a.ws + WS_H); const float* MOD = (const float*)(a.ws + WS_MOD); const bf16_t* Y = (const bf16_t*)(a.ws + WS_Y);
    for (int row = gw; row < NR; row += ngw) {
        const int b = row / TPB, t = row % TPB; const bool lat = t < SEQ; const int v = lat ? b : 4;
        if (L == 1 && !lat) continue;
        const float* mv = MOD + (size_t)(L * 5 + v) * MODW;
        f32x4 y[8], x[8], h[8];
        if (L == 0) ld_row_bf16(Y + (size_t)row * D, lane, y);
        else { const int tok = b * SEQ + t; const int* sl = (const int*)(a.ws + WS_SLOT) + tok * 2; const float* tk = (const float*)(a.ws + WS_TOPK) + (size_t)tok * 4; const float g1 = tk[2], g2 = tk[3];
            f32x4 y2[8]; ld_row_bf16(Y + (size_t)sl[0] * D, lane, y); ld_row_bf16(Y + (size_t)sl[1] * D, lane, y2);
#pragma unroll
            for (int j = 0; j < 8; ++j) y[j] = y[j] * g1 + y2[j] * g2; }
        ld_row_f32(X + (size_t)row * D, lane, x);
        const float r1 = row_rstd(y);
#pragma unroll
        for (int j = 0; j < 8; ++j) { const int c = 4 * lane + 256 * j; const f32x4 gv = *(const f32x4*)(a.in[I_GFFNPOST] + L * D + c), gt = *(const f32x4*)(mv + 5 * D + c);
            x[j] = x[j] + gt * (y[j] * r1 * gv); }
        if (L == 0) { st_row_f32(X + (size_t)row * D, lane, x); const float* mn = MOD + (size_t)(1 * 5 + v) * MODW;
            norm_mod_store(x, a.in[I_GMIXPRE] + D, mn + 0 * D, mn + 1 * D, H + (size_t)row * D, lane, h); }
        else st_row_f32(a.out + ((size_t)b * SEQ + t) * D, lane, x);
    }
}

template <int L> __device__ __forceinline__ void phase_qkpost(const Args& a, LAS unsigned char* lds, int gw, int ngw, int tid, int lane) {
    bf16_t* QKV = (bf16_t*)(a.ws + WS_QKV);
    const float L2T = 13.287712379549449f;
    const float fg = exp2f(-(float)(lane & 31) * (1.f / 32.f) * L2T), fd = exp2f(-(float)(lane & 15) * (1.f / 16.f) * L2T);
    const float qn0 = a.in[I_QNORM][L * 128 + lane], qn1 = a.in[I_QNORM][L * 128 + 64 + lane], kn0 = a.in[I_KNORM][L * 128 + lane], kn1 = a.in[I_KNORM][L * 128 + 64 + lane];
    for (int row = gw; row < NR; row += ngw) {
        const int t = row % TPB; const bool lat = t < SEQ; const int gr = t >> 6, gc = t & 63;
        bf16_t* q = QKV + (size_t)row * INW;
        float cr, sr, cc, sc2, cd, sd;
        sincosf((float)gr * fg, &sr, &cr); sincosf((float)gc * fg, &sc2, &cc); sincosf((float)(lane < 32 ? gr : gc) * fd, &sd, &cd);
#pragma unroll 2
        for (int hd = 0; hd < 10; ++hd) {
            const int base = hd < 8 ? 1536 + hd * 128 : 2560 + (hd - 8) * 128;
            float e0 = bf2f(q[base + lane]), e1 = bf2f(q[base + 64 + lane]);
            const float r = rsqrtf(wave_sum(e0 * e0 + e1 * e1) * (1.f / 128.f) + EPS);
            e0 = e0 * r * (hd < 8 ? qn0 : kn0); e1 = e1 * r * (hd < 8 ? qn1 : kn1);
            if (lat) { const float p0 = __shfl_xor(e0, 32), p1 = __shfl_xor(e1, 32);
                if (lane < 32) { e0 = e0 * cr - p0 * sr; e1 = e1 * cc - p1 * sc2; } else { e0 = e0 * cr + p0 * sr; e1 = e1 * cc + p1 * sc2; } }
            q[base + lane] = f2bf(e0); q[base + 64 + lane] = f2bf(e1);
        }
        if (lat) {
#pragma unroll 2
            for (int bl = 0; bl < 8; ++bl) {
                const int base = 3072 + bl * 128;
                float e0 = bf2f(q[base + lane]), e1 = bf2f(q[base + 64 + lane]);
                const float p0 = __shfl_xor(e0, 16), p1 = __shfl_xor(e1, 16);
                if ((lane & 16) == 0) { e0 = e0 * cd - p0 * sd; e1 = e1 * cd - p1 * sd; } else { e0 = e0 * cd + p0 * sd; e1 = e1 * cd + p1 * sd; }
                q[base + lane] = f2bf(e0); q[base + 64 + lane] = f2bf(e1);
            }
        }
    }
    bf16_t* VT = (bf16_t*)(a.ws + WS_VT); LAS bf16_t* tile = (LAS bf16_t*)lds;
    for (int task = blockIdx.x; task < NB * 4 * 68; task += gridDim.x) {
        const int tb = task % 68, h = (task / 68) % 4, b = task / 272, t0 = tb * 64;
        __syncthreads();
#pragma unroll
        for (int i = 0; i < 2; ++i) { const int pc = tid + i * 512, tk = pc >> 4, ch = pc & 15;
            const u32x4 w = *(const u32x4*)(QKV + (size_t)(b * TPB + t0 + tk) * INW + 1024 + h * 128 + ch * 8); *(LAS u32x4*)(tile + tk * 136 + ch * 8) = w; }
        __syncthreads();
        const int d = tid >> 2, tq = (tid & 3) * 16; unsigned w[8];
#pragma unroll
        for (int i = 0; i < 8; ++i) w[i] = (unsigned)tile[(tq + 2 * i) * 136 + d] | ((unsigned)tile[(tq + 2 * i + 1) * 136 + d] << 16);
        bf16_t* dst = VT + ((size_t)(b * 4 + h) * 128 + d) * TPB + t0 + tq;
        *(u32x4*)dst = (u32x4){w[0], w[1], w[2], w[3]}; *(u32x4*)(dst + 8) = (u32x4){w[4], w[5], w[6], w[7]};
    }
    __syncthreads();
}

template <int DQ> __device__ __forceinline__ void attn_wave(const bf16_t* QKV, const LAS float* qs, int kcol, int vcol, int nblk, int mode, int krow0, int b, int r, int c,
                                                               const float* rpb, float scale, int lane, float& o0, float& o1) {
    float m = -1e30f, l = 0.f, a0 = 0.f, a1 = 0.f;
    const int rs = min(max(r - 4, 0), 56), cs = min(max(c - 8, 0), 48);
    for (int blk = 0; blk < nblk; ++blk) {
        const int kidx = blk * 64 + lane; int krow; float bias = 0.f;
        if (mode == 0) krow = krow0 + kidx;
        else if (kidx < 128) { const int kr = rs + (kidx >> 4), kc = cs + (kidx & 15); krow = b * TPB + kr * 64 + kc; bias = rpb[(kr - r + 7) * 31 + (kc - c + 15)]; }
        else krow = b * TPB + SEQ + (kidx - 128);
        const bf16_t* kp = QKV + (size_t)krow * INW + kcol;
        float s = 0.f;
#pragma unroll
        for (int j = 0; j < DQ / 8; ++j) { const u32x4 kv = *(const u32x4*)(kp + 8 * j); const f32x4 q0 = *(const LAS f32x4*)(qs + 8 * j), q1 = *(const LAS f32x4*)(qs + 8 * j + 4);
            s += bf_lo(kv.x) * q0.x + bf_hi(kv.x) * q0.y + bf_lo(kv.y) * q0.z + bf_hi(kv.y) * q0.w + bf_lo(kv.z) * q1.x + bf_hi(kv.z) * q1.y + bf_lo(kv.w) * q1.z + bf_hi(kv.w) * q1.w; }
        s = s * scale + bias;
        const float mn = fmaxf(m, wave_max(s)), alpha = __expf(m - mn), p = __expf(s - mn);
        l = l * alpha + wave_sum(p); a0 *= alpha; a1 *= alpha; m = mn;
#pragma unroll 8
        for (int k = 0; k < 64; ++k) { const float pk = __shfl(p, k); const int rr = __shfl(krow, k);
            const unsigned vv = *(const unsigned*)(QKV + (size_t)rr * INW + vcol + 2 * lane); a0 += pk * bf_lo(vv); a1 += pk * bf_hi(vv); }
    }
    const float il = 1.f / l; o0 = a0 * il; o1 = a1 * il;
}
template <int L> __device__ __forceinline__ void phase_attn_naive(const Args& a, LAS unsigned char* lds, int gw, int ngw, int wave, int lane) {
    const bf16_t* QKV = (const bf16_t*)(a.ws + WS_QKV); bf16_t* ATT = (bf16_t*)(a.ws + WS_ATT);
    LAS float* qs = (LAS float*)(lds + wave * 512);
    const float lambda_init = L == 0 ? 0.2f : 0.8f - 0.6f * 0.74081822068171786607f;
    float lam;
    { const float d1 = wave_sum(a.in[I_LQ1][L * 64 + lane] * a.in[I_LK1][L * 64 + lane]), d2 = wave_sum(a.in[I_LQ2][L * 64 + lane] * a.in[I_LK2][L * 64 + lane]); lam = __expf(d1) - __expf(d2) + lambda_init; }
    const float sub0 = a.in[I_SUBLN][L * 128 + 2 * lane], sub1 = a.in[I_SUBLN][L * 128 + 2 * lane + 1];
    const int NLAT = NB * 16 * SEQ, NCTXT = (L == 0) ? NB * 16 * CTX : 0;
    for (int task = gw; task < NLAT + NCTXT; task += ngw) {
        int b, ht, t; bool lat = task < NLAT;
        if (lat) { t = task % SEQ; ht = (task / SEQ) % 16; b = task / (16 * SEQ); } else { const int u = task - NLAT; t = SEQ + u % CTX; ht = (u / CTX) % 16; b = u / (16 * CTX); }
        const int row = b * TPB + t, r = t >> 6, c = t & 63;
        const int nblk = lat ? 68 : 4, krow0 = lat ? b * TPB : b * TPB + SEQ;
        float o0, o1; int ocol;
        if (ht < 4) {
            const unsigned qv = *(const unsigned*)(QKV + (size_t)row * INW + ht * 128 + 2 * lane); qs[2 * lane] = bf_lo(qv); qs[2 * lane + 1] = bf_hi(qv); LDS_WAIT();
            attn_wave<128>(QKV, qs, 512 + ht * 128, 1024 + ht * 128, lat ? 6 : 4, lat ? 1 : 0, krow0, b, r, c, a.in[I_RPB] + (size_t)(L * 4 + ht) * 465, 0.08838834764831845f, lane, o0, o1);
            ocol = ht * 128;
        } else if (ht < 12) {
            const int hq = ht - 4, kvh = hq >> 2;
            const unsigned qv = *(const unsigned*)(QKV + (size_t)row * INW + 1536 + hq * 128 + 2 * lane); qs[2 * lane] = bf_lo(qv); qs[2 * lane + 1] = bf_hi(qv); LDS_WAIT();
            attn_wave<128>(QKV, qs, 2560 + kvh * 128, 2816 + kvh * 128, nblk, 0, krow0, b, r, c, nullptr, 0.08838834764831845f, lane, o0, o1);
            ocol = 512 + hq * 128;
        } else {
            const int h = ht - 12;
            const unsigned qv = *(const unsigned*)(QKV + (size_t)row * INW + 3072 + h * 128 + 2 * lane); qs[2 * lane] = bf_lo(qv); qs[2 * lane + 1] = bf_hi(qv); LDS_WAIT();
            float p0, p1, q0, q1;
            attn_wave<64>(QKV, qs, 3584 + h * 128, 4096 + h * 128, nblk, 0, krow0, b, r, c, nullptr, 0.125f, lane, p0, p1);
            attn_wave<64>(QKV, qs + 64, 3584 + h * 128 + 64, 4096 + h * 128, nblk, 0, krow0, b, r, c, nullptr, 0.125f, lane, q0, q1);
            o0 = p0 - lam * q0; o1 = p1 - lam * q1;
            const float rr = rsqrtf(wave_sum(o0 * o0 + o1 * o1) * (1.f / 128.f) + EPS) * (1.f - lambda_init);
            o0 = o0 * rr * sub0; o1 = o1 * rr * sub1;
            ocol = 1536 + h * 128;
        }
        *(unsigned*)(ATT + (size_t)row * D + ocol + 2 * lane) = cvt_pk_bf16(o0, o1);
        LDS_WAIT();
    }
}

template <bool SWIGLU, bool MOE> __device__ __forceinline__ void gemm_simple(const Args& a, LAS unsigned char* lds, const bf16_t* A, const int* aidx, const bf16_t* Bt, size_t bstride, bf16_t* C, int ldc,
                                                                            int nrt_static, int N, int K, int tid, int wave, int lane) {
    LAS int* toff = (LAS int*)lds;
    int nrt = nrt_static;
    if (MOE) { moe_offsets(a, toff, tid); nrt = toff[8]; }
    const int nct = N / 64, i16 = lane & 15, g4 = lane >> 4;
    for (int task = blockIdx.x; task < nrt * nct; task += gridDim.x) {
        const int rt = task / nct, ct = task % nct;
        const bf16_t* B = Bt;
        if (MOE) { int e = 0;
#pragma unroll
            for (int q = 1; q < 8; ++q) if (rt >= toff[q]) e = q;
            B += (size_t)e * bstride; }
        const int m0 = rt * 256 + wave * 32;
        const bf16_t* ap[2]; const bf16_t* bp[4]; int ccol[4];
#pragma unroll
        for (int mi = 0; mi < 2; ++mi) { int ar = m0 + 16 * mi + i16; if (aidx) ar = aidx[ar]; ap[mi] = A + (size_t)ar * K + 8 * g4; }
#pragma unroll
        for (int ni = 0; ni < 4; ++ni) { int br;
            if (SWIGLU) { const int pn = ct >> 2, q = ct & 3; br = 256 * pn + 32 * q + (ni & 1) * 16 + (ni >> 1) * 128 + i16; ccol[ni] = 128 * pn + 32 * q + (ni & 1) * 16 + i16; }
            else { br = 64 * ct + 16 * ni + i16; ccol[ni] = br; }
            bp[ni] = B + (size_t)br * K + 8 * g4; }
        f32x4 acc[2][4];
#pragma unroll
        for (int mi = 0; mi < 2; ++mi)
#pragma unroll
            for (int ni = 0; ni < 4; ++ni) acc[mi][ni] = (f32x4){0.f, 0.f, 0.f, 0.f};
#pragma unroll 2
        for (int k0 = 0; k0 < K; k0 += 32) {
            bf16x8 af[2], bfr[4];
#pragma unroll
            for (int mi = 0; mi < 2; ++mi) af[mi] = *(const bf16x8*)(ap[mi] + k0);
#pragma unroll
            for (int ni = 0; ni < 4; ++ni) bfr[ni] = *(const bf16x8*)(bp[ni] + k0);
#pragma unroll
            for (int mi = 0; mi < 2; ++mi)
#pragma unroll
                for (int ni = 0; ni < 4; ++ni) acc[mi][ni] = __builtin_amdgcn_mfma_f32_16x16x32_bf16(af[mi], bfr[ni], acc[mi][ni], 0, 0, 0);
        }
#pragma unroll
        for (int mi = 0; mi < 2; ++mi)
#pragma unroll
            for (int j = 0; j < 4; ++j) { const int row = m0 + 16 * mi + 4 * g4 + j; bf16_t* cr = C + (size_t)row * ldc;
                if (SWIGLU) {
#pragma unroll
                    for (int ni = 0; ni < 2; ++ni) { const float g = acc[mi][ni][j], u = acc[mi][ni + 2][j]; cr[ccol[ni]] = f2bf(g / (1.f + __expf(-g)) * u); }
                } else {
#pragma unroll
                    for (int ni = 0; ni < 4; ++ni) cr[ccol[ni]] = f2bf(acc[mi][ni][j]);
                } }
    }
    __syncthreads();
}

template <int L> __device__ __forceinline__ void layer_program(const Args& a, LAS unsigned char* lds, const XcdBarrier& bar, int lo, int hi, int gw, int ngw, int tid, int wave, int lane) {
    unsigned char* ws = a.ws; constexpr int P = 2 + 9 * L;
#define IN(k) (lo <= (k) && (k) < hi)
#define SEAM(k) do { if (IN(k) && IN((k) + 1)) xcd_barrier(bar); } while (0)
    if (IN(P + 0)) gemm_simple<false, false>(a, lds, (const bf16_t*)(ws + WS_H), nullptr, (const bf16_t*)(ws + WS_WIN) + (size_t)L * INW * D, 0, (bf16_t*)(ws + WS_QKV), INW, NR / 256, INW, D, tid, wave, lane);
    SEAM(P + 0);
    if (IN(P + 1)) phase_qkpost<L>(a, lds, gw, ngw, tid, lane);
    SEAM(P + 1);
    if (IN(P + 2)) phase_attn_naive<L>(a, lds, gw, ngw, wave, lane);
    SEAM(P + 2);
    if (IN(P + 3)) gemm_simple<false, false>(a, lds, (const bf16_t*)(ws + WS_ATT), nullptr, (const bf16_t*)(ws + WS_WOUT) + (size_t)L * D * D, 0, (bf16_t*)(ws + WS_O), D, NR / 256, D, D, tid, wave, lane);
    SEAM(P + 3);
    if (IN(P + 4)) phase_row_mid<L>(a, lds, gw, ngw, tid, lane);
    SEAM(P + 4);
    if (IN(P + 5)) { if (L == 1) phase_moe_slots(a, lds, gw, tid, lane); }
    if (L == 1) SEAM(P + 5);
    if (IN(P + 6)) {
        if (L == 0) gemm_simple<true, false>(a, lds, (const bf16_t*)(ws + WS_H), nullptr, (const bf16_t*)(ws + WS_W13), 0, (bf16_t*)(ws + WS_ACT), DFF, NR / 256, 2 * DFF, D, tid, wave, lane);
        else gemm_simple<true, true>(a, lds, (const bf16_t*)(ws + WS_H), (const int*)(ws + WS_IDX), (const bf16_t*)(ws + WS_MW13), (size_t)2 * DFF * D, (bf16_t*)(ws + WS_ACT), DFF, 0, 2 * DFF, D, tid, wave, lane);
    }
    SEAM(P + 6);
    if (IN(P + 7)) {
        if (L == 0) gemm_simple<false, false>(a, lds, (const bf16_t*)(ws + WS_ACT), nullptr, (const bf16_t*)(ws + WS_W2), 0, (bf16_t*)(ws + WS_Y), D, NR / 256, D, DFF, tid, wave, lane);
        else gemm_simple<false, true>(a, lds, (const bf16_t*)(ws + WS_ACT), nullptr, (const bf16_t*)(ws + WS_MW2), (size_t)D * DFF, (bf16_t*)(ws + WS_Y), D, 0, D, DFF, tid, wave, lane);
    }
    SEAM(P + 7);
    if (IN(P + 8)) phase_row_end<L>(a, gw, ngw, lane);
    if (L == 0) SEAM(P + 8);
#undef IN
#undef SEAM
}
constexpr int NPHASE = 20;

__global__ void __launch_bounds__(NTHREADS, 2) fwd_kernel(Args a) {
    extern __shared__ __attribute__((aligned(16))) unsigned char lds_raw[];
    LAS unsigned char* lds = (LAS unsigned char*)lds_raw;
    const int tid = threadIdx.x, lane = tid & 63, wave = __builtin_amdgcn_readfirstlane(tid >> 6);
    const int gw = blockIdx.x * NWAVES + wave, ngw = gridDim.x * NWAVES;
    volatile LAS unsigned* xbw = (volatile LAS unsigned*)(lds + LDS_BYTES - 16);
    if (tid < 4) xbw[tid] = 0u;
    __syncthreads();
    const int lo = a.lo, hi = a.hi;
    XcdBarrier bar; bar.bar = (unsigned*)(a.ws + WS_CTL) + CW_BAR; bar.x = 0; bar.st = xbw;
    if (hi - lo > 1) bar = xcd_barrier_post((unsigned*)(a.ws + WS_CTL) + CW_BAR, xbw);
#define IN(k) (lo <= (k) && (k) < hi)
    if (IN(0)) { phase_adaln(a, lds, tid, wave, lane); phase_convert(a, lds, gw, ngw, wave, lane); }
    if (IN(0) && IN(1)) xcd_barrier(bar);
    if (IN(1)) phase_row_entry(a, gw, ngw, lane);
    if (IN(1) && IN(2)) xcd_barrier(bar);
#undef IN
    layer_program<0>(a, lds, bar, lo, hi, gw, ngw, tid, wave, lane);
    layer_program<1>(a, lds, bar, lo, hi, gw, ngw, tid, wave, lane);
}

#ifndef MK_PER_PHASE
#define MK_PER_PHASE 1
#endif
extern "C" void kernel_launch(void* const* d_in, const int* in_sizes, int n_in, void* d_out, int out_size, void* d_ws, size_t ws_size, hipStream_t stream) {
    static int grid = 0;
    if (grid == 0) {
        if (n_in != 27 || out_size != NB * SEQ * D || ws_size < WS_END) { fprintf(stderr, "kernel_launch: unexpected shapes: n_in %d out %d ws %zu (need %zu)\n", n_in, out_size, ws_size, (size_t)WS_END); grid = -1; return; }
        int dev = 0, cus = 0, per_cu = 0;
        if (hipGetDevice(&dev) != hipSuccess || hipDeviceGetAttribute(&cus, hipDeviceAttributeMultiprocessorCount, dev) != hipSuccess) { grid = -1; return; }
        if (hipFuncSetAttribute((const void*)fwd_kernel, hipFuncAttributeMaxDynamicSharedMemorySize, LDS_BYTES) != hipSuccess) { fprintf(stderr, "kernel_launch: hipFuncSetAttribute failed\n"); grid = -1; return; }
        if (hipOccupancyMaxActiveBlocksPerMultiprocessor(&per_cu, (const void*)fwd_kernel, NTHREADS, LDS_BYTES) != hipSuccess || per_cu < 1) fprintf(stderr, "kernel_launch: occupancy query says %d\n", per_cu);
        (void)hipGetLastError();
        grid = cus;
    }
    if (grid < 0) return;
    (void)hipMemsetAsync((char*)d_ws + WS_CTL, 0, CTL_ZERO_BYTES, stream);
    Args a{};
    for (int i = 0; i < 27; ++i) a.in[i] = (const float*)d_in[i];
    a.out = (float*)d_out; a.ws = (unsigned char*)d_ws;
#if MK_PER_PHASE
    for (int p = 0; p < NPHASE; ++p) { if (p == 7) continue; a.lo = p; a.hi = p + 1; hipLaunchKernelGGL(fwd_kernel, dim3(grid), dim3(NTHREADS), LDS_BYTES, stream, a); }
#else
    a.lo = 0; a.hi = NPHASE; hipLaunchKernelGGL(fwd_kernel, dim3(grid), dim3(NTHREADS), LDS_BYTES, stream, a);
#endif
}
```

```cpp
#include <hip/hip_runtime.h>
#include <stdint.h>
#include <stdio.h>

#define GAS __attribute__((address_space(1)))
#define LAS __attribute__((address_space(3)))
typedef unsigned short bf16_t;
typedef short bf16x8 __attribute__((ext_vector_type(8)));
typedef float f32x4 __attribute__((ext_vector_type(4)));
typedef float f32x2 __attribute__((ext_vector_type(2)));
typedef unsigned u32x4 __attribute__((ext_vector_type(4)));
typedef unsigned u32x2 __attribute__((ext_vector_type(2)));

constexpr int D = 2048, NB = 4, SEQ = 4096, CTX = 256, TPB = SEQ + CTX, NR = NB * TPB;
constexpr int INW = 4608, DFF = 5632, NE = 8, MODW = 6 * D, NTOK = NB * SEQ;
constexpr int MAXSLOT = 34816;
constexpr float EPS = 1e-6f;
constexpr int NWAVES = 8, NTHREADS = 512;
constexpr int LDS_BYTES = 147456;

constexpr size_t MiB = 1u << 20;
constexpr size_t WS_CTL = 0, CTL_ZERO_BYTES = 1 * MiB;
constexpr size_t WS_MOD = 1 * MiB;
constexpr size_t WS_TOPK = 2 * MiB;
constexpr size_t WS_SLOT = WS_TOPK + 512 * 1024;
constexpr size_t WS_WIN = 4 * MiB;
constexpr size_t WS_WOUT = 40 * MiB;
constexpr size_t WS_W13 = 56 * MiB;
constexpr size_t WS_W2 = 100 * MiB;
constexpr size_t WS_MW13 = 122 * MiB;
constexpr size_t WS_MW2 = 474 * MiB;
constexpr size_t WS_X = 650 * MiB;
constexpr size_t WS_H = 786 * MiB;
constexpr size_t WS_Y = 854 * MiB;
constexpr size_t WS_HG = WS_Y;
constexpr size_t WS_R1 = 990 * MiB;
constexpr size_t WS_QKV = WS_R1, WS_VT = WS_R1 + 153 * MiB, WS_ATT = WS_R1 + 170 * MiB, WS_O = WS_R1 + 238 * MiB, WS_ACT = WS_R1;
constexpr size_t WS_END = WS_R1 + (size_t)MAXSLOT * DFF * 2;
static_assert((size_t)NR * INW * 2 <= 153 * MiB && (size_t)16 * 128 * TPB * 2 <= 17 * MiB && (size_t)NR * D * 2 <= 68 * MiB, "R1 map");
constexpr int CW_BAR = 4096;
constexpr int CW_CNT = 16384;
constexpr int CW_CUR = 16384 + 64;

__device__ __forceinline__ unsigned cvt_pk_bf16(float lo, float hi) { unsigned r; asm("v_cvt_pk_bf16_f32 %0, %1, %2" : "=v"(r) : "v"(lo), "v"(hi)); return r; }
__device__ __forceinline__ float bf_lo(unsigned w) { return __uint_as_float(w << 16); }
__device__ __forceinline__ float bf_hi(unsigned w) { return __uint_as_float(w & 0xffff0000u); }
__device__ __forceinline__ float bf2f(bf16_t b) { return __uint_as_float(((unsigned)b) << 16); }
__device__ __forceinline__ bf16_t f2bf(float f) { return (bf16_t)(cvt_pk_bf16(f, 0.f) & 0xffffu); }
__device__ __forceinline__ float wave_sum(float v) {
#pragma unroll
    for (int o = 1; o < 64; o <<= 1) v += __shfl_xor(v, o);
    return v;
}
__device__ __forceinline__ float wave_max(float v) {
#pragma unroll
    for (int o = 1; o < 64; o <<= 1) v = fmaxf(v, __shfl_xor(v, o));
    return v;
}
#define LDS_WAIT() asm volatile("s_waitcnt lgkmcnt(0)" ::: "memory")

#define XB_TMO      128
#define XB_XCNT(j)  (256  + 64 * (j))
#define XB_XSUB(j)  (1280 + 64 * (j))
#define XB_XGEN(j)  (2304 + 64 * (j))
#define XB_TOP      3328
#define XB_TOPGEN   3392
#define XCD_BAR_WORDS 3456
#define XB_SPIN_CAP (1u << 18)
__device__ __forceinline__ unsigned xb_ld(unsigned* p)              { return __hip_atomic_load(p, __ATOMIC_RELAXED, __HIP_MEMORY_SCOPE_AGENT); }
__device__ __forceinline__ unsigned xb_add(unsigned* p, unsigned v) { return __hip_atomic_fetch_add(p, v, __ATOMIC_RELAXED, __HIP_MEMORY_SCOPE_AGENT); }
__device__ __forceinline__ unsigned xb_xcc_id() { return (unsigned)__builtin_amdgcn_s_getreg((3 << 11) | 20) & 0xFu; }
#define XB_SPIN(cond, bar) do { unsigned _sp = 0; while (cond) { __builtin_amdgcn_s_sleep(1); \
    if ((++_sp & 255u) == 0u) { if (xb_ld(&(bar)[XB_TMO])) break; if (_sp > XB_SPIN_CAP) { atomicAdd(&(bar)[XB_TMO], 1u); break; } } } } while (0)
struct XcdBarrier { unsigned* bar; unsigned x; volatile LAS unsigned* st; };
__device__ __forceinline__ XcdBarrier xcd_barrier_post(unsigned* bar, volatile LAS unsigned* st) {
    XcdBarrier b; b.bar = bar; b.x = xb_xcc_id(); b.st = st;
    if (threadIdx.x == 0) (void)xb_add(&bar[XB_XCNT(b.x)], 1u);
    return b;
}
__device__ __forceinline__ void xcd_barrier_complete(unsigned* bar, unsigned x, unsigned& nloc, unsigned& nx) {
    const unsigned G = gridDim.x * gridDim.y * gridDim.z;
    unsigned sum, cnt, mine, sp = 0u;
    for (;;) {
        sum = 0u; cnt = 0u; mine = 0u;
#pragma unroll
        for (unsigned j = 0; j < 16; ++j) { const unsigned c = xb_ld(&bar[XB_XCNT(j)]); sum += c; cnt += (c > 0u) ? 1u : 0u; mine = (j == x) ? c : mine; }
        if (sum == G) break;
        __builtin_amdgcn_s_sleep(1);
        if ((++sp & 255u) == 0u) { if (xb_ld(&bar[XB_TMO])) break; if (sp > XB_SPIN_CAP) { atomicAdd(&bar[XB_TMO], 1u); break; } }
    }
    nloc = mine > 0u ? mine : 1u; nx = cnt > 0u ? cnt : 1u;
}
__device__ __forceinline__ void xcd_barrier(const XcdBarrier& b) {
    asm volatile("s_waitcnt vmcnt(0)" ::: "memory");
    __syncthreads();
    if (threadIdx.x == 0) {
        unsigned* bar = b.bar;
        __builtin_amdgcn_s_waitcnt(0);
        unsigned nloc = b.st[0], nx = b.st[1];
        if (nloc == 0u) { xcd_barrier_complete(bar, b.x, nloc, nx); b.st[0] = nloc; b.st[1] = nx; }
        const unsigned old = xb_add(&bar[XB_XSUB(b.x)], 1u);
        const unsigned gen = old / nloc;
        if (old + 1u == (gen + 1u) * nloc) {
            __builtin_amdgcn_fence(__ATOMIC_RELEASE, "agent");
            asm volatile("s_waitcnt vmcnt(0)" ::: "memory");
            const unsigned og = xb_add(&bar[XB_TOP], 1u);
            const unsigned tg = og / nx;
            if (og + 1u == (tg + 1u) * nx) xb_add(&bar[XB_TOPGEN], 1u);
            else XB_SPIN(xb_ld(&bar[XB_TOPGEN]) == tg, bar);
            __builtin_amdgcn_fence(__ATOMIC_ACQUIRE, "agent");
            xb_add(&bar[XB_XGEN(b.x)], 1u);
            asm volatile("s_waitcnt vmcnt(0)" ::: "memory");
        } else {
            XB_SPIN(xb_ld(&bar[XB_XGEN(b.x)]) == gen, bar);
            __builtin_amdgcn_fence(__ATOMIC_ACQUIRE, "agent");
            asm volatile("s_waitcnt vmcnt(0)" ::: "memory");
        }
    }
    __syncthreads();
}

struct Args { const float* in[27]; float* out; unsigned char* ws; int lo, hi; };
typedef const __attribute__((address_space(4))) Args* ArgsP;
__device__ __forceinline__ ArgsP get_args() { ArgsP p = (ArgsP)__builtin_amdgcn_kernarg_segment_ptr(); asm volatile("" : "+s"(p)); return p; }
enum { I_X = 0, I_C, I_CTX, I_CCTX, I_WMOD, I_BMOD, I_GMIXPRE, I_GMIXPOST, I_GFFNPRE, I_GFFNPOST, I_WIN, I_WOUT, I_RPB, I_QNORM, I_KNORM,
       I_LQ1, I_LK1, I_LQ2, I_LK2, I_SUBLN, I_FW1, I_FW3, I_FW2, I_ROUTER, I_MW1, I_MW3, I_MW2 };

__device__ __forceinline__ void transpose_item(const float* W, int K, int N, bf16_t* WT, int item, int mode, LAS float* scr, int lane) {
    const int nblk = N / 32, kb = item / nblk, nb = item % nblk, k0 = 64 * kb, n0 = 32 * nb;
#pragma unroll 8
    for (int i = 0; i < 32; ++i) { const int kk = 2 * i + (lane >> 5); scr[kk * 33 + (lane & 31)] = W[(size_t)(k0 + kk) * N + n0 + (lane & 31)]; }
    LDS_WAIT(); asm volatile("" ::: "memory");
    const int c = lane & 7;
    const int drow0 = mode == 0 ? n0 : (256 * (n0 >> 7) + (n0 & 127) + (mode == 2 ? 128 : 0));
#pragma unroll
    for (int j = 0; j < 4; ++j) { const int n = (lane >> 3) + 8 * j; const LAS float* s = scr + (8 * c) * 33 + n;
        u32x4 o; o.x = cvt_pk_bf16(s[0 * 33], s[1 * 33]); o.y = cvt_pk_bf16(s[2 * 33], s[3 * 33]); o.z = cvt_pk_bf16(s[4 * 33], s[5 * 33]); o.w = cvt_pk_bf16(s[6 * 33], s[7 * 33]);
        *(u32x4*)(WT + (size_t)(drow0 + n) * K + k0 + 8 * c) = o; }
    LDS_WAIT(); asm volatile("" ::: "memory");
}
__device__ __forceinline__ void phase_convert(ArgsP a, LAS unsigned char* lds, int gw, int ngw, int wave, int lane) {
    LAS float* scr = (LAS float*)(lds + wave * 16384);
    unsigned char* ws = a->ws;
    constexpr int I_IN = 32 * 144, I_OUT = 32 * 64, I_F = 5632;
    constexpr int NITEMS = 2 * I_IN + 2 * I_OUT + 27 * I_F;
    for (int it = gw; it < NITEMS; it += ngw) {
        int r = it;
        if (r < 2 * I_IN) { const int l = r / I_IN; transpose_item(a->in[I_WIN] + (size_t)l * D * INW, D, INW, (bf16_t*)(ws + WS_WIN) + (size_t)l * INW * D, r % I_IN, 0, scr, lane); continue; }
        r -= 2 * I_IN;
        if (r < 2 * I_OUT) { const int l = r / I_OUT; transpose_item(a->in[I_WOUT] + (size_t)l * D * D, D, D, (bf16_t*)(ws + WS_WOUT) + (size_t)l * D * D, r % I_OUT, 0, scr, lane); continue; }
        r -= 2 * I_OUT;
        const int m = r / I_F, q = r % I_F;
        if (m == 0) transpose_item(a->in[I_FW1], D, DFF, (bf16_t*)(ws + WS_W13), q, 1, scr, lane);
        else if (m == 1) transpose_item(a->in[I_FW3], D, DFF, (bf16_t*)(ws + WS_W13), q, 2, scr, lane);
        else if (m == 2) transpose_item(a->in[I_FW2], DFF, D, (bf16_t*)(ws + WS_W2), q, 0, scr, lane);
        else if (m < 11) { const int e = m - 3; transpose_item(a->in[I_MW1] + (size_t)e * D * DFF, D, DFF, (bf16_t*)(ws + WS_MW13) + (size_t)e * 2 * DFF * D, q, 1, scr, lane); }
        else if (m < 19) { const int e = m - 11; transpose_item(a->in[I_MW3] + (size_t)e * D * DFF, D, DFF, (bf16_t*)(ws + WS_MW13) + (size_t)e * 2 * DFF * D, q, 2, scr, lane); }
        else { const int e = m - 19; transpose_item(a->in[I_MW2] + (size_t)e * DFF * D, DFF, D, (bf16_t*)(ws + WS_MW2) + (size_t)e * D * DFF, q, 0, scr, lane); }
    }
}
__device__ __forceinline__ void phase_adaln(ArgsP a, LAS unsigned char* lds, int tid, int wave, int lane) {
    LAS float* sc = (LAS float*)lds;
    LAS float* red = (LAS float*)(lds + 5 * 2048 * 4);
    float* MOD = (float*)(a->ws + WS_MOD);
    for (int task = blockIdx.x; task < 192; task += gridDim.x) {
        const int l = task / 96, j0 = (task % 96) * 128;
        for (int i = tid; i < 5 * 2048; i += NTHREADS) { const int v = i >> 11, k = i & 2047; const float c = v < 4 ? a->in[I_C][v * D + k] : a->in[I_CCTX][k]; sc[i] = c / (1.f + __expf(-c)); }
        __syncthreads();
        float acc[5][2];
#pragma unroll
        for (int v = 0; v < 5; ++v) { acc[v][0] = 0.f; acc[v][1] = 0.f; }
        const float* wp = a->in[I_WMOD] + ((size_t)l * D + wave * 256) * MODW + j0 + 2 * lane;
        for (int k = 0; k < 256; ++k) { const f32x2 w = *(const f32x2*)(wp + (size_t)k * MODW);
#pragma unroll
            for (int v = 0; v < 5; ++v) { const float s = sc[v * 2048 + wave * 256 + k]; acc[v][0] += s * w.x; acc[v][1] += s * w.y; } }
#pragma unroll
        for (int v = 0; v < 5; ++v) { red[(wave * 5 + v) * 128 + 2 * lane] = acc[v][0]; red[(wave * 5 + v) * 128 + 2 * lane + 1] = acc[v][1]; }
        __syncthreads();
        for (int i = tid; i < 640; i += NTHREADS) { const int v = i >> 7, j = i & 127; float s = a->in[I_BMOD][l * MODW + j0 + j];
#pragma unroll
            for (int w = 0; w < 8; ++w) s += red[(w * 5 + v) * 128 + j];
            MOD[(size_t)(l * 5 + v) * MODW + j0 + j] = s; }
        __syncthreads();
    }
}

__device__ __forceinline__ void ld_row_f32(const float* p, int lane, f32x4 (&v)[8]) {
#pragma unroll
    for (int j = 0; j < 8; ++j) v[j] = *(const f32x4*)(p + 4 * lane + 256 * j);
}
__device__ __forceinline__ void ld_row_bf16(const bf16_t* p, int lane, f32x4 (&v)[8]) {
#pragma unroll
    for (int j = 0; j < 8; ++j) { const u32x2 w = *(const u32x2*)(p + 4 * lane + 256 * j); v[j] = (f32x4){bf_lo(w.x), bf_hi(w.x), bf_lo(w.y), bf_hi(w.y)}; }
}
__device__ __forceinline__ void st_row_f32(float* p, int lane, const f32x4 (&v)[8]) {
#pragma unroll
    for (int j = 0; j < 8; ++j) *(f32x4*)(p + 4 * lane + 256 * j) = v[j];
}
__device__ __forceinline__ void st_row_bf16(bf16_t* p, int lane, const f32x4 (&v)[8]) {
#pragma unroll
    for (int j = 0; j < 8; ++j) { u32x2 w; w.x = cvt_pk_bf16(v[j].x, v[j].y); w.y = cvt_pk_bf16(v[j].z, v[j].w); *(u32x2*)(p + 4 * lane + 256 * j) = w; }
}
__device__ __forceinline__ float row_rstd(const f32x4 (&v)[8]) {
    float s = 0.f;
#pragma unroll
    for (int j = 0; j < 8; ++j) s += (v[j].x * v[j].x + v[j].y * v[j].y) + (v[j].z * v[j].z + v[j].w * v[j].w);
    return rsqrtf(wave_sum(s) * (1.f / D) + EPS);
}
__device__ __forceinline__ void norm_mod_store(const f32x4 (&x)[8], const float* g, const float* sh, const float* sc, bf16_t* hrow, int lane, f32x4 (&h)[8]) {
    const float r = row_rstd(x);
#pragma unroll
    for (int j = 0; j < 8; ++j) { const int c = 4 * lane + 256 * j; const f32x4 gv = *(const f32x4*)(g + c), sv = *(const f32x4*)(sc + c), hv = *(const f32x4*)(sh + c);
        h[j] = (x[j] * r * gv) * (sv + 1.f) + hv; }
    st_row_bf16(hrow, lane, h);
}
__device__ __forceinline__ void phase_row_entry(ArgsP a, int gw, int ngw, int lane) {
    float* X = (float*)(a->ws + WS_X); bf16_t* H = (bf16_t*)(a->ws + WS_H); const float* MOD = (const float*)(a->ws + WS_MOD);
    for (int row = gw; row < NR; row += ngw) {
        const int b = row / TPB, t = row % TPB; const bool lat = t < SEQ; const int v = lat ? b : 4;
        const float* src = lat ? a->in[I_X] + ((size_t)b * SEQ + t) * D : a->in[I_CTX] + ((size_t)b * CTX + (t - SEQ)) * D;
        f32x4 x[8], h[8]; ld_row_f32(src, lane, x); st_row_f32(X + (size_t)row * D, lane, x);
        const float* mv = MOD + (size_t)(0 * 5 + v) * MODW;
        norm_mod_store(x, a->in[I_GMIXPRE], mv + 0 * D, mv + 1 * D, H + (size_t)row * D, lane, h);
    }
}
template <int L> __device__ __forceinline__ void phase_row_mid(ArgsP a, LAS unsigned char* lds, int gw, int ngw, int tid, int lane) {
    float* X = (float*)(a->ws + WS_X); bf16_t* H = (bf16_t*)(a->ws + WS_H); const float* MOD = (const float*)(a->ws + WS_MOD); const bf16_t* O = (const bf16_t*)(a->ws + WS_O);
    LAS unsigned* lcnt = (LAS unsigned*)(lds + 131072 + 64);
    if (L == 1) { if (tid < 8) lcnt[tid] = 0u; __syncthreads(); }
    for (int row = gw; row < NR; row += ngw) {
        const int b = row / TPB, t = row % TPB; const bool lat = t < SEQ; const int v = lat ? b : 4;
        if (L == 1 && !lat) continue;
        const float* mv = MOD + (size_t)(L * 5 + v) * MODW;
        f32x4 o[8], x[8], h[8]; ld_row_bf16(O + (size_t)row * D, lane, o); ld_row_f32(X + (size_t)row * D, lane, x);
        const float r1 = row_rstd(o);
#pragma unroll
        for (int j = 0; j < 8; ++j) { const int c = 4 * lane + 256 * j; const f32x4 gv = *(const f32x4*)(a->in[I_GMIXPOST] + L * D + c), gt = *(const f32x4*)(mv + 2 * D + c);
            x[j] = x[j] + gt * (o[j] * r1 * gv); }
        st_row_f32(X + (size_t)row * D, lane, x);
        norm_mod_store(x, a->in[I_GFFNPRE] + L * D, mv + 3 * D, mv + 4 * D, H + (size_t)row * D, lane, h);
        if (L == 1) {
            float lg[8];
#pragma unroll
            for (int e = 0; e < 8; ++e) lg[e] = 0.f;
#pragma unroll
            for (int j = 0; j < 8; ++j) { const float* rp = a->in[I_ROUTER] + (size_t)(4 * lane + 256 * j) * NE;
#pragma unroll
                for (int q = 0; q < 4; ++q) { const f32x4 r0 = *(const f32x4*)(rp + q * 8), r1v = *(const f32x4*)(rp + q * 8 + 4); const float hv = h[j][q];
                    lg[0] += hv * r0.x; lg[1] += hv * r0.y; lg[2] += hv * r0.z; lg[3] += hv * r0.w; lg[4] += hv * r1v.x; lg[5] += hv * r1v.y; lg[6] += hv * r1v.z; lg[7] += hv * r1v.w; } }
#pragma unroll
            for (int e = 0; e < 8; ++e) lg[e] = wave_sum(lg[e]);
            int i1 = 0; float v1 = lg[0];
#pragma unroll
            for (int e = 1; e < 8; ++e) if (lg[e] > v1) { v1 = lg[e]; i1 = e; }
            int i2 = -1; float v2 = -3.0e38f;
#pragma unroll
            for (int e = 0; e < 8; ++e) if (e != i1 && lg[e] > v2) { v2 = lg[e]; i2 = e; }
            const float e2 = __expf(v2 - v1), g1 = 1.f / (1.f + e2), g2 = e2 / (1.f + e2);
            if (lane == 0) { const int tok = b * SEQ + t; int* tk = (int*)(a->ws + WS_TOPK) + (size_t)tok * 4; tk[0] = i1; tk[1] = i2; ((float*)tk)[2] = g1; ((float*)tk)[3] = g2;
                atomicAdd((unsigned*)&lcnt[i1], 1u); atomicAdd((unsigned*)&lcnt[i2], 1u); }
        }
    }
    if (L == 1) { __syncthreads(); if (tid < 8) { const unsigned c = lcnt[tid]; if (c) __hip_atomic_fetch_add((unsigned*)(a->ws + WS_CTL) + CW_CNT + tid, c, __ATOMIC_RELAXED, __HIP_MEMORY_SCOPE_AGENT); } __syncthreads(); }
}
constexpr int LDS_CTL_OFF = 131072;
__device__ __forceinline__ LAS int* moe_offsets(ArgsP a, LAS unsigned char* lds, int tid) {
    LAS int* toff = (LAS int*)(lds + LDS_CTL_OFF);
    __syncthreads();
    if (tid == 0) { int acc = 0;
        for (int e = 0; e < 8; ++e) { toff[e] = acc; const unsigned c = __hip_atomic_load((unsigned*)(a->ws + WS_CTL) + CW_CNT + e, __ATOMIC_RELAXED, __HIP_MEMORY_SCOPE_AGENT); acc += (int)((c + 255u) >> 8); }
        toff[8] = acc; }
    __syncthreads();
    return toff;
}
__device__ __forceinline__ void phase_moe_slots(ArgsP a, LAS unsigned char* lds, int gw, int ngw, int tid, int lane) {
    LAS int* toff = moe_offsets(a, lds, tid);
    unsigned* ctl = (unsigned*)(a->ws + WS_CTL); int* SLOT = (int*)(a->ws + WS_SLOT); const int* TOPK = (const int*)(a->ws + WS_TOPK);
    const bf16_t* H = (const bf16_t*)(a->ws + WS_H); bf16_t* HG = (bf16_t*)(a->ws + WS_HG);
    for (int grp = gw; grp < NTOK / 8; grp += ngw) {
        const bool act = lane < 8; const int tok = grp * 8 + (lane & 7), b = tok / SEQ, t = tok % SEQ, row = b * TPB + t;
        const int e1 = act ? TOPK[tok * 4] : -1, e2 = act ? TOPK[tok * 4 + 1] : -1; int s0 = 0, s1 = 0;
#pragma unroll
        for (int e = 0; e < 8; ++e) { const bool sel = (e1 == e) || (e2 == e); const unsigned long long m = __ballot(sel); const int n = __popcll(m);
            unsigned base = 0; if (lane == 0 && n) base = __hip_atomic_fetch_add(ctl + CW_CUR + e, (unsigned)n, __ATOMIC_RELAXED, __HIP_MEMORY_SCOPE_AGENT);
            base = __shfl(base, 0);
            const int slot = toff[e] * 256 + (int)base + __popcll(m & ((1ull << lane) - 1ull));
            if (e1 == e) s0 = slot; if (e2 == e) s1 = slot; }
        if (act) { SLOT[tok * 2] = s0; SLOT[tok * 2 + 1] = s1; }
#pragma unroll 2
        for (int i = 0; i < 8; ++i) { const int r = __shfl(row, i), d0 = __shfl(s0, i), d1 = __shfl(s1, i);
            const u32x4* sp = (const u32x4*)(H + (size_t)r * D) + lane; u32x4* p0 = (u32x4*)(HG + (size_t)d0 * D) + lane; u32x4* p1 = (u32x4*)(HG + (size_t)d1 * D) + lane;
#pragma unroll
            for (int j = 0; j < 4; ++j) { const u32x4 w = sp[64 * j]; p0[64 * j] = w; p1[64 * j] = w; } }
    }
    __syncthreads();
}
template <int L> __device__ __forceinline__ void phase_row_end(ArgsP a, int gw, int ngw, int lane) {
    float* X = (float*)(a->ws + WS_X); bf16_t* H = (bf16_t*)(a->ws + WS_H); const float* MOD = (const float*)(a->ws + WS_MOD); const bf16_t* Y = (const bf16_t*)(a->ws + WS_Y);
    for (int row = gw; row < NR; row += ngw) {
        const int b = row / TPB, t = row % TPB; const bool lat = t < SEQ; const int v = lat ? b : 4;
        if (L == 1 && !lat) continue;
        const float* mv = MOD + (size_t)(L * 5 + v) * MODW;
        f32x4 y[8], x[8], h[8];
        if (L == 0) ld_row_bf16(Y + (size_t)row * D, lane, y);
        else { const int tok = b * SEQ + t; const int* sl = (const int*)(a->ws + WS_SLOT) + tok * 2; const float* tk = (const float*)(a->ws + WS_TOPK) + (size_t)tok * 4; const float g1 = tk[2], g2 = tk[3];
            f32x4 y2[8]; ld_row_bf16(Y + (size_t)sl[0] * D, lane, y); ld_row_bf16(Y + (size_t)sl[1] * D, lane, y2);
#pragma unroll
            for (int j = 0; j < 8; ++j) y[j] = y[j] * g1 + y2[j] * g2; }
        ld_row_f32(X + (size_t)row * D, lane, x);
        const float r1 = row_rstd(y);
#pragma unroll
        for (int j = 0; j < 8; ++j) { const int c = 4 * lane + 256 * j; const f32x4 gv = *(const f32x4*)(a->in[I_GFFNPOST] + L * D + c), gt = *(const f32x4*)(mv + 5 * D + c);
            x[j] = x[j] + gt * (y[j] * r1 * gv); }
        if (L == 0) { st_row_f32(X + (size_t)row * D, lane, x); const float* mn = MOD + (size_t)(1 * 5 + v) * MODW;
            norm_mod_store(x, a->in[I_GMIXPRE] + D, mn + 0 * D, mn + 1 * D, H + (size_t)row * D, lane, h); }
        else st_row_f32(a->out + ((size_t)b * SEQ + t) * D, lane, x);
    }
}

template <int L> __device__ __forceinline__ void phase_qkpost(ArgsP a, LAS unsigned char* lds, int gw, int ngw, int tid, int lane) {
    bf16_t* QKV = (bf16_t*)(a->ws + WS_QKV);
    const float L2T = 13.287712379549449f;
    const float fg = exp2f(-(float)(lane & 31) * (1.f / 32.f) * L2T), fd = exp2f(-(float)(lane & 15) * (1.f / 16.f) * L2T);
    const float qn0 = a->in[I_QNORM][L * 128 + lane], qn1 = a->in[I_QNORM][L * 128 + 64 + lane], kn0 = a->in[I_KNORM][L * 128 + lane], kn1 = a->in[I_KNORM][L * 128 + 64 + lane];
    for (int row = gw; row < NR; row += ngw) {
        const int t = row % TPB; const bool lat = t < SEQ; const int gr = t >> 6, gc = t & 63;
        bf16_t* q = QKV + (size_t)row * INW;
        float cr, sr, cc, sc2, cd, sd;
        sincosf((float)gr * fg, &sr, &cr); sincosf((float)gc * fg, &sc2, &cc); sincosf((float)(lane < 32 ? gr : gc) * fd, &sd, &cd);
#pragma unroll 2
        for (int hd = 0; hd < 10; ++hd) {
            const int base = hd < 8 ? 1536 + hd * 128 : 2560 + (hd - 8) * 128;
            float e0 = bf2f(q[base + lane]), e1 = bf2f(q[base + 64 + lane]);
            const float r = rsqrtf(wave_sum(e0 * e0 + e1 * e1) * (1.f / 128.f) + EPS);
            e0 = e0 * r * (hd < 8 ? qn0 : kn0); e1 = e1 * r * (hd < 8 ? qn1 : kn1);
            if (lat) { const float p0 = __shfl_xor(e0, 32), p1 = __shfl_xor(e1, 32);
                if (lane < 32) { e0 = e0 * cr - p0 * sr; e1 = e1 * cc - p1 * sc2; } else { e0 = e0 * cr + p0 * sr; e1 = e1 * cc + p1 * sc2; } }
            q[base + lane] = f2bf(e0); q[base + 64 + lane] = f2bf(e1);
        }
        if (lat) {
#pragma unroll 2
            for (int bl = 0; bl < 8; ++bl) {
                const int base = 3072 + bl * 128;
                float e0 = bf2f(q[base + lane]), e1 = bf2f(q[base + 64 + lane]);
                const float p0 = __shfl_xor(e0, 16), p1 = __shfl_xor(e1, 16);
                if ((lane & 16) == 0) { e0 = e0 * cd - p0 * sd; e1 = e1 * cd - p1 * sd; } else { e0 = e0 * cd + p0 * sd; e1 = e1 * cd + p1 * sd; }
                q[base + lane] = f2bf(e0); q[base + 64 + lane] = f2bf(e1);
            }
        }
    }
    bf16_t* VT = (bf16_t*)(a->ws + WS_VT); LAS bf16_t* tile = (LAS bf16_t*)lds;
    for (int task = blockIdx.x; task < NB * 4 * 68; task += gridDim.x) {
        const int tb = task % 68, h = (task / 68) % 4, b = task / 272, t0 = tb * 64;
        __syncthreads();
#pragma unroll
        for (int i = 0; i < 2; ++i) { const int pc = tid + i * 512, tk = pc >> 4, ch = pc & 15;
            const u32x4 w = *(const u32x4*)(QKV + (size_t)(b * TPB + t0 + tk) * INW + 1024 + h * 128 + ch * 8); *(LAS u32x4*)(tile + tk * 136 + ch * 8) = w; }
        __syncthreads();
        const int d = tid >> 2, tq = (tid & 3) * 16; unsigned w[8];
#pragma unroll
        for (int i = 0; i < 8; ++i) w[i] = (unsigned)tile[(tq + 2 * i) * 136 + d] | ((unsigned)tile[(tq + 2 * i + 1) * 136 + d] << 16);
        bf16_t* dst = VT + ((size_t)(b * 4 + h) * 128 + d) * TPB + t0 + tq;
        *(u32x4*)dst = (u32x4){w[0], w[1], w[2], w[3]}; *(u32x4*)(dst + 8) = (u32x4){w[4], w[5], w[6], w[7]};
    }
    __syncthreads();
}

template <int DQ> __device__ __forceinline__ void attn_wave(const bf16_t* QKV, const LAS float* qs, int kcol, int vcol, int nblk, int mode, int krow0, int b, int r, int c,
                                                               const float* rpb, float scale, int lane, float& o0, float& o1) {
    float m = -1e30f, l = 0.f, a0 = 0.f, a1 = 0.f;
    const int rs = min(max(r - 4, 0), 56), cs = min(max(c - 8, 0), 48);
    for (int blk = 0; blk < nblk; ++blk) {
        const int kidx = blk * 64 + lane; int krow; float bias = 0.f;
        if (mode == 0) krow = krow0 + kidx;
        else if (kidx < 128) { const int kr = rs + (kidx >> 4), kc = cs + (kidx & 15); krow = b * TPB + kr * 64 + kc; bias = rpb[(kr - r + 7) * 31 + (kc - c + 15)]; }
        else krow = b * TPB + SEQ + (kidx - 128);
        const bf16_t* kp = QKV + (size_t)krow * INW + kcol;
        float s = 0.f;
#pragma unroll
        for (int j = 0; j < DQ / 8; ++j) { const u32x4 kv = *(const u32x4*)(kp + 8 * j); const f32x4 q0 = *(const LAS f32x4*)(qs + 8 * j), q1 = *(const LAS f32x4*)(qs + 8 * j + 4);
            s += bf_lo(kv.x) * q0.x + bf_hi(kv.x) * q0.y + bf_lo(kv.y) * q0.z + bf_hi(kv.y) * q0.w + bf_lo(kv.z) * q1.x + bf_hi(kv.z) * q1.y + bf_lo(kv.w) * q1.z + bf_hi(kv.w) * q1.w; }
        s = s * scale + bias;
        const float mn = fmaxf(m, wave_max(s)), alpha = __expf(m - mn), p = __expf(s - mn);
        l = l * alpha + wave_sum(p); a0 *= alpha; a1 *= alpha; m = mn;
#pragma unroll 8
        for (int k = 0; k < 64; ++k) { const float pk = __shfl(p, k); const int rr = __shfl(krow, k);
            const unsigned vv = *(const unsigned*)(QKV + (size_t)rr * INW + vcol + 2 * lane); a0 += pk * bf_lo(vv); a1 += pk * bf_hi(vv); }
    }
    const float il = 1.f / l; o0 = a0 * il; o1 = a1 * il;
}
template <int L> __device__ __forceinline__ void phase_attn_na_naive(ArgsP a, LAS unsigned char* lds, int gw, int ngw, int wave, int lane) {
    const bf16_t* QKV = (const bf16_t*)(a->ws + WS_QKV); bf16_t* ATT = (bf16_t*)(a->ws + WS_ATT);
    LAS float* qs = (LAS float*)(lds + wave * 512);
    const int NLAT = NB * 4 * SEQ, NCTXT = (L == 0) ? NB * 4 * CTX : 0;
    for (int task = gw; task < NLAT + NCTXT; task += ngw) {
        int b, ht, t; bool lat = task < NLAT;
        if (lat) { t = task % SEQ; ht = (task / SEQ) % 4; b = task / (4 * SEQ); } else { const int u = task - NLAT; t = SEQ + u % CTX; ht = (u / CTX) % 4; b = u / (4 * CTX); }
        const int row = b * TPB + t, r = t >> 6, c = t & 63;
        const int krow0 = lat ? b * TPB : b * TPB + SEQ;
        float o0, o1;
        const unsigned qv = *(const unsigned*)(QKV + (size_t)row * INW + ht * 128 + 2 * lane); qs[2 * lane] = bf_lo(qv); qs[2 * lane + 1] = bf_hi(qv); LDS_WAIT();
        attn_wave<128>(QKV, qs, 512 + ht * 128, 1024 + ht * 128, lat ? 6 : 4, lat ? 1 : 0, krow0, b, r, c, a->in[I_RPB] + (size_t)(L * 4 + ht) * 465, 0.08838834764831845f, lane, o0, o1);
        *(unsigned*)(ATT + (size_t)row * D + ht * 128 + 2 * lane) = cvt_pk_bf16(o0, o1);
        LDS_WAIT();
    }
}
namespace att {
typedef short s16x4 __attribute__((ext_vector_type(4)));
typedef float f32x16 __attribute__((ext_vector_type(16)));
constexpr int KVBLK = 64;
constexpr int SHM_V = KVBLK * 128 * 2, SHM_K = KVBLK * 128 * 2;
constexpr float THR = 8.f;
#define KSWZ(row, colB) ((row) * 256 + ((colB) ^ (((row) & 7) << 4)))
#define SBAR() __builtin_amdgcn_sched_barrier(0)
__device__ __forceinline__ int crow(int r, int hi) { return (r & 3) + 8 * (r >> 2) + 4 * hi; }
__device__ __forceinline__ unsigned cvtpk(float lo, float hi) { unsigned r; asm volatile("v_cvt_pk_bf16_f32 %0, %1, %2" : "=v"(r) : "v"(lo), "v"(hi)); return r; }
template <int MODE> __device__ __forceinline__ void partialSM(f32x16& p0, f32x16& p1, float& m_reg, float& mn, float& alpha) {
  constexpr float SCALE = MODE == 0 ? 0.088388347648318440f : 0.125f;
  constexpr float C = SCALE * 1.4426950408889634f;
  float pmax = p0[0];
#pragma unroll
  for (int r = 1; r < 16; ++r) pmax = fmaxf(pmax, p0[r]);
#pragma unroll
  for (int r = 0; r < 16; ++r) pmax = fmaxf(pmax, p1[r]);
  { auto rr = __builtin_amdgcn_permlane32_swap(__float_as_uint(pmax), __float_as_uint(pmax), false, false);
    pmax = fmaxf(__uint_as_float(rr[0]), __uint_as_float(rr[1])); }
  if (__builtin_expect(__all(pmax - m_reg <= THR / SCALE), 1)) { mn = m_reg; alpha = 1.f; }
  else { mn = fmaxf(m_reg, pmax); alpha = __builtin_amdgcn_exp2f((m_reg - mn) * C); m_reg = mn; }
  float mnC = -mn * C;
#pragma unroll
  for (int r = 0; r < 16; ++r) p0[r] = fmaf(p0[r], C, mnC);
#pragma unroll
  for (int r = 0; r < 16; ++r) p1[r] = fmaf(p1[r], C, mnC);
#pragma unroll
  for (int r = 0; r < 16; ++r) p0[r] = __builtin_amdgcn_exp2f(p0[r]);
}
__device__ __forceinline__ void finishSM(f32x16& p0, f32x16& p1, float alpha, float& l_reg, bf16x8& pa0, bf16x8& pa1, bf16x8& pa2, bf16x8& pa3) {
#pragma unroll
  for (int r = 0; r < 16; ++r) p1[r] = __builtin_amdgcn_exp2f(p1[r]);
  float ps = 0;
#pragma unroll
  for (int r = 0; r < 16; ++r) ps += p0[r];
#pragma unroll
  for (int r = 0; r < 16; ++r) ps += p1[r];
  { auto rr = __builtin_amdgcn_permlane32_swap(__float_as_uint(ps), __float_as_uint(ps), false, false);
    ps = __uint_as_float(rr[0]) + __uint_as_float(rr[1]); }
  l_reg = l_reg * alpha + ps;
#define PK4(P, BASE, OUT) do { unsigned a0 = cvtpk(P[BASE + 0], P[BASE + 1]), a1 = cvtpk(P[BASE + 2], P[BASE + 3]);   \
    unsigned b0 = cvtpk(P[BASE + 4], P[BASE + 5]), b1 = cvtpk(P[BASE + 6], P[BASE + 7]);                              \
    auto r0 = __builtin_amdgcn_permlane32_swap(a0, b0, false, false); auto r1 = __builtin_amdgcn_permlane32_swap(a1, b1, false, false); \
    u32x4 w = {r0[0], r1[0], r0[1], r1[1]}; OUT = *reinterpret_cast<bf16x8*>(&w); } while (0)
  PK4(p0, 0, pa0); PK4(p0, 8, pa1); PK4(p1, 0, pa2); PK4(p1, 8, pa3);
#undef PK4
}
template <int NQ> __device__ __forceinline__ void qkt(f32x16& p0, f32x16& p1, const LAS unsigned char* Ks, const bf16x8* qr, int r32, int hi, int mapoff) {
  p0 = f32x16{}; p1 = f32x16{};
#pragma unroll
  for (int d0 = 0; d0 < NQ; ++d0) { int cb = (mapoff + d0 * 16 + hi * 8) * 2;
    bf16x8 b0 = *reinterpret_cast<const LAS bf16x8*>(Ks + KSWZ(r32, cb));
    bf16x8 b1 = *reinterpret_cast<const LAS bf16x8*>(Ks + KSWZ(32 + r32, cb));
    p0 = __builtin_amdgcn_mfma_f32_32x32x16_bf16(b0, qr[d0], p0, 0, 0, 0);
    p1 = __builtin_amdgcn_mfma_f32_32x32x16_bf16(b1, qr[d0], p1, 0, 0, 0); }
}
__device__ __forceinline__ int v_st(int k, int c) { const int kk = (k & ~0xC) | ((k & 4) << 1) | ((k & 8) >> 1); return ((kk >> 3) * 4 + (c >> 5)) * 512 + ((kk & 7) * 32 + (c & 31)) * 2; }
__device__ __forceinline__ int v_rd_base(int lane) { return ((lane & 3) << 3) | (((lane >> 2) & 3) << 6) | (((lane >> 4) & 1) << 5) | (((lane >> 5) & 1) << 8); }
constexpr int v_rd_off(int d0, int ks, int half) { return d0 * 512 + ks * 4096 + half * 2048; }
template <int OFF> __device__ __forceinline__ s16x4 tr_read(int vb) {
  s16x4 r; asm volatile("ds_read_b64_tr_b16 %0, %1 offset:%2" : "=&v"(r) : "v"(vb), "i"(OFF) : "memory"); return r;
}
template <int D0> __device__ __forceinline__ void pv_one(f32x16& od, int vb, bf16x8 pa0, bf16x8 pa1, bf16x8 pa2, bf16x8 pa3) {
  const s16x4 l0 = tr_read<v_rd_off(D0, 0, 0)>(vb), h0 = tr_read<v_rd_off(D0, 0, 1)>(vb), l1 = tr_read<v_rd_off(D0, 1, 0)>(vb), h1 = tr_read<v_rd_off(D0, 1, 1)>(vb);
  const s16x4 l2 = tr_read<v_rd_off(D0, 2, 0)>(vb), h2 = tr_read<v_rd_off(D0, 2, 1)>(vb), l3 = tr_read<v_rd_off(D0, 3, 0)>(vb), h3 = tr_read<v_rd_off(D0, 3, 1)>(vb);
  asm volatile("s_waitcnt lgkmcnt(0)" ::: "memory"); SBAR();
#define PK(L, H) (bf16x8){L[0], L[1], L[2], L[3], H[0], H[1], H[2], H[3]}
  od = __builtin_amdgcn_mfma_f32_32x32x16_bf16(pa0, PK(l0, h0), od, 0, 0, 0);
  od = __builtin_amdgcn_mfma_f32_32x32x16_bf16(pa1, PK(l1, h1), od, 0, 0, 0);
  od = __builtin_amdgcn_mfma_f32_32x32x16_bf16(pa2, PK(l2, h2), od, 0, 0, 0);
  od = __builtin_amdgcn_mfma_f32_32x32x16_bf16(pa3, PK(l3, h3), od, 0, 0, 0);
#undef PK
}
__device__ __forceinline__ void pv_d0(f32x16* o, int vb, bf16x8 pa0, bf16x8 pa1, bf16x8 pa2, bf16x8 pa3) {
  pv_one<0>(o[0], vb, pa0, pa1, pa2, pa3); pv_one<1>(o[1], vb, pa0, pa1, pa2, pa3); pv_one<2>(o[2], vb, pa0, pa1, pa2, pa3); pv_one<3>(o[3], vb, pa0, pa1, pa2, pa3);
}
template <int MODE>
__device__ __forceinline__ void attn_body(const bf16_t* __restrict__ Qb, const bf16_t* __restrict__ Kh, const bf16_t* __restrict__ Vh, bf16_t* __restrict__ Ob, int seq, LAS unsigned char* lds,
                                          float lam, float osc, const float* __restrict__ subln) {
  constexpr int NQ = MODE == 0 ? 8 : 4;
  const int tid = threadIdx.x, wid = __builtin_amdgcn_readfirstlane(tid >> 6), lane = tid & 63, r32 = lane & 31, hi = lane >> 5;
  const int wrow = MODE == 0 ? wid : (wid & 3), mapoff = MODE == 0 ? 0 : (wid >> 2) * 64;
  LAS unsigned char* V_lds = lds; LAS unsigned char* K_lds = lds + 2 * SHM_V;
  LAS float* wsf = (LAS float*)(lds + 2 * SHM_V + 2 * SHM_K) + wid * 64; LAS float* li_l = wsf; LAS float* al_l = wsf + 32;
  float m_reg = -1e30f, l_reg = 0; f32x16 o[4] = {}; bf16x8 qr[NQ];
  const bf16_t* Qw = Qb + (size_t)(wrow * 32 + r32) * INW + mapoff + hi * 8;
#pragma unroll
  for (int d0 = 0; d0 < NQ; ++d0) qr[d0] = *reinterpret_cast<const bf16x8*>(Qw + d0 * 16);
  const int sr = tid >> 4, sc = (tid & 15) * 8, vst0 = v_st(sr, sc), vst1 = v_st(32 + sr, sc);
  const int vb0 = (int)(uintptr_t)V_lds + v_rd_base(lane);
  struct { bf16x8 vs0, vs1, ks0, ks1; } sr_[2];
#define SLOAD(i, k0) do { sr_[i].vs0 = *(const bf16x8*)(&Vh[(size_t)((k0) + sr) * INW + sc]); sr_[i].vs1 = *(const bf16x8*)(&Vh[(size_t)((k0) + 32 + sr) * INW + sc]); \
    sr_[i].ks0 = *(const bf16x8*)(&Kh[(size_t)((k0) + sr) * INW + sc]); sr_[i].ks1 = *(const bf16x8*)(&Kh[(size_t)((k0) + 32 + sr) * INW + sc]); } while (0)
#define SWRITE(b, i) do { *(LAS bf16x8*)(V_lds + (b) * SHM_V + vst0) = sr_[i].vs0;          \
    *(LAS bf16x8*)(V_lds + (b) * SHM_V + vst1) = sr_[i].vs1; int kc = sc * 2;               \
    *(LAS bf16x8*)(K_lds + (b) * SHM_K + KSWZ(sr, kc)) = sr_[i].ks0;                       \
    *(LAS bf16x8*)(K_lds + (b) * SHM_K + KSWZ(32 + sr, kc)) = sr_[i].ks1; } while (0)
#define SWAIT() asm volatile("s_waitcnt vmcnt(4)" ::: "memory")
#define RESC(a) do { if (__any((a) < 1.f)) { if (hi == 0) al_l[r32] = (a); asm volatile("s_waitcnt lgkmcnt(0)" ::: "memory"); \
    _Pragma("unroll") for (int d = 0; d < 4; ++d) _Pragma("unroll") for (int r = 0; r < 16; ++r) o[d][r] *= al_l[crow(r, hi)]; } } while (0)
  f32x16 pA0, pA1, pB0, pB1; float mnA, mnB, alA, alB; bf16x8 pa0, pa1, pa2, pa3; const int NT = seq / KVBLK;
  constexpr int SE = 0, SO = 1;
  SLOAD(SE, 0); asm volatile("s_waitcnt vmcnt(0)" ::: "memory"); SWRITE(0, SE); __syncthreads();
  qkt<NQ>(pA0, pA1, K_lds, qr, r32, hi, mapoff); partialSM<MODE>(pA0, pA1, m_reg, mnA, alA);
  SLOAD(SO, KVBLK); if (2 < NT) SLOAD(SE, 2 * KVBLK);
  SWAIT(); SWRITE(1, SO); __syncthreads();
  for (int j = 1; j + 1 < NT; j += 2) {
    SBAR(); qkt<NQ>(pB0, pB1, K_lds + SHM_K, qr, r32, hi, mapoff);
    finishSM(pA0, pA1, alA, l_reg, pa0, pa1, pa2, pa3); SBAR();
    SLOAD(SO, (j + 2) * KVBLK); SBAR();
    pv_d0(o, vb0, pa0, pa1, pa2, pa3); partialSM<MODE>(pB0, pB1, m_reg, mnB, alB);
    __syncthreads(); SWAIT(); SWRITE(0, SE);
    RESC(alB); __syncthreads();
    SBAR(); qkt<NQ>(pA0, pA1, K_lds, qr, r32, hi, mapoff);
    finishSM(pB0, pB1, alB, l_reg, pa0, pa1, pa2, pa3); SBAR();
    if (j + 3 < NT) SLOAD(SE, (j + 3) * KVBLK); SBAR();
    pv_d0(o, vb0 + SHM_V, pa0, pa1, pa2, pa3); partialSM<MODE>(pA0, pA1, m_reg, mnA, alA);
    __syncthreads(); SWAIT(); SWRITE(1, SO);
    RESC(alA); __syncthreads();
  }
  SBAR(); qkt<NQ>(pB0, pB1, K_lds + SHM_K, qr, r32, hi, mapoff);
  finishSM(pA0, pA1, alA, l_reg, pa0, pa1, pa2, pa3); SBAR();
  pv_d0(o, vb0, pa0, pa1, pa2, pa3); partialSM<MODE>(pB0, pB1, m_reg, mnB, alB);
  __syncthreads(); RESC(alB);
  finishSM(pB0, pB1, alB, l_reg, pa0, pa1, pa2, pa3); SBAR();
  pv_d0(o, vb0 + SHM_V, pa0, pa1, pa2, pa3);
  if (hi == 0) li_l[r32] = l_reg; asm volatile("s_waitcnt lgkmcnt(0)" ::: "memory");
  float rli[16];
#pragma unroll
  for (int r = 0; r < 16; ++r) rli[r] = __builtin_amdgcn_rcpf(li_l[crow(r, hi)]);
  bf16_t* Ow = Ob + (size_t)(wrow * 32) * D;
  if (MODE == 0) {
#pragma unroll
    for (int r = 0; r < 16; ++r) { const int orow = crow(r, hi);
#pragma unroll
      for (int d0 = 0; d0 < 4; ++d0) Ow[(size_t)orow * D + d0 * 32 + r32] = f2bf(o[d0][r] * rli[r]); }
    __syncthreads();
  } else {
#pragma unroll
    for (int r = 0; r < 16; ++r)
#pragma unroll
      for (int d0 = 0; d0 < 4; ++d0) o[d0][r] *= rli[r];
    __syncthreads();
    LAS float* xb = (LAS float*)lds + (wid & 3) * 4096;
    if (wid >= 4) {
#pragma unroll
      for (int r = 0; r < 16; ++r)
#pragma unroll
        for (int d0 = 0; d0 < 4; ++d0) xb[crow(r, hi) * 128 + d0 * 32 + r32] = o[d0][r];
    }
    __syncthreads();
    if (wid < 4) {
      float sg[4];
#pragma unroll
      for (int d0 = 0; d0 < 4; ++d0) sg[d0] = subln[d0 * 32 + r32] * osc;
#pragma unroll
      for (int r = 0; r < 16; ++r) { float ss = 0.f;
#pragma unroll
        for (int d0 = 0; d0 < 4; ++d0) { o[d0][r] -= lam * xb[crow(r, hi) * 128 + d0 * 32 + r32]; ss += o[d0][r] * o[d0][r]; }
#pragma unroll
        for (int x = 1; x < 32; x <<= 1) ss += __shfl_xor(ss, x);
        const float rr = rsqrtf(ss * (1.f / 128.f) + EPS); const int orow = crow(r, hi);
#pragma unroll
        for (int d0 = 0; d0 < 4; ++d0) Ow[(size_t)orow * D + d0 * 32 + r32] = f2bf(o[d0][r] * rr * sg[d0]); }
    }
    __syncthreads();
  }
#undef SLOAD
#undef SWRITE
#undef SWAIT
#undef RESC
}
}

namespace pg8 {
constexpr int BM = 256, BK = 64, HALF = 128, HTB = HALF * BK * 2, STAGE_BYTES = 8 * HTB, NXCD = 8, WGM = 8;
__host__ __device__ __forceinline__ int lds_byte(int r, int c) { const int st = (r >> 4) * 2 + (c >> 5), rr = r & 15, cc = c & 31, ob = rr * 64 + cc * 2; return st * 1024 + (ob ^ (((ob >> 9) & 1) << 5)); }
__host__ __device__ __forceinline__ void stage_rc(int b, int& R, int& C) { const int st = b / 1024, sb = b % 1024, swz = sb ^ (((sb >> 9) & 1) << 5); R = (st >> 1) * 16 + swz / 64; C = (st & 1) * 32 + (swz % 64) / 2; }
__host__ __device__ __forceinline__ int perm32(int rho) { const int n = rho >> 4, i = rho & 15; return 8 * (i >> 2) + 4 * n + (i & 3); }
struct Unit { int pm, pn; size_t boff; };
struct Gemm { const bf16_t* A; const bf16_t* Bt; int K; };
template <bool SKIPCTX> struct StaticOrder {
    int nM, nN, nwg, G, c;
    __device__ void init(int nM_, int nN_, int G_, int c_) { nM = nM_; nN = nN_; nwg = nM * nN; G = G_; c = c_; }
    __device__ bool next(int i, Unit& u) const {
        const long L = (long)i * G + c; if (L >= nwg) return false;
        int wgid = (int)L; { const int q = nwg / NXCD, r = nwg % NXCD, xcd = wgid % NXCD, off = wgid / NXCD; wgid = (xcd < r ? xcd * (q + 1) : r * (q + 1) + (xcd - r) * q) + off; }
        const int nig = WGM * nN, gid = wgid / nig, fm = gid * WGM, gsz = (nM - fm) < WGM ? (nM - fm) : WGM;
        int pm = fm + ((wgid % nig) % gsz); u.pn = (wgid % nig) / gsz; if (SKIPCTX) pm += pm >> 4; u.pm = pm; u.boff = 0; return true;
    }
};
struct MoeOrder {
    int nM, nN, nwg, G, c; int toff[8]; size_t bstride;
    __device__ void init(const LAS int* t, int nN_, int G_, int c_, size_t bstride_) { for (int e = 0; e < 8; ++e) toff[e] = __builtin_amdgcn_readfirstlane(t[e]); nM = __builtin_amdgcn_readfirstlane(t[8]); nN = nN_; nwg = nM * nN; G = G_; c = c_; bstride = bstride_; }
    __device__ bool next(int i, Unit& u) const {
        const long L = (long)i * G + c; if (L >= nwg) return false;
        int wgid = (int)L; { const int q = nwg / NXCD, r = nwg % NXCD, xcd = wgid % NXCD, off = wgid / NXCD; wgid = (xcd < r ? xcd * (q + 1) : r * (q + 1) + (xcd - r) * q) + off; }
        const int nig = WGM * nN, gid = wgid / nig, fm = gid * WGM, gsz = (nM - fm) < WGM ? (nM - fm) : WGM;
        const int pm = fm + ((wgid % nig) % gsz); u.pn = (wgid % nig) / gsz; u.pm = pm;
        int e = 0;
#pragma unroll
        for (int q = 1; q < 8; ++q) e += (pm >= toff[q]) ? 1 : 0;
        u.boff = (size_t)e * bstride; return true;
    }
};
struct EpiBf16 {
    bf16_t* O; int ldc;
    __device__ __forceinline__ void operator()(const f32x4 (&acc)[2][2][4][2], const Unit& u, int wr, int wc, int fr, int fq) const {
        const int row0 = u.pm * BM + wr * 64 + fr, col0 = u.pn * BM + wc * 32 + 8 * fq;
#pragma unroll
        for (int ai = 0; ai < 2; ++ai)
#pragma unroll
            for (int m = 0; m < 4; ++m) { bf16_t* rowp = O + (size_t)(row0 + ai * HALF + m * 16) * ldc + col0;
#pragma unroll
                for (int bj = 0; bj < 2; ++bj) { const f32x4 v0 = acc[ai][bj][m][0], v1 = acc[ai][bj][m][1];
                    u32x4 w; w.x = cvt_pk_bf16(v0[0], v0[1]); w.y = cvt_pk_bf16(v0[2], v0[3]); w.z = cvt_pk_bf16(v1[0], v1[1]); w.w = cvt_pk_bf16(v1[2], v1[3]);
                    *(u32x4*)(rowp + bj * HALF) = w; } }
    }
};
__device__ __forceinline__ float silu_mul(float g, float u) { return g * __builtin_amdgcn_rcpf(1.f + __expf(-g)) * u; }
struct EpiSwiglu {
    bf16_t* O; int ldc;
    __device__ __forceinline__ void operator()(const f32x4 (&acc)[2][2][4][2], const Unit& u, int wr, int wc, int fr, int fq) const {
        const int row0 = u.pm * BM + wr * 64 + fr, col0 = u.pn * HALF + wc * 32 + 8 * fq;
#pragma unroll
        for (int ai = 0; ai < 2; ++ai)
#pragma unroll
            for (int m = 0; m < 4; ++m) { bf16_t* rowp = O + (size_t)(row0 + ai * HALF + m * 16) * ldc + col0;
                const f32x4 g0 = acc[ai][0][m][0], g1 = acc[ai][0][m][1], u0 = acc[ai][1][m][0], u1 = acc[ai][1][m][1];
                u32x4 w; w.x = cvt_pk_bf16(silu_mul(g0[0], u0[0]), silu_mul(g0[1], u0[1])); w.y = cvt_pk_bf16(silu_mul(g0[2], u0[2]), silu_mul(g0[3], u0[3]));
                w.z = cvt_pk_bf16(silu_mul(g1[0], u1[0]), silu_mul(g1[1], u1[1])); w.w = cvt_pk_bf16(silu_mul(g1[2], u1[2]), silu_mul(g1[3], u1[3]));
                *(u32x4*)rowp = w; }
    }
};
template <class Epi, class Sched>
__device__ __forceinline__ void gemm_phase(LAS unsigned char* lds, const Gemm g, const Sched& S, const Epi& E) {
    const int tid = threadIdx.x, wid = __builtin_amdgcn_readfirstlane(tid >> 6), lane = tid & 63, wr = wid >> 2, wc = wid & 3, fr = lane & 15, fq = lane >> 4;
    const int K = g.K, nt = K / BK;
    unsigned voffA[2], voffB[2];
#pragma unroll
    for (int i = 0; i < 2; ++i) { int R, C; stage_rc(tid * 16 + i * 8192, R, C); const int Rb = (R & ~31) + perm32(R & 31);
        voffA[i] = (unsigned)(R * K + C) * 2u; voffB[i] = (unsigned)(Rb * K + C) * 2u; }
    const size_t kstep = (size_t)(BK * 2);
    const size_t hstep = (size_t)HALF * K * 2;
    const size_t tstep = 2 * hstep;
    const unsigned ldsw = (unsigned)wid * 1024u;
    const int aoff = lds_byte(wr * 64 + fr, fq * 8), boff = lds_byte(wc * 32 + fr, fq * 8);
#define PG8_SA(b, h) (((b) * 2 + (h)) * HTB)
#define PG8_SB(b, h) ((4 + (b) * 2 + (h)) * HTB)
#define PG8_STAGE(bufoff, gbase, voff) do { _Pragma("unroll") for (int _i = 0; _i < 2; ++_i) \
        __builtin_amdgcn_global_load_lds((const unsigned*)((const char*)(gbase) + (voff)[_i]), (LAS unsigned*)(lds + (bufoff) + ldsw + _i * 8192), 16, 0, 0); } while (0)
#define PG8_LDA(dst, b, h) do { _Pragma("unroll") for (int m = 0; m < 4; ++m) _Pragma("unroll") for (int k = 0; k < 2; ++k) dst[m][k] = *(const LAS bf16x8*)(lds + PG8_SA(b, h) + aoff + m * 2048 + k * 1024); } while (0)
#define PG8_LDB(dst, b, h) do { _Pragma("unroll") for (int n = 0; n < 2; ++n) _Pragma("unroll") for (int k = 0; k < 2; ++k) dst[n][k] = *(const LAS bf16x8*)(lds + PG8_SB(b, h) + boff + n * 2048 + k * 1024); } while (0)
#define PG8_MMA(ai, bj, At, Bt) do { __builtin_amdgcn_s_setprio(1); _Pragma("unroll") for (int m = 0; m < 4; ++m) _Pragma("unroll") for (int n = 0; n < 2; ++n) _Pragma("unroll") for (int k = 0; k < 2; ++k) \
        acc[ai][bj][m][n] = __builtin_amdgcn_mfma_f32_16x16x32_bf16(Bt[n][k], At[m][k], acc[ai][bj][m][n], 0, 0, 0); __builtin_amdgcn_s_setprio(0); } while (0)
#define PG8_WAIT_V(n) asm volatile("s_waitcnt vmcnt(" #n ")" ::: "memory")
#define PG8_WAIT_L(n) asm volatile("s_waitcnt lgkmcnt(" #n ")" ::: "memory")
#define PG8_BAR __builtin_amdgcn_s_barrier()
#define PG8_SCHED __builtin_amdgcn_sched_barrier(0)
    Unit cur, nxt; int ui = 0;
    if (!S.next(0, cur)) return;
    f32x4 acc[2][2][4][2];
#pragma unroll
    for (int a = 0; a < 2; ++a)
#pragma unroll
        for (int b = 0; b < 2; ++b)
#pragma unroll
            for (int m = 0; m < 4; ++m)
#pragma unroll
                for (int n = 0; n < 2; ++n) acc[a][b][m][n] = (f32x4){0.f, 0.f, 0.f, 0.f};
    bf16x8 At[4][2], B0[2][2], B1[2][2];
    const char* cA = (const char*)g.A + (size_t)cur.pm * tstep; const char* cB = (const char*)g.Bt + cur.boff + (size_t)cur.pn * tstep;
    PG8_STAGE(PG8_SB(0, 0), cB, voffB); PG8_STAGE(PG8_SA(0, 0), cA, voffA); PG8_STAGE(PG8_SB(0, 1), cB + hstep, voffB); PG8_STAGE(PG8_SA(0, 1), cA + hstep, voffA);
    if (wr == 1) PG8_BAR;
    PG8_WAIT_V(4); PG8_BAR;
    PG8_STAGE(PG8_SB(1, 0), cB + kstep, voffB); PG8_STAGE(PG8_SA(1, 0), cA + kstep, voffA); PG8_STAGE(PG8_SB(1, 1), cB + hstep + kstep, voffB);
    PG8_WAIT_V(6); PG8_BAR;
    for (;;) {
        const bool has_next = S.next(ui + 1, nxt);
        const char* nA = has_next ? (const char*)g.A + (size_t)nxt.pm * tstep : cA; const char* nB = has_next ? (const char*)g.Bt + nxt.boff + (size_t)nxt.pn * tstep : cB;
        for (int t = 0; t < nt; t += 2) {
            const bool last = (t == nt - 2);
            const char* a1 = cA + (size_t)(t + 1) * kstep;
            const char* a2 = last ? nA : cA + (size_t)(t + 2) * kstep; const char* b2 = last ? nB : cB + (size_t)(t + 2) * kstep;
            const char* a3 = a2 + kstep; const char* b3 = b2 + kstep;
            PG8_LDB(B0, 0, 0); PG8_SCHED; PG8_LDA(At, 0, 0); PG8_STAGE(PG8_SA(1, 1), a1 + hstep, voffA);
            PG8_WAIT_L(8); PG8_BAR; PG8_WAIT_L(0); PG8_MMA(0, 0, At, B0); PG8_BAR; PG8_SCHED;
            PG8_LDB(B1, 0, 1); PG8_STAGE(PG8_SB(0, 0), b2, voffB);
            PG8_BAR; PG8_WAIT_L(0); PG8_MMA(0, 1, At, B1); PG8_BAR;
            PG8_LDA(At, 0, 1); PG8_STAGE(PG8_SA(0, 0), a2, voffA);
            PG8_BAR; PG8_WAIT_L(0); PG8_MMA(1, 0, At, B0); PG8_BAR; PG8_SCHED;
            PG8_STAGE(PG8_SB(0, 1), b2 + hstep, voffB);
            PG8_WAIT_V(6); PG8_BAR; PG8_MMA(1, 1, At, B1); PG8_BAR;
            PG8_LDB(B0, 1, 0); PG8_SCHED; PG8_LDA(At, 1, 0); PG8_STAGE(PG8_SA(0, 1), a2 + hstep, voffA);
            PG8_WAIT_L(8); PG8_BAR; PG8_WAIT_L(0); PG8_MMA(0, 0, At, B0); PG8_BAR; PG8_SCHED;
            PG8_LDB(B1, 1, 1); PG8_STAGE(PG8_SB(1, 0), b3, voffB);
            PG8_BAR; PG8_WAIT_L(0); PG8_MMA(0, 1, At, B1); PG8_BAR;
            PG8_LDA(At, 1, 1); PG8_STAGE(PG8_SA(1, 0), a3, voffA);
            PG8_BAR; PG8_WAIT_L(0); PG8_MMA(1, 0, At, B0); PG8_BAR; PG8_SCHED;
            PG8_STAGE(PG8_SB(1, 1), b3 + hstep, voffB);
            PG8_WAIT_V(6); PG8_BAR; PG8_MMA(1, 1, At, B1); PG8_BAR;
        }
        E(acc, cur, wr, wc, fr, fq);
        if (!has_next) break;
#pragma unroll
        for (int a = 0; a < 2; ++a)
#pragma unroll
            for (int b = 0; b < 2; ++b)
#pragma unroll
                for (int m = 0; m < 4; ++m)
#pragma unroll
                    for (int n = 0; n < 2; ++n) acc[a][b][m][n] = (f32x4){0.f, 0.f, 0.f, 0.f};
        cur = nxt; cA = nA; cB = nB; ++ui;
    }
    PG8_WAIT_V(0);
    if (wr == 0) PG8_BAR;
    PG8_BAR;
#undef PG8_SA
#undef PG8_SB
#undef PG8_STAGE
#undef PG8_LDA
#undef PG8_LDB
#undef PG8_MMA
#undef PG8_WAIT_V
#undef PG8_WAIT_L
#undef PG8_BAR
#undef PG8_SCHED
}
}

template <int L> __device__ __forceinline__ void phase_attn(ArgsP a, LAS unsigned char* lds, int gw, int ngw, int wave, int lane) {
    const bf16_t* QKV = (const bf16_t*)(a->ws + WS_QKV); bf16_t* ATT = (bf16_t*)(a->ws + WS_ATT);
    const float lambda_init = L == 0 ? 0.2f : 0.8f - 0.6f * 0.74081822068171786607f;
    for (int u = blockIdx.x; u < 512 + (L == 0 ? 32 : 0); u += gridDim.x) {
        int seq; size_t qrow, krow; int hq;
        if (u < 512) { const int grp = u & 7, idx = u >> 3, b = grp >> 1; hq = (grp & 1) * 4 + (idx & 3); seq = TPB; qrow = (size_t)b * TPB + (idx >> 2) * 256; krow = (size_t)b * TPB; }
        else { const int v = u - 512, b = v >> 3; hq = v & 7; seq = CTX; qrow = (size_t)b * TPB + SEQ; krow = qrow; }
        const int kvh = hq >> 2;
        att::attn_body<0>(QKV + qrow * INW + 1536 + hq * 128, QKV + krow * INW + 2560 + kvh * 128, QKV + krow * INW + 2816 + kvh * 128, ATT + qrow * D + 512 + hq * 128, seq, lds, 0.f, 0.f, nullptr);
    }
    float lam;
    { const int ln = threadIdx.x & 63; const float d1 = wave_sum(a->in[I_LQ1][L * 64 + ln] * a->in[I_LK1][L * 64 + ln]), d2 = wave_sum(a->in[I_LQ2][L * 64 + ln] * a->in[I_LK2][L * 64 + ln]); lam = __expf(d1) - __expf(d2) + lambda_init; lam = __int_as_float(__builtin_amdgcn_readfirstlane(__float_as_int(lam))); }
    for (int u = blockIdx.x; u < 512 + (L == 0 ? 64 : 0); u += gridDim.x) {
        int seq; size_t qrow, krow; int h;
        if (u < 512) { const int grp = u & 15, b = grp >> 2; h = grp & 3; seq = TPB; qrow = (size_t)b * TPB + (u >> 4) * 128; krow = (size_t)b * TPB; }
        else { const int v = u - 544; if (v < 0) continue; const int b = v >> 3; h = (v >> 1) & 3; seq = CTX; krow = (size_t)b * TPB + SEQ; qrow = krow + (v & 1) * 128; }
        att::attn_body<1>(QKV + qrow * INW + 3072 + h * 128, QKV + krow * INW + 3584 + h * 128, QKV + krow * INW + 4096 + h * 128, ATT + qrow * D + 1536 + h * 128, seq, lds, lam, 1.f - lambda_init, a->in[I_SUBLN] + L * 128);
    }
    __syncthreads();
    { const int tid2 = threadIdx.x, lane2 = tid2 & 63, wave2 = __builtin_amdgcn_readfirstlane(tid2 >> 6); phase_attn_na_naive<L>(a, lds, blockIdx.x * NWAVES + wave2, gridDim.x * NWAVES, wave2, lane2); }
}

template <int L> __device__ __forceinline__ void layer_program(LAS unsigned char* lds, const XcdBarrier& bar, int lo, int hi) {
    constexpr int P = 2 + 9 * L; const int G = gridDim.x, cid = blockIdx.x;
    const int tid = threadIdx.x, lane = tid & 63, wave = __builtin_amdgcn_readfirstlane(tid >> 6), gw = blockIdx.x * NWAVES + wave, ngw = gridDim.x * NWAVES;
#define IN(k) (lo <= (k) && (k) < hi)
#define SEAM(k) do { if (IN(k) && IN((k) + 1)) xcd_barrier(bar); } while (0)
    if (IN(P + 0)) { ArgsP a = get_args(); unsigned char* ws = a->ws;
        pg8::Gemm g{(const bf16_t*)(ws + WS_H), (const bf16_t*)(ws + WS_WIN) + (size_t)L * INW * D, D}; pg8::StaticOrder<false> S; S.init(NR / 256, INW / 256, G, cid);
        pg8::EpiBf16 E{(bf16_t*)(ws + WS_QKV), INW}; pg8::gemm_phase(lds, g, S, E); }
    SEAM(P + 0);
    if (IN(P + 1)) { ArgsP a = get_args(); phase_qkpost<L>(a, lds, gw, ngw, tid, lane); }
    SEAM(P + 1);
    if (IN(P + 2)) { ArgsP a = get_args(); phase_attn<L>(a, lds, gw, ngw, wave, lane); }
    SEAM(P + 2);
    if (IN(P + 3)) { ArgsP a = get_args(); unsigned char* ws = a->ws;
        pg8::Gemm g{(const bf16_t*)(ws + WS_ATT), (const bf16_t*)(ws + WS_WOUT) + (size_t)L * D * D, D}; pg8::EpiBf16 E{(bf16_t*)(ws + WS_O), D};
        if (L == 0) { pg8::StaticOrder<false> S; S.init(NR / 256, D / 256, G, cid); pg8::gemm_phase(lds, g, S, E); }
        else { pg8::StaticOrder<true> S; S.init(NTOK / 256, D / 256, G, cid); pg8::gemm_phase(lds, g, S, E); } }
    SEAM(P + 3);
    if (IN(P + 4)) { ArgsP a = get_args(); phase_row_mid<L>(a, lds, gw, ngw, tid, lane); }
    SEAM(P + 4);
    if (IN(P + 5)) { if (L == 1) { ArgsP a = get_args(); phase_moe_slots(a, lds, gw, ngw, tid, lane); } }
    if (L == 1) SEAM(P + 5);
    if (IN(P + 6)) { ArgsP a = get_args(); unsigned char* ws = a->ws;
        pg8::EpiSwiglu E{(bf16_t*)(ws + WS_ACT), DFF};
        if (L == 0) { pg8::Gemm g{(const bf16_t*)(ws + WS_H), (const bf16_t*)(ws + WS_W13), D}; pg8::StaticOrder<false> S; S.init(NR / 256, 2 * DFF / 256, G, cid); pg8::gemm_phase(lds, g, S, E); }
        else { LAS int* toff = moe_offsets(a, lds, tid); pg8::Gemm g{(const bf16_t*)(ws + WS_HG), (const bf16_t*)(ws + WS_MW13), D}; pg8::MoeOrder S; S.init(toff, 2 * DFF / 256, G, cid, (size_t)2 * DFF * D * 2); pg8::gemm_phase(lds, g, S, E); }
    }
    SEAM(P + 6);
    if (IN(P + 7)) { ArgsP a = get_args(); unsigned char* ws = a->ws;
        pg8::EpiBf16 E{(bf16_t*)(ws + WS_Y), D};
        if (L == 0) { pg8::Gemm g{(const bf16_t*)(ws + WS_ACT), (const bf16_t*)(ws + WS_W2), DFF}; pg8::StaticOrder<false> S; S.init(NR / 256, D / 256, G, cid); pg8::gemm_phase(lds, g, S, E); }
        else { LAS int* toff = moe_offsets(a, lds, tid); pg8::Gemm g{(const bf16_t*)(ws + WS_ACT), (const bf16_t*)(ws + WS_MW2), DFF}; pg8::MoeOrder S; S.init(toff, D / 256, G, cid, (size_t)D * DFF * 2); pg8::gemm_phase(lds, g, S, E); }
    }
    SEAM(P + 7);
    if (IN(P + 8)) { ArgsP a = get_args(); phase_row_end<L>(a, gw, ngw, lane); }
    if (L == 0) SEAM(P + 8);
#undef IN
#undef SEAM
}
constexpr int NPHASE = 20;

__global__ void __launch_bounds__(NTHREADS, 2) fwd_kernel(Args kargs_unused) {
    extern __shared__ __attribute__((aligned(16))) unsigned char lds_raw[];
    LAS unsigned char* lds = (LAS unsigned char*)lds_raw;
    volatile LAS unsigned* xbw = (volatile LAS unsigned*)(lds + LDS_BYTES - 16);
    if (threadIdx.x < 4) xbw[threadIdx.x] = 0u;
    __syncthreads();
    int lo, hi; XcdBarrier bar;
    { ArgsP a = get_args(); lo = a->lo; hi = a->hi; bar.bar = (unsigned*)(a->ws + WS_CTL) + CW_BAR; bar.x = 0; bar.st = xbw;
      if (hi - lo > 1) bar = xcd_barrier_post((unsigned*)(a->ws + WS_CTL) + CW_BAR, xbw); }
#define IN(k) (lo <= (k) && (k) < hi)
    { const int tid = threadIdx.x, lane = tid & 63, wave = __builtin_amdgcn_readfirstlane(tid >> 6), gw = blockIdx.x * NWAVES + wave, ngw = gridDim.x * NWAVES;
      if (IN(0)) { ArgsP a = get_args(); phase_adaln(a, lds, tid, wave, lane); phase_convert(a, lds, gw, ngw, wave, lane); }
      if (IN(0) && IN(1)) xcd_barrier(bar);
      if (IN(1)) { ArgsP a = get_args(); phase_row_entry(a, gw, ngw, lane); }
      if (IN(1) && IN(2)) xcd_barrier(bar); }
#undef IN
    layer_program<0>(lds, bar, lo, hi);
    layer_program<1>(lds, bar, lo, hi);
}

#ifndef MK_PER_PHASE
#define MK_PER_PHASE 0
#endif
extern "C" void kernel_launch(void* const* d_in, const int* in_sizes, int n_in, void* d_out, int out_size, void* d_ws, size_t ws_size, hipStream_t stream) {
    static int grid = 0;
    if (grid == 0) {
        if (n_in != 27 || out_size != NB * SEQ * D || ws_size < WS_END) { fprintf(stderr, "kernel_launch: unexpected shapes: n_in %d out %d ws %zu (need %zu)\n", n_in, out_size, ws_size, (size_t)WS_END); grid = -1; return; }
        int dev = 0, cus = 0, per_cu = 0;
        if (hipGetDevice(&dev) != hipSuccess || hipDeviceGetAttribute(&cus, hipDeviceAttributeMultiprocessorCount, dev) != hipSuccess) { grid = -1; return; }
        if (hipFuncSetAttribute((const void*)fwd_kernel, hipFuncAttributeMaxDynamicSharedMemorySize, LDS_BYTES) != hipSuccess) { fprintf(stderr, "kernel_launch: hipFuncSetAttribute failed\n"); grid = -1; return; }
        if (hipOccupancyMaxActiveBlocksPerMultiprocessor(&per_cu, (const void*)fwd_kernel, NTHREADS, LDS_BYTES) != hipSuccess || per_cu < 1) fprintf(stderr, "kernel_launch: occupancy query says %d\n", per_cu);
        (void)hipGetLastError();
        grid = cus;
    }
    if (grid < 0) return;
    (void)hipMemsetAsync((char*)d_ws + WS_CTL, 0, CTL_ZERO_BYTES, stream);
    Args a{};
    for (int i = 0; i < 27; ++i) a.in[i] = (const float*)d_in[i];
    a.out = (float*)d_out; a.ws = (unsigned char*)d_ws;
#if MK_PER_PHASE
    for (int p = 0; p < NPHASE; ++p) { if (p == 7) continue; a.lo = p; a.hi = p + 1; hipLaunchKernelGGL(fwd_kernel, dim3(grid), dim3(NTHREADS), LDS_BYTES, stream, a); }
#else
    a.lo = 0; a.hi = NPHASE; hipLaunchKernelGGL(fwd_kernel, dim3(grid), dim3(NTHREADS), LDS_BYTES, stream, a);
#endif
}
```

```cpp
#include <hip/hip_runtime.h>
#include <stdint.h>
#include <stdio.h>

#define GAS __attribute__((address_space(1)))
#define LAS __attribute__((address_space(3)))
typedef unsigned short bf16_t;
typedef short bf16x8 __attribute__((ext_vector_type(8)));
typedef float f32x4 __attribute__((ext_vector_type(4)));
typedef float f32x2 __attribute__((ext_vector_type(2)));
typedef unsigned u32x4 __attribute__((ext_vector_type(4)));
typedef unsigned u32x2 __attribute__((ext_vector_type(2)));

#ifndef PROBE_DUP
#define PROBE_DUP 0
#endif
#define DUP(bit) for (int _rep = 0; _rep < (((PROBE_DUP) >> (bit)) & 1) + 1; ++_rep)
constexpr int D = 2048, NB = 4, SEQ = 4096, CTX = 256, TPB = SEQ + CTX, NR = NB * TPB;
constexpr int INW = 4608, DFF = 5632, NE = 8, MODW = 6 * D, NTOK = NB * SEQ;
constexpr int MAXSLOT = 34816;
constexpr float EPS = 1e-6f;
constexpr int NWAVES = 8, NTHREADS = 512;
constexpr int LDS_BYTES = 147456;

constexpr size_t MiB = 1u << 20;
constexpr size_t WS_CTL = 0, CTL_ZERO_BYTES = 1 * MiB;
constexpr size_t WS_MOD = 1 * MiB;
constexpr size_t WS_TOPK = 2 * MiB;
constexpr size_t WS_SLOT = WS_TOPK + 512 * 1024;
constexpr size_t WS_WIN = 4 * MiB;
constexpr size_t WS_WOUT = 40 * MiB;
constexpr size_t WS_W13 = 56 * MiB;
constexpr size_t WS_W2 = 100 * MiB;
constexpr size_t WS_MW13 = 122 * MiB;
constexpr size_t WS_MW2 = 474 * MiB;
constexpr size_t WS_X = 650 * MiB;
constexpr size_t WS_H = 786 * MiB;
constexpr size_t WS_Y = 854 * MiB;
constexpr size_t WS_HG = WS_Y;
constexpr size_t WS_R1 = 990 * MiB;
constexpr size_t WS_QKV = WS_R1, WS_VT = WS_R1 + 153 * MiB, WS_ATT = WS_R1 + 170 * MiB, WS_O = WS_R1 + 238 * MiB, WS_ACT = WS_R1;
constexpr size_t WS_END = WS_R1 + (size_t)MAXSLOT * DFF * 2;
static_assert((size_t)NR * INW * 2 <= 153 * MiB && (size_t)16 * 128 * TPB * 2 <= 17 * MiB && (size_t)NR * D * 2 <= 68 * MiB, "R1 map");
constexpr int CW_BAR = 4096;
constexpr int CW_CNT = 16384;
constexpr int CW_CUR = 16384 + 64;

__device__ __forceinline__ unsigned cvt_pk_bf16(float lo, float hi) { unsigned r; asm("v_cvt_pk_bf16_f32 %0, %1, %2" : "=v"(r) : "v"(lo), "v"(hi)); return r; }
__device__ __forceinline__ float bf_lo(unsigned w) { return __uint_as_float(w << 16); }
__device__ __forceinline__ float bf_hi(unsigned w) { return __uint_as_float(w & 0xffff0000u); }
__device__ __forceinline__ float bf2f(bf16_t b) { return __uint_as_float(((unsigned)b) << 16); }
__device__ __forceinline__ bf16_t f2bf(float f) { return (bf16_t)(cvt_pk_bf16(f, 0.f) & 0xffffu); }
__device__ __forceinline__ float wave_sum(float v) {
#pragma unroll
    for (int o = 1; o < 64; o <<= 1) v += __shfl_xor(v, o);
    return v;
}
__device__ __forceinline__ float wave_max(float v) {
#pragma unroll
    for (int o = 1; o < 64; o <<= 1) v = fmaxf(v, __shfl_xor(v, o));
    return v;
}
#define LDS_WAIT() asm volatile("s_waitcnt lgkmcnt(0)" ::: "memory")
__device__ __forceinline__ unsigned pk4_fp8(float a, float b, float c, float d) {
    a = fminf(fmaxf(a, -448.f), 448.f); b = fminf(fmaxf(b, -448.f), 448.f); c = fminf(fmaxf(c, -448.f), 448.f); d = fminf(fmaxf(d, -448.f), 448.f);
    int w = 0; w = __builtin_amdgcn_cvt_pk_fp8_f32(a, b, w, false); w = __builtin_amdgcn_cvt_pk_fp8_f32(c, d, w, true); return (unsigned)w; }
constexpr float F8_SW = 64.f, F8_SH = 16.f, F8_SA = 8.f;

#define XB_TMO      128
#define XB_XCNT(j)  (256  + 64 * (j))
#define XB_XSUB(j)  (1280 + 64 * (j))
#define XB_XGEN(j)  (2304 + 64 * (j))
#define XB_TOP      3328
#define XB_TOPGEN   3392
#define XCD_BAR_WORDS 3456
#define XB_SPIN_CAP (1u << 18)
__device__ __forceinline__ unsigned xb_ld(unsigned* p)              { return __hip_atomic_load(p, __ATOMIC_RELAXED, __HIP_MEMORY_SCOPE_AGENT); }
__device__ __forceinline__ unsigned xb_add(unsigned* p, unsigned v) { return __hip_atomic_fetch_add(p, v, __ATOMIC_RELAXED, __HIP_MEMORY_SCOPE_AGENT); }
__device__ __forceinline__ unsigned xb_xcc_id() { return (unsigned)__builtin_amdgcn_s_getreg((3 << 11) | 20) & 0xFu; }
#define XB_SPIN(cond, bar) do { unsigned _sp = 0; while (cond) { __builtin_amdgcn_s_sleep(1); \
    if ((++_sp & 255u) == 0u) { if (xb_ld(&(bar)[XB_TMO])) break; if (_sp > XB_SPIN_CAP) { atomicAdd(&(bar)[XB_TMO], 1u); break; } } } } while (0)
struct XcdBarrier { unsigned* bar; unsigned x; volatile LAS unsigned* st; };
__device__ __forceinline__ XcdBarrier xcd_barrier_post(unsigned* bar, volatile LAS unsigned* st) {
    XcdBarrier b; b.bar = bar; b.x = xb_xcc_id(); b.st = st;
    if (threadIdx.x == 0) (void)xb_add(&bar[XB_XCNT(b.x)], 1u);
    return b;
}
__device__ __forceinline__ void xcd_barrier_complete(unsigned* bar, unsigned x, unsigned& nloc, unsigned& nx) {
    const unsigned G = gridDim.x * gridDim.y * gridDim.z;
    unsigned sum, cnt, mine, sp = 0u;
    for (;;) {
        sum = 0u; cnt = 0u; mine = 0u;
#pragma unroll
        for (unsigned j = 0; j < 16; ++j) { const unsigned c = xb_ld(&bar[XB_XCNT(j)]); sum += c; cnt += (c > 0u) ? 1u : 0u; mine = (j == x) ? c : mine; }
        if (sum == G) break;
        __builtin_amdgcn_s_sleep(1);
        if ((++sp & 255u) == 0u) { if (xb_ld(&bar[XB_TMO])) break; if (sp > XB_SPIN_CAP) { atomicAdd(&bar[XB_TMO], 1u); break; } }
    }
    nloc = mine > 0u ? mine : 1u; nx = cnt > 0u ? cnt : 1u;
}
__device__ __forceinline__ void xcd_barrier(const XcdBarrier& b) {
    asm volatile("s_waitcnt vmcnt(0)" ::: "memory");
    __syncthreads();
    if (threadIdx.x == 0) {
        unsigned* bar = b.bar;
        __builtin_amdgcn_s_waitcnt(0);
        unsigned nloc = b.st[0], nx = b.st[1];
        if (nloc == 0u) { xcd_barrier_complete(bar, b.x, nloc, nx); b.st[0] = nloc; b.st[1] = nx; }
        const unsigned old = xb_add(&bar[XB_XSUB(b.x)], 1u);
        const unsigned gen = old / nloc;
        if (old + 1u == (gen + 1u) * nloc) {
            __builtin_amdgcn_fence(__ATOMIC_RELEASE, "agent");
            asm volatile("s_waitcnt vmcnt(0)" ::: "memory");
            const unsigned og = xb_add(&bar[XB_TOP], 1u);
            const unsigned tg = og / nx;
            if (og + 1u == (tg + 1u) * nx) xb_add(&bar[XB_TOPGEN], 1u);
            else XB_SPIN(xb_ld(&bar[XB_TOPGEN]) == tg, bar);
            __builtin_amdgcn_fence(__ATOMIC_ACQUIRE, "agent");
            xb_add(&bar[XB_XGEN(b.x)], 1u);
            asm volatile("s_waitcnt vmcnt(0)" ::: "memory");
        } else {
            XB_SPIN(xb_ld(&bar[XB_XGEN(b.x)]) == gen, bar);
            __builtin_amdgcn_fence(__ATOMIC_ACQUIRE, "agent");
            asm volatile("s_waitcnt vmcnt(0)" ::: "memory");
        }
    }
    __syncthreads();
}

struct Args { const float* in[27]; float* out; unsigned char* ws; int lo, hi; };
typedef const __attribute__((address_space(4))) Args* ArgsP;
__device__ __forceinline__ ArgsP get_args() { ArgsP p = (ArgsP)__builtin_amdgcn_kernarg_segment_ptr(); asm volatile("" : "+s"(p)); return p; }
enum { I_X = 0, I_C, I_CTX, I_CCTX, I_WMOD, I_BMOD, I_GMIXPRE, I_GMIXPOST, I_GFFNPRE, I_GFFNPOST, I_WIN, I_WOUT, I_RPB, I_QNORM, I_KNORM,
       I_LQ1, I_LK1, I_LQ2, I_LK2, I_SUBLN, I_FW1, I_FW3, I_FW2, I_ROUTER, I_MW1, I_MW3, I_MW2 };

__device__ __forceinline__ void transpose_item(const float* W, int K, int N, bf16_t* WT, int item, int mode, LAS float* scr, int lane) {
    const int nblk = N / 32, kb = item / nblk, nb = item % nblk, k0 = 64 * kb, n0 = 32 * nb;
#pragma unroll 8
    for (int i = 0; i < 32; ++i) { const int kk = 2 * i + (lane >> 5); scr[kk * 33 + (lane & 31)] = W[(size_t)(k0 + kk) * N + n0 + (lane & 31)]; }
    LDS_WAIT(); asm volatile("" ::: "memory");
    const int c = lane & 7;
    const int drow0 = mode == 0 ? n0 : (256 * (n0 >> 7) + (n0 & 127) + (mode == 2 ? 128 : 0));
#pragma unroll
    for (int j = 0; j < 4; ++j) { const int n = (lane >> 3) + 8 * j; const LAS float* s = scr + (8 * c) * 33 + n;
        u32x4 o; o.x = cvt_pk_bf16(s[0 * 33], s[1 * 33]); o.y = cvt_pk_bf16(s[2 * 33], s[3 * 33]); o.z = cvt_pk_bf16(s[4 * 33], s[5 * 33]); o.w = cvt_pk_bf16(s[6 * 33], s[7 * 33]);
        *(u32x4*)(WT + (size_t)(drow0 + n) * K + k0 + 8 * c) = o; }
    LDS_WAIT(); asm volatile("" ::: "memory");
}
__device__ __forceinline__ void transpose_item_f8(const float* W, int K, int N, unsigned char* WT, int item, int mode, LAS float* scr, int lane) {
    const int nblk = N / 32, kb = item / nblk, nb = item % nblk, k0 = 64 * kb, n0 = 32 * nb;
#pragma unroll 8
    for (int i = 0; i < 32; ++i) { const int kk = 2 * i + (lane >> 5); scr[kk * 33 + (lane & 31)] = W[(size_t)(k0 + kk) * N + n0 + (lane & 31)]; }
    LDS_WAIT(); asm volatile("" ::: "memory");
    const int c = lane & 7;
    const int drow0 = mode == 0 ? n0 : (256 * (n0 >> 7) + (n0 & 127) + (mode == 2 ? 128 : 0));
#pragma unroll
    for (int j = 0; j < 4; ++j) { const int n = (lane >> 3) + 8 * j; const LAS float* s = scr + (8 * c) * 33 + n;
        u32x2 o; o.x = pk4_fp8(s[0 * 33] * F8_SW, s[1 * 33] * F8_SW, s[2 * 33] * F8_SW, s[3 * 33] * F8_SW); o.y = pk4_fp8(s[4 * 33] * F8_SW, s[5 * 33] * F8_SW, s[6 * 33] * F8_SW, s[7 * 33] * F8_SW);
        *(u32x2*)(WT + (size_t)(drow0 + n) * K + k0 + 8 * c) = o; }
    LDS_WAIT(); asm volatile("" ::: "memory");
}
__device__ __forceinline__ void phase_convert(ArgsP a, LAS unsigned char* lds, int gw, int ngw, int wave, int lane) {
    LAS float* scr = (LAS float*)(lds + wave * 16384);
    unsigned char* ws = a->ws;
    constexpr int I_IN = 32 * 144, I_OUT = 32 * 64, I_F = 5632;
    constexpr int NITEMS = 2 * I_IN + 2 * I_OUT + 27 * I_F;
    for (int it = gw; it < NITEMS; it += ngw) {
        int r = it;
        if (r < 2 * I_IN) { const int l = r / I_IN; transpose_item(a->in[I_WIN] + (size_t)l * D * INW, D, INW, (bf16_t*)(ws + WS_WIN) + (size_t)l * INW * D, r % I_IN, 0, scr, lane); continue; }
        r -= 2 * I_IN;
        if (r < 2 * I_OUT) { const int l = r / I_OUT; transpose_item(a->in[I_WOUT] + (size_t)l * D * D, D, D, (bf16_t*)(ws + WS_WOUT) + (size_t)l * D * D, r % I_OUT, 0, scr, lane); continue; }
        r -= 2 * I_OUT;
        const int m = r / I_F, q = r % I_F;
        if (m == 0) transpose_item(a->in[I_FW1], D, DFF, (bf16_t*)(ws + WS_W13), q, 1, scr, lane);
        else if (m == 1) transpose_item(a->in[I_FW3], D, DFF, (bf16_t*)(ws + WS_W13), q, 2, scr, lane);
        else if (m == 2) transpose_item(a->in[I_FW2], DFF, D, (bf16_t*)(ws + WS_W2), q, 0, scr, lane);
        else if (m < 11) { const int e = m - 3; transpose_item_f8(a->in[I_MW1] + (size_t)e * D * DFF, D, DFF, ws + WS_MW13 + (size_t)e * 2 * DFF * D, q, 1, scr, lane); }
        else if (m < 19) { const int e = m - 11; transpose_item_f8(a->in[I_MW3] + (size_t)e * D * DFF, D, DFF, ws + WS_MW13 + (size_t)e * 2 * DFF * D, q, 2, scr, lane); }
        else { const int e = m - 19; transpose_item_f8(a->in[I_MW2] + (size_t)e * DFF * D, DFF, D, ws + WS_MW2 + (size_t)e * D * DFF, q, 0, scr, lane); }
    }
}
__device__ __forceinline__ void phase_adaln(ArgsP a, LAS unsigned char* lds, int tid, int wave, int lane) {
    LAS float* sc = (LAS float*)lds;
    LAS float* red = (LAS float*)(lds + 5 * 2048 * 4);
    float* MOD = (float*)(a->ws + WS_MOD);
    for (int task = blockIdx.x; task < 192; task += gridDim.x) {
        const int l = task / 96, j0 = (task % 96) * 128;
        for (int i = tid; i < 5 * 2048; i += NTHREADS) { const int v = i >> 11, k = i & 2047; const float c = v < 4 ? a->in[I_C][v * D + k] : a->in[I_CCTX][k]; sc[i] = c / (1.f + __expf(-c)); }
        __syncthreads();
        float acc[5][2];
#pragma unroll
        for (int v = 0; v < 5; ++v) { acc[v][0] = 0.f; acc[v][1] = 0.f; }
        const float* wp = a->in[I_WMOD] + ((size_t)l * D + wave * 256) * MODW + j0 + 2 * lane;
        for (int k = 0; k < 256; ++k) { const f32x2 w = *(const f32x2*)(wp + (size_t)k * MODW);
#pragma unroll
            for (int v = 0; v < 5; ++v) { const float s = sc[v * 2048 + wave * 256 + k]; acc[v][0] += s * w.x; acc[v][1] += s * w.y; } }
#pragma unroll
        for (int v = 0; v < 5; ++v) { red[(wave * 5 + v) * 128 + 2 * lane] = acc[v][0]; red[(wave * 5 + v) * 128 + 2 * lane + 1] = acc[v][1]; }
        __syncthreads();
        for (int i = tid; i < 640; i += NTHREADS) { const int v = i >> 7, j = i & 127; float s = a->in[I_BMOD][l * MODW + j0 + j];
#pragma unroll
            for (int w = 0; w < 8; ++w) s += red[(w * 5 + v) * 128 + j];
            MOD[(size_t)(l * 5 + v) * MODW + j0 + j] = s; }
        __syncthreads();
    }
}

__device__ __forceinline__ void ld_row_f32(const float* p, int lane, f32x4 (&v)[8]) {
#pragma unroll
    for (int j = 0; j < 8; ++j) v[j] = *(const f32x4*)(p + 4 * lane + 256 * j);
}
__device__ __forceinline__ void ld_row_bf16(const bf16_t* p, int lane, f32x4 (&v)[8]) {
#pragma unroll
    for (int j = 0; j < 8; ++j) { const u32x2 w = *(const u32x2*)(p + 4 * lane + 256 * j); v[j] = (f32x4){bf_lo(w.x), bf_hi(w.x), bf_lo(w.y), bf_hi(w.y)}; }
}
__device__ __forceinline__ void st_row_f32(float* p, int lane, const f32x4 (&v)[8]) {
#pragma unroll
    for (int j = 0; j < 8; ++j) *(f32x4*)(p + 4 * lane + 256 * j) = v[j];
}
__device__ __forceinline__ void st_row_bf16(bf16_t* p, int lane, const f32x4 (&v)[8]) {
#pragma unroll
    for (int j = 0; j < 8; ++j) { u32x2 w; w.x = cvt_pk_bf16(v[j].x, v[j].y); w.y = cvt_pk_bf16(v[j].z, v[j].w); *(u32x2*)(p + 4 * lane + 256 * j) = w; }
}
__device__ __forceinline__ float row_rstd(const f32x4 (&v)[8]) {
    float s = 0.f;
#pragma unroll
    for (int j = 0; j < 8; ++j) s += (v[j].x * v[j].x + v[j].y * v[j].y) + (v[j].z * v[j].z + v[j].w * v[j].w);
    return rsqrtf(wave_sum(s) * (1.f / D) + EPS);
}
__device__ __forceinline__ void norm_mod_store(const f32x4 (&x)[8], const float* g, const float* sh, const float* sc, bf16_t* hrow, int lane, f32x4 (&h)[8]) {
    const float r = row_rstd(x);
#pragma unroll
    for (int j = 0; j < 8; ++j) { const int c = 4 * lane + 256 * j; const f32x4 gv = *(const f32x4*)(g + c), sv = *(const f32x4*)(sc + c), hv = *(const f32x4*)(sh + c);
        h[j] = (x[j] * r * gv) * (sv + 1.f) + hv; }
    st_row_bf16(hrow, lane, h);
}
__device__ __forceinline__ void phase_row_entry(ArgsP a, int gw, int ngw, int lane) {
    float* X = (float*)(a->ws + WS_X); bf16_t* H = (bf16_t*)(a->ws + WS_H); const float* MOD = (const float*)(a->ws + WS_MOD);
    for (int row = gw; row < NR; row += ngw) {
        const int b = row / TPB, t = row % TPB; const bool lat = t < SEQ; const int v = lat ? b : 4;
        const float* src = lat ? a->in[I_X] + ((size_t)b * SEQ + t) * D : a->in[I_CTX] + ((size_t)b * CTX + (t - SEQ)) * D;
        f32x4 x[8], h[8]; ld_row_f32(src, lane, x); st_row_f32(X + (size_t)row * D, lane, x);
        const float* mv = MOD + (size_t)(0 * 5 + v) * MODW;
        norm_mod_store(x, a->in[I_GMIXPRE], mv + 0 * D, mv + 1 * D, H + (size_t)row * D, lane, h);
    }
}
template <int L> __device__ __forceinline__ void phase_row_mid(ArgsP a, LAS unsigned char* lds, int gw, int ngw, int tid, int lane) {
    float* X = (float*)(a->ws + WS_X); bf16_t* H = (bf16_t*)(a->ws + WS_H); const float* MOD = (const float*)(a->ws + WS_MOD); const bf16_t* O = (const bf16_t*)(a->ws + WS_O);
    LAS unsigned* lcnt = (LAS unsigned*)(lds + 131072 + 64);
    if (L == 1) { if (tid < 8) lcnt[tid] = 0u; __syncthreads(); }
    for (int row = gw; row < NR; row += ngw) {
        const int b = row / TPB, t = row % TPB; const bool lat = t < SEQ; const int v = lat ? b : 4;
        if (L == 1 && !lat) continue;
        const float* mv = MOD + (size_t)(L * 5 + v) * MODW;
        f32x4 o[8], x[8], h[8]; ld_row_bf16(O + (size_t)row * D, lane, o); ld_row_f32(X + (size_t)row * D, lane, x);
        const float r1 = row_rstd(o);
#pragma unroll
        for (int j = 0; j < 8; ++j) { const int c = 4 * lane + 256 * j; const f32x4 gv = *(const f32x4*)(a->in[I_GMIXPOST] + L * D + c), gt = *(const f32x4*)(mv + 2 * D + c);
            x[j] = x[j] + gt * (o[j] * r1 * gv); }
        st_row_f32(X + (size_t)row * D, lane, x);
        norm_mod_store(x, a->in[I_GFFNPRE] + L * D, mv + 3 * D, mv + 4 * D, H + (size_t)row * D, lane, h);
        if (L == 1) {
            float lg[8];
#pragma unroll
            for (int e = 0; e < 8; ++e) lg[e] = 0.f;
#pragma unroll
            for (int j = 0; j < 8; ++j) { const float* rp = a->in[I_ROUTER] + (size_t)(4 * lane + 256 * j) * NE;
#pragma unroll
                for (int q = 0; q < 4; ++q) { const f32x4 r0 = *(const f32x4*)(rp + q * 8), r1v = *(const f32x4*)(rp + q * 8 + 4); const float hv = h[j][q];
                    lg[0] += hv * r0.x; lg[1] += hv * r0.y; lg[2] += hv * r0.z; lg[3] += hv * r0.w; lg[4] += hv * r1v.x; lg[5] += hv * r1v.y; lg[6] += hv * r1v.z; lg[7] += hv * r1v.w; } }
#pragma unroll
            for (int e = 0; e < 8; ++e) lg[e] = wave_sum(lg[e]);
            int i1 = 0; float v1 = lg[0];
#pragma unroll
            for (int e = 1; e < 8; ++e) if (lg[e] > v1) { v1 = lg[e]; i1 = e; }
            int i2 = -1; float v2 = -3.0e38f;
#pragma unroll
            for (int e = 0; e < 8; ++e) if (e != i1 && lg[e] > v2) { v2 = lg[e]; i2 = e; }
            const float e2 = __expf(v2 - v1), g1 = 1.f / (1.f + e2), g2 = e2 / (1.f + e2);
            if (lane == 0) { const int tok = b * SEQ + t; int* tk = (int*)(a->ws + WS_TOPK) + (size_t)tok * 4; tk[0] = i1; tk[1] = i2; ((float*)tk)[2] = g1; ((float*)tk)[3] = g2;
                atomicAdd((unsigned*)&lcnt[i1], 1u); atomicAdd((unsigned*)&lcnt[i2], 1u); }
        }
    }
    if (L == 1) { __syncthreads(); if (tid < 8) { const unsigned c = lcnt[tid]; if (c) __hip_atomic_fetch_add((unsigned*)(a->ws + WS_CTL) + CW_CNT + tid, c, __ATOMIC_RELAXED, __HIP_MEMORY_SCOPE_AGENT); } __syncthreads(); }
}
constexpr int LDS_CTL_OFF = 131072;
__device__ __forceinline__ LAS int* moe_offsets(ArgsP a, LAS unsigned char* lds, int tid) {
    LAS int* toff = (LAS int*)(lds + LDS_CTL_OFF);
    __syncthreads();
    if (tid == 0) { int acc = 0;
        for (int e = 0; e < 8; ++e) { toff[e] = acc; const unsigned c = __hip_atomic_load((unsigned*)(a->ws + WS_CTL) + CW_CNT + e, __ATOMIC_RELAXED, __HIP_MEMORY_SCOPE_AGENT); acc += (int)((c + 255u) >> 8); }
        toff[8] = acc; }
    __syncthreads();
    return toff;
}
__device__ __forceinline__ void phase_moe_slots(ArgsP a, LAS unsigned char* lds, int gw, int ngw, int tid, int lane) {
    LAS int* toff = moe_offsets(a, lds, tid);
    unsigned* ctl = (unsigned*)(a->ws + WS_CTL); int* SLOT = (int*)(a->ws + WS_SLOT); const int* TOPK = (const int*)(a->ws + WS_TOPK);
    const bf16_t* H = (const bf16_t*)(a->ws + WS_H); unsigned char* HG = a->ws + WS_HG;
    for (int grp = gw; grp < NTOK / 8; grp += ngw) {
        const bool act = lane < 8; const int tok = grp * 8 + (lane & 7), b = tok / SEQ, t = tok % SEQ, row = b * TPB + t;
        const int e1 = act ? TOPK[tok * 4] : -1, e2 = act ? TOPK[tok * 4 + 1] : -1; int s0 = 0, s1 = 0;
#pragma unroll
        for (int e = 0; e < 8; ++e) { const bool sel = (e1 == e) || (e2 == e); const unsigned long long m = __ballot(sel); const int n = __popcll(m);
            unsigned base = 0; if (lane == 0 && n) base = __hip_atomic_fetch_add(ctl + CW_CUR + e, (unsigned)n, __ATOMIC_RELAXED, __HIP_MEMORY_SCOPE_AGENT);
            base = __shfl(base, 0);
            const int slot = toff[e] * 256 + (int)base + __popcll(m & ((1ull << lane) - 1ull));
            if (e1 == e) s0 = slot; if (e2 == e) s1 = slot; }
        if (act) { SLOT[tok * 2] = s0; SLOT[tok * 2 + 1] = s1; }
#pragma unroll 2
        for (int i = 0; i < 8; ++i) { const int r = __shfl(row, i), d0 = __shfl(s0, i), d1 = __shfl(s1, i);
            const u32x4* sp = (const u32x4*)(H + (size_t)r * D) + lane; u32x2* p0 = (u32x2*)(HG + (size_t)d0 * D) + lane; u32x2* p1 = (u32x2*)(HG + (size_t)d1 * D) + lane;
#pragma unroll
            for (int j = 0; j < 4; ++j) { const u32x4 w = sp[64 * j]; u32x2 o;
                o.x = pk4_fp8(bf_lo(w.x) * F8_SH, bf_hi(w.x) * F8_SH, bf_lo(w.y) * F8_SH, bf_hi(w.y) * F8_SH); o.y = pk4_fp8(bf_lo(w.z) * F8_SH, bf_hi(w.z) * F8_SH, bf_lo(w.w) * F8_SH, bf_hi(w.w) * F8_SH);
                p0[64 * j] = o; p1[64 * j] = o; } }
    }
    __syncthreads();
}
template <int L> __device__ __forceinline__ void phase_row_end(ArgsP a, int gw, int ngw, int lane) {
    float* X = (float*)(a->ws + WS_X); bf16_t* H = (bf16_t*)(a->ws + WS_H); const float* MOD = (const float*)(a->ws + WS_MOD); const bf16_t* Y = (const bf16_t*)(a->ws + WS_Y);
    for (int row = gw; row < NR; row += ngw) {
        const int b = row / TPB, t = row % TPB; const bool lat = t < SEQ; const int v = lat ? b : 4;
        if (L == 1 && !lat) continue;
        const float* mv = MOD + (size_t)(L * 5 + v) * MODW;
        f32x4 y[8], x[8], h[8];
        if (L == 0) ld_row_bf16(Y + (size_t)row * D, lane, y);
        else { const int tok = b * SEQ + t; const int* sl = (const int*)(a->ws + WS_SLOT) + tok * 2; const float* tk = (const float*)(a->ws + WS_TOPK) + (size_t)tok * 4; const float g1 = tk[2], g2 = tk[3];
            f32x4 y2[8]; ld_row_bf16(Y + (size_t)sl[0] * D, lane, y); ld_row_bf16(Y + (size_t)sl[1] * D, lane, y2);
#pragma unroll
            for (int j = 0; j < 8; ++j) y[j] = y[j] * g1 + y2[j] * g2; }
        ld_row_f32(X + (size_t)row * D, lane, x);
        const float r1 = row_rstd(y);
#pragma unroll
        for (int j = 0; j < 8; ++j) { const int c = 4 * lane + 256 * j; const f32x4 gv = *(const f32x4*)(a->in[I_GFFNPOST] + L * D + c), gt = *(const f32x4*)(mv + 5 * D + c);
            x[j] = x[j] + gt * (y[j] * r1 * gv); }
        if (L == 0) { st_row_f32(X + (size_t)row * D, lane, x); const float* mn = MOD + (size_t)(1 * 5 + v) * MODW;
            norm_mod_store(x, a->in[I_GMIXPRE] + D, mn + 0 * D, mn + 1 * D, H + (size_t)row * D, lane, h); }
        else st_row_f32(a->out + ((size_t)b * SEQ + t) * D, lane, x);
    }
}

template <int L> __device__ __forceinline__ void phase_qkpost(ArgsP a, LAS unsigned char* lds, int gw, int ngw, int tid, int lane) {
    bf16_t* QKV = (bf16_t*)(a->ws + WS_QKV);
    const float L2T = 13.287712379549449f;
    const float fg = exp2f(-(float)(lane & 31) * (1.f / 32.f) * L2T), fd = exp2f(-(float)(lane & 15) * (1.f / 16.f) * L2T);
    const float qn0 = a->in[I_QNORM][L * 128 + lane], qn1 = a->in[I_QNORM][L * 128 + 64 + lane], kn0 = a->in[I_KNORM][L * 128 + lane], kn1 = a->in[I_KNORM][L * 128 + 64 + lane];
    for (int row = gw; row < NR; row += ngw) {
        const int t = row % TPB; const bool lat = t < SEQ; const int gr = t >> 6, gc = t & 63;
        bf16_t* q = QKV + (size_t)row * INW;
        float cr, sr, cc, sc2, cd, sd;
        sincosf((float)gr * fg, &sr, &cr); sincosf((float)gc * fg, &sc2, &cc); sincosf((float)(lane < 32 ? gr : gc) * fd, &sd, &cd);
#pragma unroll 2
        for (int hd = 0; hd < 10; ++hd) {
            const int base = hd < 8 ? 1536 + hd * 128 : 2560 + (hd - 8) * 128;
            float e0 = bf2f(q[base + lane]), e1 = bf2f(q[base + 64 + lane]);
            const float r = rsqrtf(wave_sum(e0 * e0 + e1 * e1) * (1.f / 128.f) + EPS);
            e0 = e0 * r * (hd < 8 ? qn0 : kn0); e1 = e1 * r * (hd < 8 ? qn1 : kn1);
            if (lat) { const float p0 = __shfl_xor(e0, 32), p1 = __shfl_xor(e1, 32);
                if (lane < 32) { e0 = e0 * cr - p0 * sr; e1 = e1 * cc - p1 * sc2; } else { e0 = e0 * cr + p0 * sr; e1 = e1 * cc + p1 * sc2; } }
            q[base + lane] = f2bf(e0); q[base + 64 + lane] = f2bf(e1);
        }
        if (lat) {
#pragma unroll 2
            for (int bl = 0; bl < 8; ++bl) {
                const int base = 3072 + bl * 128;
                float e0 = bf2f(q[base + lane]), e1 = bf2f(q[base + 64 + lane]);
                const float p0 = __shfl_xor(e0, 16), p1 = __shfl_xor(e1, 16);
                if ((lane & 16) == 0) { e0 = e0 * cd - p0 * sd; e1 = e1 * cd - p1 * sd; } else { e0 = e0 * cd + p0 * sd; e1 = e1 * cd + p1 * sd; }
                q[base + lane] = f2bf(e0); q[base + 64 + lane] = f2bf(e1);
            }
        }
    }
    bf16_t* VT = (bf16_t*)(a->ws + WS_VT); LAS bf16_t* tile = (LAS bf16_t*)lds;
    for (int task = blockIdx.x; task < NB * 4 * 68; task += gridDim.x) {
        const int tb = task % 68, h = (task / 68) % 4, b = task / 272, t0 = tb * 64;
        __syncthreads();
#pragma unroll
        for (int i = 0; i < 2; ++i) { const int pc = tid + i * 512, tk = pc >> 4, ch = pc & 15;
            const u32x4 w = *(const u32x4*)(QKV + (size_t)(b * TPB + t0 + tk) * INW + 1024 + h * 128 + ch * 8); *(LAS u32x4*)(tile + tk * 136 + ch * 8) = w; }
        __syncthreads();
        const int d = tid >> 2, tq = (tid & 3) * 16; unsigned w[8];
#pragma unroll
        for (int i = 0; i < 8; ++i) w[i] = (unsigned)tile[(tq + 2 * i) * 136 + d] | ((unsigned)tile[(tq + 2 * i + 1) * 136 + d] << 16);
        bf16_t* dst = VT + ((size_t)(b * 4 + h) * 128 + d) * TPB + t0 + tq;
        *(u32x4*)dst = (u32x4){w[0], w[1], w[2], w[3]}; *(u32x4*)(dst + 8) = (u32x4){w[4], w[5], w[6], w[7]};
    }
    __syncthreads();
}

template <int DQ> __device__ __forceinline__ void attn_wave(const bf16_t* QKV, const LAS float* qs, int kcol, int vcol, int nblk, int mode, int krow0, int b, int r, int c,
                                                               const float* rpb, float scale, int lane, float& o0, float& o1) {
    float m = -1e30f, l = 0.f, a0 = 0.f, a1 = 0.f;
    const int rs = min(max(r - 4, 0), 56), cs = min(max(c - 8, 0), 48);
    for (int blk = 0; blk < nblk; ++blk) {
        const int kidx = blk * 64 + lane; int krow; float bias = 0.f;
        if (mode == 0) krow = krow0 + kidx;
        else if (kidx < 128) { const int kr = rs + (kidx >> 4), kc = cs + (kidx & 15); krow = b * TPB + kr * 64 + kc; bias = rpb[(kr - r + 7) * 31 + (kc - c + 15)]; }
        else krow = b * TPB + SEQ + (kidx - 128);
        const bf16_t* kp = QKV + (size_t)krow * INW + kcol;
        float s = 0.f;
#pragma unroll
        for (int j = 0; j < DQ / 8; ++j) { const u32x4 kv = *(const u32x4*)(kp + 8 * j); const f32x4 q0 = *(const LAS f32x4*)(qs + 8 * j), q1 = *(const LAS f32x4*)(qs + 8 * j + 4);
            s += bf_lo(kv.x) * q0.x + bf_hi(kv.x) * q0.y + bf_lo(kv.y) * q0.z + bf_hi(kv.y) * q0.w + bf_lo(kv.z) * q1.x + bf_hi(kv.z) * q1.y + bf_lo(kv.w) * q1.z + bf_hi(kv.w) * q1.w; }
        s = s * scale + bias;
        const float mn = fmaxf(m, wave_max(s)), alpha = __expf(m - mn), p = __expf(s - mn);
        l = l * alpha + wave_sum(p); a0 *= alpha; a1 *= alpha; m = mn;
#pragma unroll 8
        for (int k = 0; k < 64; ++k) { const float pk = __shfl(p, k); const int rr = __shfl(krow, k);
            const unsigned vv = *(const unsigned*)(QKV + (size_t)rr * INW + vcol + 2 * lane); a0 += pk * bf_lo(vv); a1 += pk * bf_hi(vv); }
    }
    const float il = 1.f / l; o0 = a0 * il; o1 = a1 * il;
}
template <int L> __device__ __forceinline__ void phase_attn_na_naive(ArgsP a, LAS unsigned char* lds, int gw, int ngw, int wave, int lane) {
    const bf16_t* QKV = (const bf16_t*)(a->ws + WS_QKV); bf16_t* ATT = (bf16_t*)(a->ws + WS_ATT);
    LAS float* qs = (LAS float*)(lds + wave * 512);
    const int NLAT = NB * 4 * SEQ, NCTXT = (L == 0) ? NB * 4 * CTX : 0;
    for (int task = gw; task < NLAT + NCTXT; task += ngw) {
        int b, ht, t; bool lat = task < NLAT;
        if (lat) { t = task % SEQ; ht = (task / SEQ) % 4; b = task / (4 * SEQ); } else { const int u = task - NLAT; t = SEQ + u % CTX; ht = (u / CTX) % 4; b = u / (4 * CTX); }
        const int row = b * TPB + t, r = t >> 6, c = t & 63;
        const int krow0 = lat ? b * TPB : b * TPB + SEQ;
        float o0, o1;
        const unsigned qv = *(const unsigned*)(QKV + (size_t)row * INW + ht * 128 + 2 * lane); qs[2 * lane] = bf_lo(qv); qs[2 * lane + 1] = bf_hi(qv); LDS_WAIT();
        attn_wave<128>(QKV, qs, 512 + ht * 128, 1024 + ht * 128, lat ? 6 : 4, lat ? 1 : 0, krow0, b, r, c, a->in[I_RPB] + (size_t)(L * 4 + ht) * 465, 0.08838834764831845f, lane, o0, o1);
        *(unsigned*)(ATT + (size_t)row * D + ht * 128 + 2 * lane) = cvt_pk_bf16(o0, o1);
        LDS_WAIT();
    }
}
namespace att {
typedef short s16x4 __attribute__((ext_vector_type(4)));
typedef float f32x16 __attribute__((ext_vector_type(16)));
constexpr int KVBLK = 64;
constexpr int SHM_V = KVBLK * 128 * 2, SHM_K = KVBLK * 128 * 2;
constexpr float THR = 8.f;
#define KSWZ(row, colB) ((row) * 256 + ((colB) ^ (((row) & 7) << 4)))
#define SBAR() __builtin_amdgcn_sched_barrier(0)
__device__ __forceinline__ int crow(int r, int hi) { return (r & 3) + 8 * (r >> 2) + 4 * hi; }
__device__ __forceinline__ unsigned cvtpk(float lo, float hi) { unsigned r; asm volatile("v_cvt_pk_bf16_f32 %0, %1, %2" : "=v"(r) : "v"(lo), "v"(hi)); return r; }
template <int MODE> __device__ __forceinline__ void partialSM(f32x16& p0, f32x16& p1, float& m_reg, float& mn, float& alpha) {
  constexpr float SCALE = MODE == 0 ? 0.088388347648318440f : 0.125f;
  constexpr float C = SCALE * 1.4426950408889634f;
  float pmax = p0[0];
#pragma unroll
  for (int r = 1; r < 16; ++r) pmax = fmaxf(pmax, p0[r]);
#pragma unroll
  for (int r = 0; r < 16; ++r) pmax = fmaxf(pmax, p1[r]);
  { auto rr = __builtin_amdgcn_permlane32_swap(__float_as_uint(pmax), __float_as_uint(pmax), false, false);
    pmax = fmaxf(__uint_as_float(rr[0]), __uint_as_float(rr[1])); }
  if (__builtin_expect(__all(pmax - m_reg <= THR / SCALE), 1)) { mn = m_reg; alpha = 1.f; }
  else { mn = fmaxf(m_reg, pmax); alpha = __builtin_amdgcn_exp2f((m_reg - mn) * C); m_reg = mn; }
  float mnC = -mn * C;
#pragma unroll
  for (int r = 0; r < 16; ++r) p0[r] = fmaf(p0[r], C, mnC);
#pragma unroll
  for (int r = 0; r < 16; ++r) p1[r] = fmaf(p1[r], C, mnC);
#pragma unroll
  for (int r = 0; r < 16; ++r) p0[r] = __builtin_amdgcn_exp2f(p0[r]);
}
__device__ __forceinline__ void finishSM(f32x16& p0, f32x16& p1, float alpha, float& l_reg, bf16x8& pa0, bf16x8& pa1, bf16x8& pa2, bf16x8& pa3) {
#pragma unroll
  for (int r = 0; r < 16; ++r) p1[r] = __builtin_amdgcn_exp2f(p1[r]);
  float ps = 0;
#pragma unroll
  for (int r = 0; r < 16; ++r) ps += p0[r];
#pragma unroll
  for (int r = 0; r < 16; ++r) ps += p1[r];
  { auto rr = __builtin_amdgcn_permlane32_swap(__float_as_uint(ps), __float_as_uint(ps), false, false);
    ps = __uint_as_float(rr[0]) + __uint_as_float(rr[1]); }
  l_reg = l_reg * alpha + ps;
#define PK4(P, BASE, OUT) do { unsigned a0 = cvtpk(P[BASE + 0], P[BASE + 1]), a1 = cvtpk(P[BASE + 2], P[BASE + 3]);   \
    unsigned b0 = cvtpk(P[BASE + 4], P[BASE + 5]), b1 = cvtpk(P[BASE + 6], P[BASE + 7]);                              \
    auto r0 = __builtin_amdgcn_permlane32_swap(a0, b0, false, false); auto r1 = __builtin_amdgcn_permlane32_swap(a1, b1, false, false); \
    u32x4 w = {r0[0], r1[0], r0[1], r1[1]}; OUT = *reinterpret_cast<bf16x8*>(&w); } while (0)
  PK4(p0, 0, pa0); PK4(p0, 8, pa1); PK4(p1, 0, pa2); PK4(p1, 8, pa3);
#undef PK4
}
template <int NQ> __device__ __forceinline__ void qkt(f32x16& p0, f32x16& p1, const LAS unsigned char* Ks, const bf16x8* qr, int r32, int hi, int mapoff) {
  p0 = f32x16{}; p1 = f32x16{};
#pragma unroll
  for (int d0 = 0; d0 < NQ; ++d0) { int cb = (mapoff + d0 * 16 + hi * 8) * 2;
    bf16x8 b0 = *reinterpret_cast<const LAS bf16x8*>(Ks + KSWZ(r32, cb));
    bf16x8 b1 = *reinterpret_cast<const LAS bf16x8*>(Ks + KSWZ(32 + r32, cb));
    p0 = __builtin_amdgcn_mfma_f32_32x32x16_bf16(b0, qr[d0], p0, 0, 0, 0);
    p1 = __builtin_amdgcn_mfma_f32_32x32x16_bf16(b1, qr[d0], p1, 0, 0, 0); }
}
__device__ __forceinline__ int v_st(int k, int c) { const int kk = (k & ~0xC) | ((k & 4) << 1) | ((k & 8) >> 1); return ((kk >> 3) * 4 + (c >> 5)) * 512 + ((kk & 7) * 32 + (c & 31)) * 2; }
__device__ __forceinline__ int v_rd_base(int lane) { return ((lane & 3) << 3) | (((lane >> 2) & 3) << 6) | (((lane >> 4) & 1) << 5) | (((lane >> 5) & 1) << 8); }
constexpr int v_rd_off(int d0, int ks, int half) { return d0 * 512 + ks * 4096 + half * 2048; }
template <int OFF> __device__ __forceinline__ s16x4 tr_read(int vb) {
  s16x4 r; asm volatile("ds_read_b64_tr_b16 %0, %1 offset:%2" : "=&v"(r) : "v"(vb), "i"(OFF) : "memory"); return r;
}
template <int D0> __device__ __forceinline__ void pv_one(f32x16& od, int vb, bf16x8 pa0, bf16x8 pa1, bf16x8 pa2, bf16x8 pa3) {
  const s16x4 l0 = tr_read<v_rd_off(D0, 0, 0)>(vb), h0 = tr_read<v_rd_off(D0, 0, 1)>(vb), l1 = tr_read<v_rd_off(D0, 1, 0)>(vb), h1 = tr_read<v_rd_off(D0, 1, 1)>(vb);
  const s16x4 l2 = tr_read<v_rd_off(D0, 2, 0)>(vb), h2 = tr_read<v_rd_off(D0, 2, 1)>(vb), l3 = tr_read<v_rd_off(D0, 3, 0)>(vb), h3 = tr_read<v_rd_off(D0, 3, 1)>(vb);
  asm volatile("s_waitcnt lgkmcnt(0)" ::: "memory"); SBAR();
#define PK(L, H) (bf16x8){L[0], L[1], L[2], L[3], H[0], H[1], H[2], H[3]}
  od = __builtin_amdgcn_mfma_f32_32x32x16_bf16(pa0, PK(l0, h0), od, 0, 0, 0);
  od = __builtin_amdgcn_mfma_f32_32x32x16_bf16(pa1, PK(l1, h1), od, 0, 0, 0);
  od = __builtin_amdgcn_mfma_f32_32x32x16_bf16(pa2, PK(l2, h2), od, 0, 0, 0);
  od = __builtin_amdgcn_mfma_f32_32x32x16_bf16(pa3, PK(l3, h3), od, 0, 0, 0);
#undef PK
}
__device__ __forceinline__ void pv_d0(f32x16* o, int vb, bf16x8 pa0, bf16x8 pa1, bf16x8 pa2, bf16x8 pa3) {
  pv_one<0>(o[0], vb, pa0, pa1, pa2, pa3); pv_one<1>(o[1], vb, pa0, pa1, pa2, pa3); pv_one<2>(o[2], vb, pa0, pa1, pa2, pa3); pv_one<3>(o[3], vb, pa0, pa1, pa2, pa3);
}
template <int MODE>
__device__ __forceinline__ void attn_body(const bf16_t* __restrict__ Qb, const bf16_t* __restrict__ Kh, const bf16_t* __restrict__ Vh, bf16_t* __restrict__ Ob, int seq, LAS unsigned char* lds,
                                          float lam, float osc, const float* __restrict__ subln) {
  constexpr int NQ = MODE == 0 ? 8 : 4;
  const int tid = threadIdx.x, wid = __builtin_amdgcn_readfirstlane(tid >> 6), lane = tid & 63, r32 = lane & 31, hi = lane >> 5;
  const int wrow = MODE == 0 ? wid : (wid & 3), mapoff = MODE == 0 ? 0 : (wid >> 2) * 64;
  LAS unsigned char* V_lds = lds; LAS unsigned char* K_lds = lds + 2 * SHM_V;
  LAS float* wsf = (LAS float*)(lds + 2 * SHM_V + 2 * SHM_K) + wid * 64; LAS float* li_l = wsf; LAS float* al_l = wsf + 32;
  float m_reg = -1e30f, l_reg = 0; f32x16 o[4] = {}; bf16x8 qr[NQ];
  const bf16_t* Qw = Qb + (size_t)(wrow * 32 + r32) * INW + mapoff + hi * 8;
#pragma unroll
  for (int d0 = 0; d0 < NQ; ++d0) qr[d0] = *reinterpret_cast<const bf16x8*>(Qw + d0 * 16);
  const int sr = tid >> 4, sc = (tid & 15) * 8, vst0 = v_st(sr, sc), vst1 = v_st(32 + sr, sc);
  const int vb0 = (int)(uintptr_t)V_lds + v_rd_base(lane);
  struct { bf16x8 vs0, vs1, ks0, ks1; } sr_[2];
#define SLOAD(i, k0) do { sr_[i].vs0 = *(const bf16x8*)(&Vh[(size_t)((k0) + sr) * INW + sc]); sr_[i].vs1 = *(const bf16x8*)(&Vh[(size_t)((k0) + 32 + sr) * INW + sc]); \
    sr_[i].ks0 = *(const bf16x8*)(&Kh[(size_t)((k0) + sr) * INW + sc]); sr_[i].ks1 = *(const bf16x8*)(&Kh[(size_t)((k0) + 32 + sr) * INW + sc]); } while (0)
#define SWRITE(b, i) do { *(LAS bf16x8*)(V_lds + (b) * SHM_V + vst0) = sr_[i].vs0;          \
    *(LAS bf16x8*)(V_lds + (b) * SHM_V + vst1) = sr_[i].vs1; int kc = sc * 2;               \
    *(LAS bf16x8*)(K_lds + (b) * SHM_K + KSWZ(sr, kc)) = sr_[i].ks0;                       \
    *(LAS bf16x8*)(K_lds + (b) * SHM_K + KSWZ(32 + sr, kc)) = sr_[i].ks1; } while (0)
#define SWAIT() asm volatile("s_waitcnt vmcnt(4)" ::: "memory")
#define RESC(a) do { if (__any((a) < 1.f)) { if (hi == 0) al_l[r32] = (a); asm volatile("s_waitcnt lgkmcnt(0)" ::: "memory"); \
    _Pragma("unroll") for (int d = 0; d < 4; ++d) _Pragma("unroll") for (int r = 0; r < 16; ++r) o[d][r] *= al_l[crow(r, hi)]; } } while (0)
  f32x16 pA0, pA1, pB0, pB1; float mnA, mnB, alA, alB; bf16x8 pa0, pa1, pa2, pa3; const int NT = seq / KVBLK;
  constexpr int SE = 0, SO = 1;
  SLOAD(SE, 0); asm volatile("s_waitcnt vmcnt(0)" ::: "memory"); SWRITE(0, SE); __syncthreads();
  qkt<NQ>(pA0, pA1, K_lds, qr, r32, hi, mapoff); partialSM<MODE>(pA0, pA1, m_reg, mnA, alA);
  SLOAD(SO, KVBLK); if (2 < NT) SLOAD(SE, 2 * KVBLK);
  SWAIT(); SWRITE(1, SO); __syncthreads();
  for (int j = 1; j + 1 < NT; j += 2) {
    SBAR(); qkt<NQ>(pB0, pB1, K_lds + SHM_K, qr, r32, hi, mapoff);
    finishSM(pA0, pA1, alA, l_reg, pa0, pa1, pa2, pa3); SBAR();
    SLOAD(SO, (j + 2) * KVBLK); SBAR();
    pv_d0(o, vb0, pa0, pa1, pa2, pa3); partialSM<MODE>(pB0, pB1, m_reg, mnB, alB);
    __syncthreads(); SWAIT(); SWRITE(0, SE);
    RESC(alB); __syncthreads();
    SBAR(); qkt<NQ>(pA0, pA1, K_lds, qr, r32, hi, mapoff);
    finishSM(pB0, pB1, alB, l_reg, pa0, pa1, pa2, pa3); SBAR();
    if (j + 3 < NT) SLOAD(SE, (j + 3) * KVBLK); SBAR();
    pv_d0(o, vb0 + SHM_V, pa0, pa1, pa2, pa3); partialSM<MODE>(pA0, pA1, m_reg, mnA, alA);
    __syncthreads(); SWAIT(); SWRITE(1, SO);
    RESC(alA); __syncthreads();
  }
  SBAR(); qkt<NQ>(pB0, pB1, K_lds + SHM_K, qr, r32, hi, mapoff);
  finishSM(pA0, pA1, alA, l_reg, pa0, pa1, pa2, pa3); SBAR();
  pv_d0(o, vb0, pa0, pa1, pa2, pa3); partialSM<MODE>(pB0, pB1, m_reg, mnB, alB);
  __syncthreads(); RESC(alB);
  finishSM(pB0, pB1, alB, l_reg, pa0, pa1, pa2, pa3); SBAR();
  pv_d0(o, vb0 + SHM_V, pa0, pa1, pa2, pa3);
  if (hi == 0) li_l[r32] = l_reg; asm volatile("s_waitcnt lgkmcnt(0)" ::: "memory");
  float rli[16];
#pragma unroll
  for (int r = 0; r < 16; ++r) rli[r] = __builtin_amdgcn_rcpf(li_l[crow(r, hi)]);
  bf16_t* Ow = Ob + (size_t)(wrow * 32) * D;
  if (MODE == 0) {
#pragma unroll
    for (int r = 0; r < 16; ++r) { const int orow = crow(r, hi);
#pragma unroll
      for (int d0 = 0; d0 < 4; ++d0) Ow[(size_t)orow * D + d0 * 32 + r32] = f2bf(o[d0][r] * rli[r]); }
    __syncthreads();
  } else {
#pragma unroll
    for (int r = 0; r < 16; ++r)
#pragma unroll
      for (int d0 = 0; d0 < 4; ++d0) o[d0][r] *= rli[r];
    __syncthreads();
    LAS float* xb = (LAS float*)lds + (wid & 3) * 4096;
    if (wid >= 4) {
#pragma unroll
      for (int r = 0; r < 16; ++r)
#pragma unroll
        for (int d0 = 0; d0 < 4; ++d0) xb[crow(r, hi) * 128 + d0 * 32 + r32] = o[d0][r];
    }
    __syncthreads();
    if (wid < 4) {
      float sg[4];
#pragma unroll
      for (int d0 = 0; d0 < 4; ++d0) sg[d0] = subln[d0 * 32 + r32] * osc;
#pragma unroll
      for (int r = 0; r < 16; ++r) { float ss = 0.f;
#pragma unroll
        for (int d0 = 0; d0 < 4; ++d0) { o[d0][r] -= lam * xb[crow(r, hi) * 128 + d0 * 32 + r32]; ss += o[d0][r] * o[d0][r]; }
#pragma unroll
        for (int x = 1; x < 32; x <<= 1) ss += __shfl_xor(ss, x);
        const float rr = rsqrtf(ss * (1.f / 128.f) + EPS); const int orow = crow(r, hi);
#pragma unroll
        for (int d0 = 0; d0 < 4; ++d0) Ow[(size_t)orow * D + d0 * 32 + r32] = f2bf(o[d0][r] * rr * sg[d0]); }
    }
    __syncthreads();
  }
#undef SLOAD
#undef SWRITE
#undef SWAIT
#undef RESC
}
}

namespace pg8 {
constexpr int BM = 256, BK = 64, HALF = 128, HTB = HALF * BK * 2, STAGE_BYTES = 8 * HTB, NXCD = 8, WGM = 8;
__host__ __device__ __forceinline__ int lds_byte(int r, int c) { const int st = (r >> 4) * 2 + (c >> 5), rr = r & 15, cc = c & 31, ob = rr * 64 + cc * 2; return st * 1024 + (ob ^ (((ob >> 9) & 1) << 5)); }
__host__ __device__ __forceinline__ void stage_rc(int b, int& R, int& C) { const int st = b / 1024, sb = b % 1024, swz = sb ^ (((sb >> 9) & 1) << 5); R = (st >> 1) * 16 + swz / 64; C = (st & 1) * 32 + (swz % 64) / 2; }
__host__ __device__ __forceinline__ int perm32(int rho) { const int n = rho >> 4, i = rho & 15; return 8 * (i >> 2) + 4 * n + (i & 3); }
struct Unit { int pm, pn; size_t boff; };
struct Gemm { const void* A; const void* Bt; int KB; };
typedef int v8i __attribute__((ext_vector_type(8))); typedef int v4i __attribute__((ext_vector_type(4)));
template <bool SKIPCTX> struct StaticOrder {
    int nM, nN, nwg, G, c;
    __device__ void init(int nM_, int nN_, int G_, int c_) { nM = nM_; nN = nN_; nwg = nM * nN; G = G_; c = c_; }
    __device__ bool next(int i, Unit& u) const {
        const long L = (long)i * G + c; if (L >= nwg) return false;
        int wgid = (int)L; { const int q = nwg / NXCD, r = nwg % NXCD, xcd = wgid % NXCD, off = wgid / NXCD; wgid = (xcd < r ? xcd * (q + 1) : r * (q + 1) + (xcd - r) * q) + off; }
        const int nig = WGM * nN, gid = wgid / nig, fm = gid * WGM, gsz = (nM - fm) < WGM ? (nM - fm) : WGM;
        int pm = fm + ((wgid % nig) % gsz); u.pn = (wgid % nig) / gsz; if (SKIPCTX) pm += pm >> 4; u.pm = pm; u.boff = 0; return true;
    }
};
struct MoeOrder {
    int nM, nN, nwg, G, c; int toff[8]; size_t bstride;
    __device__ void init(const LAS int* t, int nN_, int G_, int c_, size_t bstride_) { for (int e = 0; e < 8; ++e) toff[e] = __builtin_amdgcn_readfirstlane(t[e]); nM = __builtin_amdgcn_readfirstlane(t[8]); nN = nN_; nwg = nM * nN; G = G_; c = c_; bstride = bstride_; }
    __device__ bool next(int i, Unit& u) const {
        const long L = (long)i * G + c; if (L >= nwg) return false;
        int wgid = (int)L; { const int q = nwg / NXCD, r = nwg % NXCD, xcd = wgid % NXCD, off = wgid / NXCD; wgid = (xcd < r ? xcd * (q + 1) : r * (q + 1) + (xcd - r) * q) + off; }
        const int nig = WGM * nN, gid = wgid / nig, fm = gid * WGM, gsz = (nM - fm) < WGM ? (nM - fm) : WGM;
        const int pm = fm + ((wgid % nig) % gsz); u.pn = (wgid % nig) / gsz; u.pm = pm;
        int e = 0;
#pragma unroll
        for (int q = 1; q < 8; ++q) e += (pm >= toff[q]) ? 1 : 0;
        u.boff = (size_t)e * bstride; return true;
    }
};
template <bool SCALED> struct EpiBf16T {
    bf16_t* O; int ldc; float scale;
    __device__ __forceinline__ void operator()(const f32x4 (&acc)[2][2][4][2], const Unit& u, int wr, int wc, int fr, int fq) const {
        const int row0 = u.pm * BM + wr * 64 + fr, col0 = u.pn * BM + wc * 32 + 8 * fq;
#pragma unroll
        for (int ai = 0; ai < 2; ++ai)
#pragma unroll
            for (int m = 0; m < 4; ++m) { bf16_t* rowp = O + (size_t)(row0 + ai * HALF + m * 16) * ldc + col0;
#pragma unroll
                for (int bj = 0; bj < 2; ++bj) { f32x4 v0 = acc[ai][bj][m][0], v1 = acc[ai][bj][m][1]; if (SCALED) { v0 = v0 * scale; v1 = v1 * scale; }
                    u32x4 w; w.x = cvt_pk_bf16(v0[0], v0[1]); w.y = cvt_pk_bf16(v0[2], v0[3]); w.z = cvt_pk_bf16(v1[0], v1[1]); w.w = cvt_pk_bf16(v1[2], v1[3]);
                    *(u32x4*)(rowp + bj * HALF) = w; } }
    }
};
__device__ __forceinline__ float silu_mul(float g, float u) { return g * __builtin_amdgcn_rcpf(1.f + __expf(-g)) * u; }
struct EpiSwiglu {
    bf16_t* O; int ldc;
    __device__ __forceinline__ void operator()(const f32x4 (&acc)[2][2][4][2], const Unit& u, int wr, int wc, int fr, int fq) const {
        const int row0 = u.pm * BM + wr * 64 + fr, col0 = u.pn * HALF + wc * 32 + 8 * fq;
#pragma unroll
        for (int ai = 0; ai < 2; ++ai)
#pragma unroll
            for (int m = 0; m < 4; ++m) { bf16_t* rowp = O + (size_t)(row0 + ai * HALF + m * 16) * ldc + col0;
                const f32x4 g0 = acc[ai][0][m][0], g1 = acc[ai][0][m][1], u0 = acc[ai][1][m][0], u1 = acc[ai][1][m][1];
                u32x4 w; w.x = cvt_pk_bf16(silu_mul(g0[0], u0[0]), silu_mul(g0[1], u0[1])); w.y = cvt_pk_bf16(silu_mul(g0[2], u0[2]), silu_mul(g0[3], u0[3]));
                w.z = cvt_pk_bf16(silu_mul(g1[0], u1[0]), silu_mul(g1[1], u1[1])); w.w = cvt_pk_bf16(silu_mul(g1[2], u1[2]), silu_mul(g1[3], u1[3]));
                *(u32x4*)rowp = w; }
    }
};
typedef EpiBf16T<false> EpiBf16;
struct EpiSwigluF8 {
    unsigned char* O; int ldc;
    __device__ __forceinline__ void operator()(const f32x4 (&acc)[2][2][4][2], const Unit& u, int wr, int wc, int fr, int fq) const {
        const int row0 = u.pm * BM + wr * 64 + fr, col0 = u.pn * HALF + wc * 32 + 8 * fq; constexpr float SI = 1.f / (F8_SH * F8_SW);
#pragma unroll
        for (int ai = 0; ai < 2; ++ai)
#pragma unroll
            for (int m = 0; m < 4; ++m) { unsigned char* rowp = O + (size_t)(row0 + ai * HALF + m * 16) * ldc + col0;
                const f32x4 g0 = acc[ai][0][m][0] * SI, g1 = acc[ai][0][m][1] * SI, u0 = acc[ai][1][m][0] * (SI * F8_SA), u1 = acc[ai][1][m][1] * (SI * F8_SA);
                u32x2 w; w.x = pk4_fp8(silu_mul(g0[0], u0[0]), silu_mul(g0[1], u0[1]), silu_mul(g0[2], u0[2]), silu_mul(g0[3], u0[3]));
                w.y = pk4_fp8(silu_mul(g1[0], u1[0]), silu_mul(g1[1], u1[1]), silu_mul(g1[2], u1[2]), silu_mul(g1[3], u1[3]));
                *(u32x2*)rowp = w; }
    }
};
template <bool FP8, class Epi, class Sched>
__device__ __forceinline__ void gemm_phase(LAS unsigned char* lds, const Gemm g, const Sched& S, const Epi& E) {
    const int tid = threadIdx.x, wid = __builtin_amdgcn_readfirstlane(tid >> 6), lane = tid & 63, wr = wid >> 2, wc = wid & 3, fr = lane & 15, fq = lane >> 4;
    const int KB = g.KB, nt = KB / 128;
    unsigned voffA[2], voffB[2];
#pragma unroll
    for (int i = 0; i < 2; ++i) { int R, C; stage_rc(tid * 16 + i * 8192, R, C); const int Rb = (R & ~31) + perm32(R & 31);
        voffA[i] = (unsigned)(R * KB + C * 2); voffB[i] = (unsigned)(Rb * KB + C * 2); }
    const size_t kstep = (size_t)(BK * 2);
    const size_t hstep = (size_t)HALF * KB;
    const size_t tstep = 2 * hstep;
    const unsigned ldsw = (unsigned)wid * 1024u;
    const int aoff = lds_byte(wr * 64 + fr, fq * 8), boff = lds_byte(wc * 32 + fr, fq * 8);
#define PG8_SA(b, h) (((b) * 2 + (h)) * HTB)
#define PG8_SB(b, h) ((4 + (b) * 2 + (h)) * HTB)
#define PG8_STAGE(bufoff, gbase, voff) do { _Pragma("unroll") for (int _i = 0; _i < 2; ++_i) \
        __builtin_amdgcn_global_load_lds((const unsigned*)((const char*)(gbase) + (voff)[_i]), (LAS unsigned*)(lds + (bufoff) + ldsw + _i * 8192), 16, 0, 0); } while (0)
#define PG8_LDA(dst, b, h) do { _Pragma("unroll") for (int m = 0; m < 4; ++m) { const v4i _l = *(const LAS v4i*)(lds + PG8_SA(b, h) + aoff + m * 2048), _h = *(const LAS v4i*)(lds + PG8_SA(b, h) + aoff + m * 2048 + 1024); \
        dst[m] = __builtin_shufflevector(_l, _h, 0, 1, 2, 3, 4, 5, 6, 7); } } while (0)
#define PG8_LDB(dst, b, h) do { _Pragma("unroll") for (int n = 0; n < 2; ++n) { const v4i _l = *(const LAS v4i*)(lds + PG8_SB(b, h) + boff + n * 2048), _h = *(const LAS v4i*)(lds + PG8_SB(b, h) + boff + n * 2048 + 1024); \
        dst[n] = __builtin_shufflevector(_l, _h, 0, 1, 2, 3, 4, 5, 6, 7); } } while (0)
#define PG8_H(v, k) __builtin_bit_cast(bf16x8, __builtin_shufflevector(v, v, 4 * (k), 4 * (k) + 1, 4 * (k) + 2, 4 * (k) + 3))
#define PG8_MMA(ai, bj, At, Bt) do { __builtin_amdgcn_s_setprio(1); _Pragma("unroll") for (int m = 0; m < 4; ++m) _Pragma("unroll") for (int n = 0; n < 2; ++n) { \
        if (FP8) asm volatile("v_mfma_f32_16x16x128_f8f6f4 %0, %1, %2, %0" : "+v"(acc[ai][bj][m][n]) : "v"(Bt[n]), "v"(At[m])); \
        else { acc[ai][bj][m][n] = __builtin_amdgcn_mfma_f32_16x16x32_bf16(PG8_H(Bt[n], 0), PG8_H(At[m], 0), acc[ai][bj][m][n], 0, 0, 0); \
               acc[ai][bj][m][n] = __builtin_amdgcn_mfma_f32_16x16x32_bf16(PG8_H(Bt[n], 1), PG8_H(At[m], 1), acc[ai][bj][m][n], 0, 0, 0); } } \
        __builtin_amdgcn_s_setprio(0); } while (0)
#define PG8_WAIT_V(n) asm volatile("s_waitcnt vmcnt(" #n ")" ::: "memory")
#define PG8_WAIT_L(n) asm volatile("s_waitcnt lgkmcnt(" #n ")" ::: "memory")
#define PG8_BAR __builtin_amdgcn_s_barrier()
#define PG8_SCHED __builtin_amdgcn_sched_barrier(0)
    Unit cur, nxt; int ui = 0;
    if (!S.next(0, cur)) return;
    f32x4 acc[2][2][4][2];
#pragma unroll
    for (int a = 0; a < 2; ++a)
#pragma unroll
        for (int b = 0; b < 2; ++b)
#pragma unroll
            for (int m = 0; m < 4; ++m)
#pragma unroll
                for (int n = 0; n < 2; ++n) acc[a][b][m][n] = (f32x4){0.f, 0.f, 0.f, 0.f};
    v8i At[4], B0[2], B1[2];
    const char* cA = (const char*)g.A + (size_t)cur.pm * tstep; const char* cB = (const char*)g.Bt + cur.boff + (size_t)cur.pn * tstep;
    PG8_STAGE(PG8_SB(0, 0), cB, voffB); PG8_STAGE(PG8_SA(0, 0), cA, voffA); PG8_STAGE(PG8_SB(0, 1), cB + hstep, voffB); PG8_STAGE(PG8_SA(0, 1), cA + hstep, voffA);
    if (wr == 1) PG8_BAR;
    PG8_WAIT_V(4); PG8_BAR;
    PG8_STAGE(PG8_SB(1, 0), cB + kstep, voffB); PG8_STAGE(PG8_SA(1, 0), cA + kstep, voffA); PG8_STAGE(PG8_SB(1, 1), cB + hstep + kstep, voffB);
    PG8_WAIT_V(6); PG8_BAR;
    for (;;) {
        const bool has_next = S.next(ui + 1, nxt);
        const char* nA = has_next ? (const char*)g.A + (size_t)nxt.pm * tstep : cA; const char* nB = has_next ? (const char*)g.Bt + nxt.boff + (size_t)nxt.pn * tstep : cB;
        for (int t = 0; t < nt; t += 2) {
            const bool last = (t == nt - 2);
            const char* a1 = cA + (size_t)(t + 1) * kstep;
            const char* a2 = last ? nA : cA + (size_t)(t + 2) * kstep; const char* b2 = last ? nB : cB + (size_t)(t + 2) * kstep;
            const char* a3 = a2 + kstep; const char* b3 = b2 + kstep;
            PG8_LDB(B0, 0, 0); PG8_SCHED; PG8_LDA(At, 0, 0); PG8_STAGE(PG8_SA(1, 1), a1 + hstep, voffA);
            PG8_WAIT_L(8); PG8_BAR; PG8_WAIT_L(0); PG8_MMA(0, 0, At, B0); PG8_BAR; PG8_SCHED;
            PG8_LDB(B1, 0, 1); PG8_STAGE(PG8_SB(0, 0), b2, voffB);
            PG8_BAR; PG8_WAIT_L(0); PG8_MMA(0, 1, At, B1); PG8_BAR;
            PG8_LDA(At, 0, 1); PG8_STAGE(PG8_SA(0, 0), a2, voffA);
            PG8_BAR; PG8_WAIT_L(0); PG8_MMA(1, 0, At, B0); PG8_BAR; PG8_SCHED;
            PG8_STAGE(PG8_SB(0, 1), b2 + hstep, voffB);
            PG8_WAIT_V(6); PG8_BAR; PG8_MMA(1, 1, At, B1); PG8_BAR;
            PG8_LDB(B0, 1, 0); PG8_SCHED; PG8_LDA(At, 1, 0); PG8_STAGE(PG8_SA(0, 1), a2 + hstep, voffA);
            PG8_WAIT_L(8); PG8_BAR; PG8_WAIT_L(0); PG8_MMA(0, 0, At, B0); PG8_BAR; PG8_SCHED;
            PG8_LDB(B1, 1, 1); PG8_STAGE(PG8_SB(1, 0), b3, voffB);
            PG8_BAR; PG8_WAIT_L(0); PG8_MMA(0, 1, At, B1); PG8_BAR;
            PG8_LDA(At, 1, 1); PG8_STAGE(PG8_SA(1, 0), a3, voffA);
            PG8_BAR; PG8_WAIT_L(0); PG8_MMA(1, 0, At, B0); PG8_BAR; PG8_SCHED;
            PG8_STAGE(PG8_SB(1, 1), b3 + hstep, voffB);
            PG8_WAIT_V(6); PG8_BAR; PG8_MMA(1, 1, At, B1); PG8_BAR;
        }
        if (FP8) asm volatile("s_nop 15\n\ts_nop 15" ::: "memory");
        E(acc, cur, wr, wc, fr, fq);
        if (!has_next) break;
#pragma unroll
        for (int a = 0; a < 2; ++a)
#pragma unroll
            for (int b = 0; b < 2; ++b)
#pragma unroll
                for (int m = 0; m < 4; ++m)
#pragma unroll
                    for (int n = 0; n < 2; ++n) acc[a][b][m][n] = (f32x4){0.f, 0.f, 0.f, 0.f};
        cur = nxt; cA = nA; cB = nB; ++ui;
    }
    PG8_WAIT_V(0);
    if (wr == 0) PG8_BAR;
    PG8_BAR;
#undef PG8_SA
#undef PG8_SB
#undef PG8_STAGE
#undef PG8_LDA
#undef PG8_LDB
#undef PG8_MMA
#undef PG8_H
#undef PG8_WAIT_V
#undef PG8_WAIT_L
#undef PG8_BAR
#undef PG8_SCHED
}
}

template <int L> __device__ __forceinline__ void phase_attn_na(ArgsP a, int gw, int ngw, int lane) {
    const bf16_t* QKV = (const bf16_t*)(a->ws + WS_QKV); const bf16_t* VT = (const bf16_t*)(a->ws + WS_VT); bf16_t* ATT = (bf16_t*)(a->ws + WS_ATT);
    const int j = lane & 15, g4 = lane >> 4;
    constexpr int NT_LAT = NB * 4 * 64 * 4, NT_CTX = (L == 0) ? NB * 4 * 16 : 0;
    constexpr float SCALE = 0.088388347648318440f, LOG2E = 1.4426950408889634f;
    for (int task = gw; task < NT_LAT + NT_CTX; task += ngw) {
        int b, h, r, cg, qtok0, rs, kc0; const bool lat = task < NT_LAT;
        if (lat) { cg = task & 3; r = (task >> 2) & 63; h = (task >> 8) & 3; b = task >> 10; qtok0 = r * 64 + 16 * cg; rs = min(max(r - 4, 0), 56); kc0 = cg == 0 ? 0 : (cg == 1 ? 8 : (cg == 2 ? 24 : 32)); }
        else { const int u = task - NT_LAT; cg = 0; r = 0; rs = 0; kc0 = 0; h = (u >> 4) & 3; b = u >> 6; qtok0 = SEQ + 16 * (u & 15); }
        const float* rpb = a->in[I_RPB] + (size_t)(L * 4 + h) * 465;
        const bf16_t* qp = QKV + ((size_t)b * TPB + qtok0 + j) * INW + h * 128 + 8 * g4;
        bf16x8 qf[4];
#pragma unroll
        for (int s = 0; s < 4; ++s) qf[s] = *(const bf16x8*)(qp + 32 * s);
        const char* kuni = (const char*)(QKV + (size_t)b * TPB * INW + 512 + h * 128);
        const unsigned koff = (unsigned)(j * INW + 8 * g4) * 2u;
        const char* vuni = (const char*)(VT + (size_t)(b * 4 + h) * 128 * TPB);
        const unsigned voff = (unsigned)(j * TPB + 4 * g4) * 2u;
        float m = -1e30f, l = 0.f; f32x4 o[8];
#pragma unroll
        for (int dt = 0; dt < 8; ++dt) o[dt] = (f32x4){0.f, 0.f, 0.f, 0.f};
        const int c = 16 * cg + j, cs = min(max(c - 8, 0), 48);
#pragma unroll 1
        for (int ch = lat ? 0 : 4; ch < 8; ++ch) {
            const bool band = ch < 4;
            f32x4 sc[4];
#pragma unroll
            for (int g = 0; g < 4; ++g) {
                const int tok0 = band ? (rs + 2 * ch + (g >> 1)) * 64 + kc0 + 16 * (g & 1) : SEQ + 64 * (ch - 4) + 16 * g;
                const char* kp = kuni + (size_t)tok0 * (INW * 2);
                f32x4 acc = (f32x4){0.f, 0.f, 0.f, 0.f};
#pragma unroll
                for (int s = 0; s < 4; ++s) acc = __builtin_amdgcn_mfma_f32_16x16x32_bf16(*(const bf16x8*)(kp + koff + 64 * s), qf[s], acc, 0, 0, 0);
                sc[g] = acc;
            }
            float tmax = -1e30f;
#pragma unroll
            for (int g = 0; g < 4; ++g)
#pragma unroll
                for (int e = 0; e < 4; ++e) { float v = sc[g][e] * SCALE;
                    if (band) { const int kc = kc0 + 16 * (g & 1) + 4 * g4 + e; const bool valid = kc >= cs && kc < cs + 16; const int dc = min(max(kc - c + 15, 0), 30);
                        const float bias = rpb[(rs + 2 * ch + (g >> 1) - r + 7) * 31 + dc]; v = valid ? v + bias : -1e30f; }
                    sc[g][e] = v; tmax = fmaxf(tmax, v); }
            tmax = fmaxf(tmax, __shfl_xor(tmax, 16)); tmax = fmaxf(tmax, __shfl_xor(tmax, 32));
            const float mn = fmaxf(m, tmax), alpha = __builtin_amdgcn_exp2f((m - mn) * LOG2E); m = mn;
            float ps = 0.f; bf16x8 pf[2];
#pragma unroll
            for (int ks = 0; ks < 2; ++ks) { float p[8];
#pragma unroll
                for (int e = 0; e < 4; ++e) { p[e] = __builtin_amdgcn_exp2f((sc[2 * ks][e] - mn) * LOG2E); p[4 + e] = __builtin_amdgcn_exp2f((sc[2 * ks + 1][e] - mn) * LOG2E); }
#pragma unroll
                for (int e = 0; e < 8; ++e) ps += p[e];
                u32x4 w; w.x = cvt_pk_bf16(p[0], p[1]); w.y = cvt_pk_bf16(p[2], p[3]); w.z = cvt_pk_bf16(p[4], p[5]); w.w = cvt_pk_bf16(p[6], p[7]);
                pf[ks] = *reinterpret_cast<bf16x8*>(&w); }
            ps += __shfl_xor(ps, 16); ps += __shfl_xor(ps, 32);
            l = l * alpha + ps;
#pragma unroll
            for (int dt = 0; dt < 8; ++dt) o[dt] = o[dt] * alpha;
#pragma unroll
            for (int ks = 0; ks < 2; ++ks) {
                const int tokA = band ? (rs + 2 * ch + ks) * 64 + kc0 : SEQ + 64 * (ch - 4) + 32 * ks;
#pragma unroll
                for (int dt = 0; dt < 8; ++dt) { const char* vp = vuni + ((size_t)dt * 16 * TPB + tokA) * 2;
                    const u32x2 lo = *(const u32x2*)(vp + voff), hi = *(const u32x2*)(vp + voff + 32);
                    u32x4 w = {lo.x, lo.y, hi.x, hi.y};
                    o[dt] = __builtin_amdgcn_mfma_f32_16x16x32_bf16(*reinterpret_cast<bf16x8*>(&w), pf[ks], o[dt], 0, 0, 0); }
            }
        }
        const float il = 1.f / l;
        bf16_t* op = ATT + ((size_t)b * TPB + qtok0 + j) * D + h * 128 + 4 * g4;
#pragma unroll
        for (int dt = 0; dt < 8; ++dt) { u32x2 w; w.x = cvt_pk_bf16(o[dt][0] * il, o[dt][1] * il); w.y = cvt_pk_bf16(o[dt][2] * il, o[dt][3] * il); *(u32x2*)(op + 16 * dt) = w; }
    }
}

template <int L> __device__ __forceinline__ void phase_attn(ArgsP a, LAS unsigned char* lds, int gw, int ngw, int wave, int lane) {
    const bf16_t* QKV = (const bf16_t*)(a->ws + WS_QKV); bf16_t* ATT = (bf16_t*)(a->ws + WS_ATT);
    const float lambda_init = L == 0 ? 0.2f : 0.8f - 0.6f * 0.74081822068171786607f;
    {
    constexpr int REP2 = ((PROBE_DUP >> 2) & 1) + 1, NUQ = 512 + (L == 0 ? 32 : 0);
    for (int uu = blockIdx.x; uu < NUQ * REP2; uu += gridDim.x) { const int u = REP2 == 1 ? uu : uu % NUQ;
        int seq; size_t qrow, krow; int hq;
        if (u < 512) { const int grp = u & 7, idx = u >> 3, b = grp >> 1; hq = (grp & 1) * 4 + (idx & 3); seq = TPB; qrow = (size_t)b * TPB + (idx >> 2) * 256; krow = (size_t)b * TPB; }
        else { const int v = u - 512, b = v >> 3; hq = v & 7; seq = CTX; qrow = (size_t)b * TPB + SEQ; krow = qrow; }
        const int kvh = hq >> 2;
        att::attn_body<0>(QKV + qrow * INW + 1536 + hq * 128, QKV + krow * INW + 2560 + kvh * 128, QKV + krow * INW + 2816 + kvh * 128, ATT + qrow * D + 512 + hq * 128, seq, lds, 0.f, 0.f, nullptr);
    }
    float lam;
    { const int ln = threadIdx.x & 63; const float d1 = wave_sum(a->in[I_LQ1][L * 64 + ln] * a->in[I_LK1][L * 64 + ln]), d2 = wave_sum(a->in[I_LQ2][L * 64 + ln] * a->in[I_LK2][L * 64 + ln]); lam = __expf(d1) - __expf(d2) + lambda_init; lam = __int_as_float(__builtin_amdgcn_readfirstlane(__float_as_int(lam))); }
    constexpr int NUD = 512 + (L == 0 ? 64 : 0);
    for (int uu = blockIdx.x; uu < NUD * REP2; uu += gridDim.x) { const int u = REP2 == 1 ? uu : uu % NUD;
        int seq; size_t qrow, krow; int h;
        if (u < 512) { const int grp = u & 15, b = grp >> 2; h = grp & 3; seq = TPB; qrow = (size_t)b * TPB + (u >> 4) * 128; krow = (size_t)b * TPB; }
        else { const int v = u - 544; if (v < 0) continue; const int b = v >> 3; h = (v >> 1) & 3; seq = CTX; krow = (size_t)b * TPB + SEQ; qrow = krow + (v & 1) * 128; }
        att::attn_body<1>(QKV + qrow * INW + 3072 + h * 128, QKV + krow * INW + 3584 + h * 128, QKV + krow * INW + 4096 + h * 128, ATT + qrow * D + 1536 + h * 128, seq, lds, lam, 1.f - lambda_init, a->in[I_SUBLN] + L * 128);
    }
    }
    __syncthreads();
    DUP(3)
    { const int tid2 = threadIdx.x, lane2 = tid2 & 63, wave2 = __builtin_amdgcn_readfirstlane(tid2 >> 6); phase_attn_na<L>(a, blockIdx.x * NWAVES + wave2, gridDim.x * NWAVES, lane2); }
}

template <int L> __device__ __forceinline__ void layer_program(LAS unsigned char* lds, const XcdBarrier& bar, int lo, int hi) {
    constexpr int P = 2 + 9 * L; const int G = gridDim.x, cid = blockIdx.x;
    const int tid = threadIdx.x, lane = tid & 63, wave = __builtin_amdgcn_readfirstlane(tid >> 6), gw = blockIdx.x * NWAVES + wave, ngw = gridDim.x * NWAVES;
#define IN(k) (lo <= (k) && (k) < hi)
#define SEAM(k) do { if (IN(k) && IN((k) + 1)) xcd_barrier(bar); } while (0)
    if (IN(P + 0)) DUP(1) { ArgsP a = get_args(); unsigned char* ws = a->ws;
        pg8::Gemm g{ws + WS_H, (const bf16_t*)(ws + WS_WIN) + (size_t)L * INW * D, 2 * D}; pg8::StaticOrder<false> S; S.init(NR / 256, INW / 256, G, cid);
        pg8::EpiBf16 E{(bf16_t*)(ws + WS_QKV), INW, 1.f}; pg8::gemm_phase<false>(lds, g, S, E); }
    SEAM(P + 0);
    if (IN(P + 1)) { ArgsP a = get_args(); phase_qkpost<L>(a, lds, gw, ngw, tid, lane); }
    SEAM(P + 1);
    if (IN(P + 2)) { ArgsP a = get_args(); phase_attn<L>(a, lds, gw, ngw, wave, lane); }
    SEAM(P + 2);
    if (IN(P + 3)) DUP(4) { ArgsP a = get_args(); unsigned char* ws = a->ws;
        pg8::Gemm g{ws + WS_ATT, (const bf16_t*)(ws + WS_WOUT) + (size_t)L * D * D, 2 * D}; pg8::EpiBf16 E{(bf16_t*)(ws + WS_O), D, 1.f};
        if (L == 0) { pg8::StaticOrder<false> S; S.init(NR / 256, D / 256, G, cid); pg8::gemm_phase<false>(lds, g, S, E); }
        else { pg8::StaticOrder<true> S; S.init(NTOK / 256, D / 256, G, cid); pg8::gemm_phase<false>(lds, g, S, E); } }
    SEAM(P + 3);
    if (IN(P + 4)) { ArgsP a = get_args(); phase_row_mid<L>(a, lds, gw, ngw, tid, lane); }
    SEAM(P + 4);
    if (IN(P + 5)) { if (L == 1) { ArgsP a = get_args(); phase_moe_slots(a, lds, gw, ngw, tid, lane); } }
    if (L == 1) SEAM(P + 5);
    if (IN(P + 6)) DUP(5) { ArgsP a = get_args(); unsigned char* ws = a->ws;
        if (L == 0) { pg8::EpiSwiglu E{(bf16_t*)(ws + WS_ACT), DFF}; pg8::Gemm g{ws + WS_H, ws + WS_W13, 2 * D}; pg8::StaticOrder<false> S; S.init(NR / 256, 2 * DFF / 256, G, cid); pg8::gemm_phase<false>(lds, g, S, E); }
        else { LAS int* toff = moe_offsets(a, lds, tid); pg8::EpiSwigluF8 E{ws + WS_ACT, DFF}; pg8::Gemm g{ws + WS_HG, ws + WS_MW13, D}; pg8::MoeOrder S; S.init(toff, 2 * DFF / 256, G, cid, (size_t)2 * DFF * D); pg8::gemm_phase<true>(lds, g, S, E); }
    }
    SEAM(P + 6);
    if (IN(P + 7)) DUP(6) { ArgsP a = get_args(); unsigned char* ws = a->ws;
        if (L == 0) { pg8::EpiBf16 E{(bf16_t*)(ws + WS_Y), D, 1.f}; pg8::Gemm g{ws + WS_ACT, ws + WS_W2, 2 * DFF}; pg8::StaticOrder<false> S; S.init(NR / 256, D / 256, G, cid); pg8::gemm_phase<false>(lds, g, S, E); }
        else { LAS int* toff = moe_offsets(a, lds, tid); pg8::EpiBf16T<true> E{(bf16_t*)(ws + WS_Y), D, 1.f / (F8_SA * F8_SW)}; pg8::Gemm g{ws + WS_ACT, ws + WS_MW2, DFF}; pg8::MoeOrder S; S.init(toff, D / 256, G, cid, (size_t)D * DFF); pg8::gemm_phase<true>(lds, g, S, E); }
    }
    SEAM(P + 7);
    if (IN(P + 8)) { ArgsP a = get_args(); phase_row_end<L>(a, gw, ngw, lane); }
    if (L == 0) SEAM(P + 8);
#undef IN
#undef SEAM
}
constexpr int NPHASE = 20;


__global__ void __launch_bounds__(NTHREADS, 2) fwd_kernel(Args kargs_unused) {
    extern __shared__ __attribute__((aligned(16))) unsigned char lds_raw[];
    LAS unsigned char* lds = (LAS unsigned char*)lds_raw;
    volatile LAS unsigned* xbw = (volatile LAS unsigned*)(lds + LDS_BYTES - 16);
    if (threadIdx.x < 4) xbw[threadIdx.x] = 0u;
    __syncthreads();
    int lo, hi; XcdBarrier bar;
    { ArgsP a = get_args(); lo = a->lo; hi = a->hi; bar.bar = (unsigned*)(a->ws + WS_CTL) + CW_BAR; bar.x = 0; bar.st = xbw;
      if (hi - lo > 1) bar = xcd_barrier_post((unsigned*)(a->ws + WS_CTL) + CW_BAR, xbw); }
#define IN(k) (lo <= (k) && (k) < hi)
    { const int tid = threadIdx.x, lane = tid & 63, wave = __builtin_amdgcn_readfirstlane(tid >> 6), gw = blockIdx.x * NWAVES + wave, ngw = gridDim.x * NWAVES;
      if (IN(0)) DUP(0) { ArgsP a = get_args(); phase_adaln(a, lds, tid, wave, lane); phase_convert(a, lds, gw, ngw, wave, lane); __syncthreads(); }
      if (IN(0) && IN(1)) xcd_barrier(bar);
      if (IN(1)) { ArgsP a = get_args(); phase_row_entry(a, gw, ngw, lane); }
      if (IN(1) && IN(2)) xcd_barrier(bar); }
#undef IN
    layer_program<0>(lds, bar, lo, hi);
    layer_program<1>(lds, bar, lo, hi);
}

#ifndef MK_PER_PHASE
#define MK_PER_PHASE 0
#endif
extern "C" void kernel_launch(void* const* d_in, const int* in_sizes, int n_in, void* d_out, int out_size, void* d_ws, size_t ws_size, hipStream_t stream) {
    static int grid = 0;
    if (grid == 0) {
        if (n_in != 27 || out_size != NB * SEQ * D || ws_size < WS_END) { fprintf(stderr, "kernel_launch: unexpected shapes: n_in %d out %d ws %zu (need %zu)\n", n_in, out_size, ws_size, (size_t)WS_END); grid = -1; return; }
        int dev = 0, cus = 0, per_cu = 0;
        if (hipGetDevice(&dev) != hipSuccess || hipDeviceGetAttribute(&cus, hipDeviceAttributeMultiprocessorCount, dev) != hipSuccess) { grid = -1; return; }
        if (hipFuncSetAttribute((const void*)fwd_kernel, hipFuncAttributeMaxDynamicSharedMemorySize, LDS_BYTES) != hipSuccess) { fprintf(stderr, "kernel_launch: hipFuncSetAttribute failed\n"); grid = -1; return; }
        if (hipOccupancyMaxActiveBlocksPerMultiprocessor(&per_cu, (const void*)fwd_kernel, NTHREADS, LDS_BYTES) != hipSuccess || per_cu < 1) fprintf(stderr, "kernel_launch: occupancy query says %d\n", per_cu);
        (void)hipGetLastError();
        grid = cus;
    }
    if (grid < 0) return;
    (void)hipMemsetAsync((char*)d_ws + WS_CTL, 0, CTL_ZERO_BYTES, stream);
    Args a{};
    for (int i = 0; i < 27; ++i) a.in[i] = (const float*)d_in[i];
    a.out = (float*)d_out; a.ws = (unsigned char*)d_ws;
#if MK_PER_PHASE
    for (int p = 0; p < NPHASE; ++p) { if (p == 7) continue; a.lo = p; a.hi = p + 1; hipLaunchKernelGGL(fwd_kernel, dim3(grid), dim3(NTHREADS), LDS_BYTES, stream, a); }
#else
    a.lo = 0; a.hi = NPHASE; hipLaunchKernelGGL(fwd_kernel, dim3(grid), dim3(NTHREADS), LDS_BYTES, stream, a);
#endif
}
```

```cpp
#include <hip/hip_runtime.h>
#include <stdint.h>
#include <stdio.h>

#define GAS __attribute__((address_space(1)))
#define LAS __attribute__((address_space(3)))
typedef unsigned short bf16_t;
typedef short bf16x8 __attribute__((ext_vector_type(8)));
typedef float f32x4 __attribute__((ext_vector_type(4)));
typedef float f32x2 __attribute__((ext_vector_type(2)));
typedef unsigned u32x4 __attribute__((ext_vector_type(4)));
typedef unsigned u32x2 __attribute__((ext_vector_type(2)));

#ifndef PROBE_DUP
#define PROBE_DUP 0
#endif
#define DUP(bit) for (int _rep = 0; _rep < (((PROBE_DUP) >> (bit)) & 1) + 1; ++_rep)
#ifndef PROBE_STAMP
#define PROBE_STAMP -1
#endif
#define STAMP(i) do { if (PROBE_STAMP >= 0 && blockIdx.x == 0 && threadIdx.x == 0) { ((volatile LAS unsigned long long*)(lds + 131072 + 1024))[i] = (unsigned long long)wall_clock64(); ((volatile LAS unsigned long long*)(lds + 131072 + 1024))[32 + (i)] = (unsigned long long)clock64(); } } while (0)
constexpr int D = 2048, NB = 4, SEQ = 4096, CTX = 256, TPB = SEQ + CTX, NR = NB * TPB;
constexpr int INW = 4608, DFF = 5632, NE = 8, MODW = 6 * D, NTOK = NB * SEQ;
constexpr int MAXSLOT = 34816;
constexpr float EPS = 1e-6f;
constexpr int NWAVES = 8, NTHREADS = 512;
constexpr int LDS_BYTES = 147456;

constexpr size_t MiB = 1u << 20;
constexpr size_t WS_CTL = 0, CTL_ZERO_BYTES = 128 * 1024;
constexpr size_t WS_MOD = 1 * MiB;
constexpr size_t WS_TOPK = 2 * MiB;
constexpr size_t WS_SLOT = WS_TOPK + 512 * 1024;
constexpr size_t WS_IDX = 3 * MiB;
constexpr size_t WS_WIN = 4 * MiB;
constexpr size_t WS_WOUT = 40 * MiB;
constexpr size_t WS_W13 = 56 * MiB;
constexpr size_t WS_W2 = 100 * MiB;
constexpr size_t WS_MW13 = 122 * MiB;
constexpr size_t WS_MW2 = 474 * MiB;
constexpr size_t WS_X = 650 * MiB;
constexpr size_t WS_H = 786 * MiB;
constexpr size_t WS_Y = 854 * MiB;
constexpr size_t WS_HG = WS_Y;
constexpr size_t WS_R1 = 990 * MiB;
constexpr size_t WS_QKV = WS_R1, WS_VT = WS_R1 + 153 * MiB, WS_ATT = WS_R1 + 170 * MiB, WS_O = WS_R1 + 238 * MiB, WS_ACT = WS_R1;
constexpr size_t WS_END = WS_R1 + (size_t)MAXSLOT * DFF * 2;
constexpr size_t WS_H8 = WS_END;
constexpr size_t WS_PART_A = WS_QKV;
constexpr size_t WS_PART_B = WS_Y + 68 * MiB;
static_assert((size_t)NR * INW * 2 <= 153 * MiB && (size_t)16 * 128 * TPB * 2 <= 17 * MiB && (size_t)NR * D * 2 <= 68 * MiB, "R1 map");
constexpr int CW_BAR = 4096;
constexpr int CW_CNT = 16384;
constexpr int CW_CUR = 16384 + 64;

__device__ __forceinline__ unsigned cvt_pk_bf16(float lo, float hi) { unsigned r; asm("v_cvt_pk_bf16_f32 %0, %1, %2" : "=v"(r) : "v"(lo), "v"(hi)); return r; }
__device__ __forceinline__ float bf_lo(unsigned w) { return __uint_as_float(w << 16); }
__device__ __forceinline__ float bf_hi(unsigned w) { return __uint_as_float(w & 0xffff0000u); }
__device__ __forceinline__ float bf2f(bf16_t b) { return __uint_as_float(((unsigned)b) << 16); }
__device__ __forceinline__ bf16_t f2bf(float f) { return (bf16_t)(cvt_pk_bf16(f, 0.f) & 0xffffu); }
__device__ __forceinline__ float wave_sum(float v) {
#pragma unroll
    for (int o = 1; o < 64; o <<= 1) v += __shfl_xor(v, o);
    return v;
}
__device__ __forceinline__ float wave_max(float v) {
#pragma unroll
    for (int o = 1; o < 64; o <<= 1) v = fmaxf(v, __shfl_xor(v, o));
    return v;
}
#define LDS_WAIT() asm volatile("s_waitcnt lgkmcnt(0)" ::: "memory")
__device__ __forceinline__ unsigned pk4_fp8(float a, float b, float c, float d) {
    a = fminf(fmaxf(a, -448.f), 448.f); b = fminf(fmaxf(b, -448.f), 448.f); c = fminf(fmaxf(c, -448.f), 448.f); d = fminf(fmaxf(d, -448.f), 448.f);
    int w = 0; w = __builtin_amdgcn_cvt_pk_fp8_f32(a, b, w, false); w = __builtin_amdgcn_cvt_pk_fp8_f32(c, d, w, true); return (unsigned)w; }
#ifndef FP8_UP0
#define FP8_UP0 1
#endif
constexpr float F8_SW = 64.f, F8_SH = 16.f, F8_SA = 8.f;

#define XB_TMO      128
#define XB_XCNT(j)  (256  + 64 * (j))
#define XB_XSUB(j)  (1280 + 64 * (j))
#define XB_XGEN(j)  (2304 + 64 * (j))
#define XB_TOP      3328
#define XB_TOPGEN   3392
#define XCD_BAR_WORDS 3456
#define XB_SPIN_CAP (1u << 18)
__device__ __forceinline__ unsigned xb_ld(unsigned* p)              { return __hip_atomic_load(p, __ATOMIC_RELAXED, __HIP_MEMORY_SCOPE_AGENT); }
__device__ __forceinline__ unsigned xb_add(unsigned* p, unsigned v) { return __hip_atomic_fetch_add(p, v, __ATOMIC_RELAXED, __HIP_MEMORY_SCOPE_AGENT); }
__device__ __forceinline__ unsigned xb_xcc_id() { return (unsigned)__builtin_amdgcn_s_getreg((3 << 11) | 20) & 0xFu; }
#define XB_SPIN(cond, bar) do { unsigned _sp = 0; while (cond) { __builtin_amdgcn_s_sleep(1); \
    if ((++_sp & 255u) == 0u) { if (xb_ld(&(bar)[XB_TMO])) break; if (_sp > XB_SPIN_CAP) { atomicAdd(&(bar)[XB_TMO], 1u); break; } } } } while (0)
struct XcdBarrier { unsigned* bar; unsigned x; volatile LAS unsigned* st; };
__device__ __forceinline__ XcdBarrier xcd_barrier_post(unsigned* bar, volatile LAS unsigned* st) {
    XcdBarrier b; b.bar = bar; b.x = xb_xcc_id(); b.st = st;
    if (threadIdx.x == 0) (void)xb_add(&bar[XB_XCNT(b.x)], 1u);
    return b;
}
__device__ __forceinline__ void xcd_barrier_complete(unsigned* bar, unsigned x, unsigned& nloc, unsigned& nx) {
    const unsigned G = gridDim.x * gridDim.y * gridDim.z;
    unsigned sum, cnt, mine, sp = 0u;
    for (;;) {
        sum = 0u; cnt = 0u; mine = 0u;
#pragma unroll
        for (unsigned j = 0; j < 16; ++j) { const unsigned c = xb_ld(&bar[XB_XCNT(j)]); sum += c; cnt += (c > 0u) ? 1u : 0u; mine = (j == x) ? c : mine; }
        if (sum == G) break;
        __builtin_amdgcn_s_sleep(1);
        if ((++sp & 255u) == 0u) { if (xb_ld(&bar[XB_TMO])) break; if (sp > XB_SPIN_CAP) { atomicAdd(&bar[XB_TMO], 1u); break; } }
    }
    nloc = mine > 0u ? mine : 1u; nx = cnt > 0u ? cnt : 1u;
}
__device__ __forceinline__ void xcd_barrier(const XcdBarrier& b) {
    asm volatile("s_waitcnt vmcnt(0)" ::: "memory");
    __syncthreads();
    if (threadIdx.x == 0) {
        unsigned* bar = b.bar;
        __builtin_amdgcn_s_waitcnt(0);
        unsigned nloc = b.st[0], nx = b.st[1];
        if (nloc == 0u) { xcd_barrier_complete(bar, b.x, nloc, nx); b.st[0] = nloc; b.st[1] = nx; }
        const unsigned old = xb_add(&bar[XB_XSUB(b.x)], 1u);
        const unsigned gen = old / nloc;
        if (old + 1u == (gen + 1u) * nloc) {
            __builtin_amdgcn_fence(__ATOMIC_RELEASE, "agent");
            asm volatile("s_waitcnt vmcnt(0)" ::: "memory");
            const unsigned og = xb_add(&bar[XB_TOP], 1u);
            const unsigned tg = og / nx;
            if (og + 1u == (tg + 1u) * nx) xb_add(&bar[XB_TOPGEN], 1u);
            else XB_SPIN(xb_ld(&bar[XB_TOPGEN]) == tg, bar);
            __builtin_amdgcn_fence(__ATOMIC_ACQUIRE, "agent");
            xb_add(&bar[XB_XGEN(b.x)], 1u);
            asm volatile("s_waitcnt vmcnt(0)" ::: "memory");
        } else {
            XB_SPIN(xb_ld(&bar[XB_XGEN(b.x)]) == gen, bar);
            __builtin_amdgcn_fence(__ATOMIC_ACQUIRE, "agent");
            asm volatile("s_waitcnt vmcnt(0)" ::: "memory");
        }
    }
    __syncthreads();
}

struct Args { const float* in[27]; float* out; unsigned char* ws; int lo, hi; };
typedef const __attribute__((address_space(4))) Args* ArgsP;
__device__ __forceinline__ int fresh_tid() { int t = threadIdx.x; asm volatile("" : "+v"(t)); return t; }
__device__ __forceinline__ ArgsP get_args() { ArgsP p = (ArgsP)__builtin_amdgcn_kernarg_segment_ptr(); asm volatile("" : "+s"(p)); return p; }
enum { I_X = 0, I_C, I_CTX, I_CCTX, I_WMOD, I_BMOD, I_GMIXPRE, I_GMIXPOST, I_GFFNPRE, I_GFFNPOST, I_WIN, I_WOUT, I_RPB, I_QNORM, I_KNORM,
       I_LQ1, I_LK1, I_LQ2, I_LK2, I_SUBLN, I_FW1, I_FW3, I_FW2, I_ROUTER, I_MW1, I_MW3, I_MW2 };

__device__ __forceinline__ void transpose_item(const float* W, int K, int N, bf16_t* WT, int item, int mode, LAS float* scr, int lane) {
    const int nblk = N / 32, kb = item / nblk, nb = item % nblk, k0 = 64 * kb, n0 = 32 * nb;
#pragma unroll 8
    for (int i = 0; i < 32; ++i) { const int kk = 2 * i + (lane >> 5); scr[kk * 33 + (lane & 31)] = W[(size_t)(k0 + kk) * N + n0 + (lane & 31)]; }
    LDS_WAIT(); asm volatile("" ::: "memory");
    const int c = lane & 7;
    const int drow0 = mode == 0 ? n0 : (256 * (n0 >> 7) + (n0 & 127) + (mode == 2 ? 128 : 0));
#pragma unroll
    for (int j = 0; j < 4; ++j) { const int n = (lane >> 3) + 8 * j; const LAS float* s = scr + (8 * c) * 33 + n;
        u32x4 o; o.x = cvt_pk_bf16(s[0 * 33], s[1 * 33]); o.y = cvt_pk_bf16(s[2 * 33], s[3 * 33]); o.z = cvt_pk_bf16(s[4 * 33], s[5 * 33]); o.w = cvt_pk_bf16(s[6 * 33], s[7 * 33]);
        *(u32x4*)(WT + (size_t)(drow0 + n) * K + k0 + 8 * c) = o; }
    LDS_WAIT(); asm volatile("" ::: "memory");
}
__device__ __forceinline__ void transpose_item_f8(const float* W, int K, int N, unsigned char* WT, int item, int mode, LAS float* scr, int lane) {
    const int nblk = N / 32, kb = item / nblk, nb = item % nblk, k0 = 64 * kb, n0 = 32 * nb;
#pragma unroll 8
    for (int i = 0; i < 32; ++i) { const int kk = 2 * i + (lane >> 5); scr[kk * 33 + (lane & 31)] = W[(size_t)(k0 + kk) * N + n0 + (lane & 31)]; }
    LDS_WAIT(); asm volatile("" ::: "memory");
    const int c = lane & 7;
    const int drow0 = mode == 0 ? n0 : (256 * (n0 >> 7) + (n0 & 127) + (mode == 2 ? 128 : 0));
#pragma unroll
    for (int j = 0; j < 4; ++j) { const int n = (lane >> 3) + 8 * j; const LAS float* s = scr + (8 * c) * 33 + n;
        u32x2 o; o.x = pk4_fp8(s[0 * 33] * F8_SW, s[1 * 33] * F8_SW, s[2 * 33] * F8_SW, s[3 * 33] * F8_SW); o.y = pk4_fp8(s[4 * 33] * F8_SW, s[5 * 33] * F8_SW, s[6 * 33] * F8_SW, s[7 * 33] * F8_SW);
        *(u32x2*)(WT + (size_t)(drow0 + n) * K + k0 + 8 * c) = o; }
    LDS_WAIT(); asm volatile("" ::: "memory");
}
struct CvtItem { const float* src; unsigned char* dst; int N, K, f8; };
__device__ __forceinline__ CvtItem cvt_decode(ArgsP a, int it, int lane) {
    unsigned char* ws = a->ws;
    constexpr int I_IN = 32 * 144, I_OUT = 32 * 64, I_F = 5632;
    const float* W; unsigned char* WT; int K, N, mode, f8 = 0, q;
    int r = it;
    if (r < 2 * I_IN) { const int l = r / I_IN; W = a->in[I_WIN] + (size_t)l * D * INW; K = D; N = INW; WT = ws + WS_WIN + (size_t)l * INW * D * 2; mode = 0; q = r % I_IN; }
    else if (r < 2 * I_IN + 2 * I_OUT) { r -= 2 * I_IN; const int l = r / I_OUT; W = a->in[I_WOUT] + (size_t)l * D * D; K = D; N = D; WT = ws + WS_WOUT + (size_t)l * D * D * 2; mode = 0; q = r % I_OUT; }
    else { r -= 2 * I_IN + 2 * I_OUT; const int m = r / I_F; q = r % I_F;
        if (m == 0) { W = a->in[I_FW1]; K = D; N = DFF; WT = ws + WS_W13; mode = 1; f8 = FP8_UP0; }
        else if (m == 1) { W = a->in[I_FW3]; K = D; N = DFF; WT = ws + WS_W13; mode = 2; f8 = FP8_UP0; }
        else if (m == 2) { W = a->in[I_FW2]; K = DFF; N = D; WT = ws + WS_W2; mode = 0; }
        else if (m < 11) { const int e = m - 3; W = a->in[I_MW1] + (size_t)e * D * DFF; K = D; N = DFF; WT = ws + WS_MW13 + (size_t)e * 2 * DFF * D; mode = 1; f8 = 1; }
        else if (m < 19) { const int e = m - 11; W = a->in[I_MW3] + (size_t)e * D * DFF; K = D; N = DFF; WT = ws + WS_MW13 + (size_t)e * 2 * DFF * D; mode = 2; f8 = 1; }
        else { const int e = m - 19; W = a->in[I_MW2] + (size_t)e * DFF * D; K = DFF; N = D; WT = ws + WS_MW2 + (size_t)e * D * DFF; mode = 0; f8 = 1; } }
    const int nblk = N / 32, kb = q / nblk, nb = q % nblk, k0 = 64 * kb, n0 = 32 * nb;
    const int drow0 = mode == 0 ? n0 : (256 * (n0 >> 7) + (n0 & 127) + (mode == 2 ? 128 : 0));
    CvtItem c; c.src = W + (size_t)k0 * N + n0; c.N = N; c.K = K; c.f8 = f8; c.dst = WT + ((size_t)drow0 * K + k0) * (f8 ? 1 : 2); return c;
}
__device__ __forceinline__ void cvt_load(const CvtItem& c, int lane, float (&v)[32]) {
    const float* p = c.src + (size_t)(lane >> 5) * c.N + (lane & 31);
#pragma unroll
    for (int i = 0; i < 32; ++i) v[i] = p[(size_t)(2 * i) * c.N];
}
__device__ __forceinline__ void cvt_store(const CvtItem& c, int lane, const float (&v)[32], LAS float* scr) {
#pragma unroll
    for (int i = 0; i < 32; ++i) scr[(2 * i + (lane >> 5)) * 33 + (lane & 31)] = v[i];
    LDS_WAIT(); asm volatile("" ::: "memory");
    const int cc = lane & 7;
#pragma unroll
    for (int j = 0; j < 4; ++j) { const int n = (lane >> 3) + 8 * j; const LAS float* s = scr + (8 * cc) * 33 + n;
        if (c.f8) { u32x2 o; o.x = pk4_fp8(s[0 * 33] * F8_SW, s[1 * 33] * F8_SW, s[2 * 33] * F8_SW, s[3 * 33] * F8_SW); o.y = pk4_fp8(s[4 * 33] * F8_SW, s[5 * 33] * F8_SW, s[6 * 33] * F8_SW, s[7 * 33] * F8_SW);
            *(u32x2*)(c.dst + (size_t)n * c.K + 8 * cc) = o; }
        else { u32x4 o; o.x = cvt_pk_bf16(s[0 * 33], s[1 * 33]); o.y = cvt_pk_bf16(s[2 * 33], s[3 * 33]); o.z = cvt_pk_bf16(s[4 * 33], s[5 * 33]); o.w = cvt_pk_bf16(s[6 * 33], s[7 * 33]);
            *(u32x4*)(c.dst + ((size_t)n * c.K + 8 * cc) * 2) = o; } }
    LDS_WAIT(); asm volatile("" ::: "memory");
}
__device__ __forceinline__ void phase_convert(ArgsP a, LAS unsigned char* lds, int gw, int ngw, int wave, int lane) {
    LAS float* scr = (LAS float*)(lds + wave * 16384);
    constexpr int NITEMS = 2 * 32 * 144 + 2 * 32 * 64 + 27 * 5632;
    int it = gw; if (it >= NITEMS) return;
    CvtItem cur = cvt_decode(a, it, lane); float va[32], vb[32];
    cvt_load(cur, lane, va);
    for (;;) {
        const int n1 = it + ngw; const bool h1 = n1 < NITEMS; CvtItem nx = cur;
        if (h1) { nx = cvt_decode(a, n1, lane); cvt_load(nx, lane, vb); }
        cvt_store(cur, lane, va, scr);
        if (!h1) break;
        const int n2 = n1 + ngw; const bool h2 = n2 < NITEMS;
        if (h2) { cur = cvt_decode(a, n2, lane); cvt_load(cur, lane, va); }
        cvt_store(nx, lane, vb, scr);
        if (!h2) break;
        it = n2;
    }
}
__device__ __forceinline__ void phase_adaln(ArgsP a, LAS unsigned char* lds, int tid, int wave, int lane) {
    LAS float* sc = (LAS float*)lds;
    LAS float* red = (LAS float*)(lds + 5 * 2048 * 4);
    float* MOD = (float*)(a->ws + WS_MOD);
    for (int task = blockIdx.x; task < 192; task += gridDim.x) {
        const int l = task / 96, j0 = (task % 96) * 128;
        for (int i = tid; i < 5 * 2048; i += NTHREADS) { const int v = i >> 11, k = i & 2047; const float c = v < 4 ? a->in[I_C][v * D + k] : a->in[I_CCTX][k]; sc[i] = c / (1.f + __expf(-c)); }
        __syncthreads();
        float acc[5][2];
#pragma unroll
        for (int v = 0; v < 5; ++v) { acc[v][0] = 0.f; acc[v][1] = 0.f; }
        const float* wp = a->in[I_WMOD] + ((size_t)l * D + wave * 256) * MODW + j0 + 2 * lane;
        for (int k = 0; k < 256; ++k) { const f32x2 w = *(const f32x2*)(wp + (size_t)k * MODW);
#pragma unroll
            for (int v = 0; v < 5; ++v) { const float s = sc[v * 2048 + wave * 256 + k]; acc[v][0] += s * w.x; acc[v][1] += s * w.y; } }
#pragma unroll
        for (int v = 0; v < 5; ++v) { red[(wave * 5 + v) * 128 + 2 * lane] = acc[v][0]; red[(wave * 5 + v) * 128 + 2 * lane + 1] = acc[v][1]; }
        __syncthreads();
        for (int i = tid; i < 640; i += NTHREADS) { const int v = i >> 7, j = i & 127; float s = a->in[I_BMOD][l * MODW + j0 + j];
#pragma unroll
            for (int w = 0; w < 8; ++w) s += red[(w * 5 + v) * 128 + j];
            MOD[(size_t)(l * 5 + v) * MODW + j0 + j] = s; }
        __syncthreads();
    }
}

__device__ __forceinline__ void ld_row_f32(const float* p, int lane, f32x4 (&v)[8]) {
#pragma unroll
    for (int j = 0; j < 8; ++j) v[j] = *(const f32x4*)(p + 4 * lane + 256 * j);
}
__device__ __forceinline__ void ld_row_bf16(const bf16_t* p, int lane, f32x4 (&v)[8]) {
#pragma unroll
    for (int j = 0; j < 8; ++j) { const u32x2 w = *(const u32x2*)(p + 4 * lane + 256 * j); v[j] = (f32x4){bf_lo(w.x), bf_hi(w.x), bf_lo(w.y), bf_hi(w.y)}; }
}
__device__ __forceinline__ void st_row_f32(float* p, int lane, const f32x4 (&v)[8]) {
#pragma unroll
    for (int j = 0; j < 8; ++j) *(f32x4*)(p + 4 * lane + 256 * j) = v[j];
}
__device__ __forceinline__ void st_row_bf16(bf16_t* p, int lane, const f32x4 (&v)[8]) {
#pragma unroll
    for (int j = 0; j < 8; ++j) { u32x2 w; w.x = cvt_pk_bf16(v[j].x, v[j].y); w.y = cvt_pk_bf16(v[j].z, v[j].w); *(u32x2*)(p + 4 * lane + 256 * j) = w; }
}
__device__ __forceinline__ float row_rstd(const f32x4 (&v)[8]) {
    float s = 0.f;
#pragma unroll
    for (int j = 0; j < 8; ++j) s += (v[j].x * v[j].x + v[j].y * v[j].y) + (v[j].z * v[j].z + v[j].w * v[j].w);
    return rsqrtf(wave_sum(s) * (1.f / D) + EPS);
}
template <bool STORE = true> __device__ __forceinline__ void norm_mod_store(const f32x4 (&x)[8], const float* g, const float* sh, const float* sc, bf16_t* hrow, int lane, f32x4 (&h)[8]) {
    const float r = row_rstd(x);
#pragma unroll
    for (int j = 0; j < 8; ++j) { const int c = 4 * lane + 256 * j; const f32x4 gv = *(const f32x4*)(g + c), sv = *(const f32x4*)(sc + c), hv = *(const f32x4*)(sh + c);
        h[j] = (x[j] * r * gv) * (sv + 1.f) + hv; }
    if (STORE) st_row_bf16(hrow, lane, h);
}
__device__ __forceinline__ void phase_row_entry(ArgsP a, int gw, int ngw, int lane) {
    bf16_t* X = (bf16_t*)(a->ws + WS_X); bf16_t* H = (bf16_t*)(a->ws + WS_H); const float* MOD = (const float*)(a->ws + WS_MOD);
    for (int row = gw; row < NR; row += ngw) {
        const int b = row / TPB, t = row % TPB; const bool lat = t < SEQ; const int v = lat ? b : 4;
        const float* src = lat ? a->in[I_X] + ((size_t)b * SEQ + t) * D : a->in[I_CTX] + ((size_t)b * CTX + (t - SEQ)) * D;
        f32x4 x[8], h[8]; ld_row_f32(src, lane, x); st_row_bf16(X + (size_t)row * D, lane, x);
        const float* mv = MOD + (size_t)(0 * 5 + v) * MODW;
        norm_mod_store(x, a->in[I_GMIXPRE], mv + 0 * D, mv + 1 * D, H + (size_t)row * D, lane, h);
    }
}
template <int L> __device__ __forceinline__ void phase_row_mid(ArgsP a, LAS unsigned char* lds, int gw, int ngw, int tid, int lane) {
    bf16_t* X = (bf16_t*)(a->ws + WS_X); bf16_t* H = (bf16_t*)(a->ws + WS_H); const float* MOD = (const float*)(a->ws + WS_MOD); const bf16_t* O = (const bf16_t*)(a->ws + WS_O);
    LAS unsigned* lcnt = (LAS unsigned*)(lds + 131072 + 64); LAS float* rt = (LAS float*)lds;
    if (L == 1) { if (tid < 8) lcnt[tid] = 0u;
        for (int i = tid; i < D * NE; i += NTHREADS) rt[(i & 7) * D + (i >> 3)] = a->in[I_ROUTER][i];
        __syncthreads(); }
    for (int row = gw; row < NR; row += ngw) {
        const int b = row / TPB, t = row % TPB; const bool lat = t < SEQ; const int v = lat ? b : 4;
        if (L == 1 && !lat) continue;
        const float* mv = MOD + (size_t)(L * 5 + v) * MODW;
        f32x4 o[8], x[8], h[8];
        if (L == 0 && !lat) { const bf16_t* P = (const bf16_t*)(a->ws + WS_PART_A) + (size_t)(b * CTX + (t - SEQ)) * D; ld_row_bf16(P, lane, o);
#pragma unroll
            for (int s = 1; s < 8; ++s) { f32x4 p[8]; ld_row_bf16(P + (size_t)s * (NB * CTX) * D, lane, p);
#pragma unroll
                for (int j = 0; j < 8; ++j) o[j] = o[j] + p[j]; } }
        else ld_row_bf16(O + (size_t)row * D, lane, o);
        ld_row_bf16(X + (size_t)row * D, lane, x);
        const float r1 = row_rstd(o);
#pragma unroll
        for (int j = 0; j < 8; ++j) { const int c = 4 * lane + 256 * j; const f32x4 gv = *(const f32x4*)(a->in[I_GMIXPOST] + L * D + c), gt = *(const f32x4*)(mv + 2 * D + c);
            x[j] = x[j] + gt * (o[j] * r1 * gv); }
        st_row_bf16(X + (size_t)row * D, lane, x);
        norm_mod_store<(L == 0 && !FP8_UP0)>(x, a->in[I_GFFNPRE] + L * D, mv + 3 * D, mv + 4 * D, H + (size_t)row * D, lane, h);
        { unsigned char* h8 = a->ws + WS_H8 + (size_t)row * D;
#pragma unroll
            for (int j = 0; j < 8; ++j) *(unsigned*)(h8 + 4 * lane + 256 * j) = pk4_fp8(h[j].x * F8_SH, h[j].y * F8_SH, h[j].z * F8_SH, h[j].w * F8_SH); }
        if (L == 1) {
            float lg[8];
#pragma unroll
            for (int e = 0; e < 8; ++e) lg[e] = 0.f;
#pragma unroll
            for (int j = 0; j < 8; ++j)
#pragma unroll
                for (int e = 0; e < 8; ++e) { const f32x4 r = *(const LAS f32x4*)(rt + e * D + 4 * lane + 256 * j); lg[e] += (h[j].x * r.x + h[j].y * r.y) + (h[j].z * r.z + h[j].w * r.w); }
#pragma unroll
            for (int e = 0; e < 8; ++e) lg[e] = wave_sum(lg[e]);
            int i1 = 0; float v1 = lg[0];
#pragma unroll
            for (int e = 1; e < 8; ++e) if (lg[e] > v1) { v1 = lg[e]; i1 = e; }
            int i2 = -1; float v2 = -3.0e38f;
#pragma unroll
            for (int e = 0; e < 8; ++e) if (e != i1 && lg[e] > v2) { v2 = lg[e]; i2 = e; }
            const float e2 = __expf(v2 - v1), g1 = 1.f / (1.f + e2), g2 = e2 / (1.f + e2);
            if (lane == 0) { const int tok = b * SEQ + t; int* tk = (int*)(a->ws + WS_TOPK) + (size_t)tok * 4; tk[0] = i1; tk[1] = i2; ((float*)tk)[2] = g1; ((float*)tk)[3] = g2;
                atomicAdd((unsigned*)&lcnt[i1], 1u); atomicAdd((unsigned*)&lcnt[i2], 1u); }
        }
    }
    if (L == 1) { __syncthreads(); if (tid < 8) { const unsigned c = lcnt[tid]; if (c) __hip_atomic_fetch_add((unsigned*)(a->ws + WS_CTL) + CW_CNT + tid, c, __ATOMIC_RELAXED, __HIP_MEMORY_SCOPE_AGENT); } __syncthreads(); }
}
constexpr int LDS_CTL_OFF = 131072;
__device__ __forceinline__ LAS int* moe_offsets(ArgsP a, LAS unsigned char* lds, int tid) {
    LAS int* toff = (LAS int*)(lds + LDS_CTL_OFF);
    __syncthreads();
    if (tid == 0) { int acc = 0;
        for (int e = 0; e < 8; ++e) { toff[e] = acc; const unsigned c = __hip_atomic_load((unsigned*)(a->ws + WS_CTL) + CW_CNT + e, __ATOMIC_RELAXED, __HIP_MEMORY_SCOPE_AGENT); toff[16 + e] = (int)c; acc += (int)((c + 255u) >> 8); }
        toff[8] = acc; }
    __syncthreads();
    return toff;
}
__device__ __forceinline__ void phase_moe_slots(ArgsP a, LAS unsigned char* lds, int gw, int ngw, int tid, int lane) {
    LAS int* toff = moe_offsets(a, lds, fresh_tid());
    unsigned* ctl = (unsigned*)(a->ws + WS_CTL); int* SLOT = (int*)(a->ws + WS_SLOT); int* IDX = (int*)(a->ws + WS_IDX); const int* TOPK = (const int*)(a->ws + WS_TOPK);
    const int wave = tid >> 6;
    for (int e = blockIdx.x; e < 8; e += gridDim.x) { const int c = toff[16 + e], s0 = toff[e] * 256 + c, n = ((c + 255) & ~255) - c;
        for (int i = tid; i < n; i += NTHREADS) IDX[s0 + i] = 0; }
    for (int grp = blockIdx.x; grp < NTOK / 64; grp += gridDim.x) {
        if (wave == 0) {
            const int tok = grp * 64 + lane, b = tok / SEQ, t = tok % SEQ, row = b * TPB + t;
            const int e1 = TOPK[tok * 4], e2 = TOPK[tok * 4 + 1]; int s0 = 0, s1 = 0;
            unsigned long long msk[8]; int nmine = 0;
#pragma unroll
            for (int e = 0; e < 8; ++e) { msk[e] = __ballot((e1 == e) || (e2 == e)); nmine = (lane == e) ? __popcll(msk[e]) : nmine; }
            unsigned base = 0; if (lane < 8 && nmine) base = __hip_atomic_fetch_add(ctl + CW_CUR + lane, (unsigned)nmine, __ATOMIC_RELAXED, __HIP_MEMORY_SCOPE_AGENT);
#pragma unroll
            for (int e = 0; e < 8; ++e) { const unsigned be = __shfl(base, e);
                const int slot = toff[e] * 256 + (int)be + __popcll(msk[e] & ((1ull << lane) - 1ull));
                if (e1 == e) s0 = slot; if (e2 == e) s1 = slot; }
            SLOT[tok * 2] = s0; SLOT[tok * 2 + 1] = s1; IDX[s0] = row; IDX[s1] = row;
        }
    }
    __syncthreads();
}
template <int L> __device__ __forceinline__ void phase_row_end(ArgsP a, int gw, int ngw, int lane) {
    bf16_t* X = (bf16_t*)(a->ws + WS_X); bf16_t* H = (bf16_t*)(a->ws + WS_H); const float* MOD = (const float*)(a->ws + WS_MOD); const bf16_t* Y = (const bf16_t*)(a->ws + WS_Y);
    for (int row = gw; row < NR; row += ngw) {
        const int b = row / TPB, t = row % TPB; const bool lat = t < SEQ; const int v = lat ? b : 4;
        if (L == 1 && !lat) continue;
        const float* mv = MOD + (size_t)(L * 5 + v) * MODW;
        f32x4 y[8], x[8], h[8];
        if (L == 0 && !lat) { const bf16_t* P = (const bf16_t*)(a->ws + WS_PART_B) + (size_t)(b * CTX + (t - SEQ)) * D; ld_row_bf16(P, lane, y);
#pragma unroll
            for (int s = 1; s < 8; ++s) { f32x4 p[8]; ld_row_bf16(P + (size_t)s * (NB * CTX) * D, lane, p);
#pragma unroll
                for (int j = 0; j < 8; ++j) y[j] = y[j] + p[j]; } }
        else if (L == 0) ld_row_bf16(Y + (size_t)row * D, lane, y);
        else { const int tok = b * SEQ + t; const int* sl = (const int*)(a->ws + WS_SLOT) + tok * 2; const float* tk = (const float*)(a->ws + WS_TOPK) + (size_t)tok * 4; const float g1 = tk[2], g2 = tk[3];
            f32x4 y2[8]; ld_row_bf16(Y + (size_t)sl[0] * D, lane, y); ld_row_bf16(Y + (size_t)sl[1] * D, lane, y2);
#pragma unroll
            for (int j = 0; j < 8; ++j) y[j] = y[j] * g1 + y2[j] * g2; }
        ld_row_bf16(X + (size_t)row * D, lane, x);
        const float r1 = row_rstd(y);
#pragma unroll
        for (int j = 0; j < 8; ++j) { const int c = 4 * lane + 256 * j; const f32x4 gv = *(const f32x4*)(a->in[I_GFFNPOST] + L * D + c), gt = *(const f32x4*)(mv + 5 * D + c);
            x[j] = x[j] + gt * (y[j] * r1 * gv); }
        if (L == 0) { st_row_bf16(X + (size_t)row * D, lane, x); const float* mn = MOD + (size_t)(1 * 5 + v) * MODW;
            norm_mod_store(x, a->in[I_GMIXPRE] + D, mn + 0 * D, mn + 1 * D, H + (size_t)row * D, lane, h); }
        else st_row_f32(a->out + ((size_t)b * SEQ + t) * D, lane, x);
    }
}

template <int L> __device__ __forceinline__ void phase_qkpost(ArgsP a, LAS unsigned char* lds, int gw, int ngw, int tid, int lane) {
    bf16_t* QKV = (bf16_t*)(a->ws + WS_QKV);
    const float L2T = 13.287712379549449f;
    LAS f32x2* tg = (LAS f32x2*)lds; LAS f32x2* td = tg + 64 * 32;
    for (int i = tid; i < 64 * 32 + 64 * 16; i += NTHREADS) { float s_, c_;
        if (i < 64 * 32) { sincosf((float)(i >> 5) * exp2f(-(float)(i & 31) * (1.f / 32.f) * L2T), &s_, &c_); tg[i] = (f32x2){c_, s_}; }
        else { const int q_ = i - 64 * 32; sincosf((float)(q_ >> 4) * exp2f(-(float)(q_ & 15) * (1.f / 16.f) * L2T), &s_, &c_); td[q_] = (f32x2){c_, s_}; } }
    __syncthreads();
    const float qn0 = a->in[I_QNORM][L * 128 + lane], qn1 = a->in[I_QNORM][L * 128 + 64 + lane], kn0 = a->in[I_KNORM][L * 128 + lane], kn1 = a->in[I_KNORM][L * 128 + 64 + lane];
    for (int row = gw; row < NR; row += ngw) {
        const int t = row % TPB; const bool lat = t < SEQ; const int gr = t >> 6, gc = t & 63;
        bf16_t* q = QKV + (size_t)row * INW;
        const f32x2 t_r = tg[gr * 32 + (lane & 31)], t_c = tg[gc * 32 + (lane & 31)], t_d = td[(lane < 32 ? gr : gc) * 16 + (lane & 15)];
        const float cr = t_r.x, sr = t_r.y, cc = t_c.x, sc2 = t_c.y, cd = t_d.x, sd = t_d.y;
        float e0[10], e1[10], f0[8], f1[8];
#pragma unroll
        for (int hd = 8; hd < 10; ++hd) { const int base = hd < 8 ? 1536 + hd * 128 : 2560 + (hd - 8) * 128; e0[hd] = bf2f(q[base + lane]); e1[hd] = bf2f(q[base + 64 + lane]); }
        if (lat) {
#pragma unroll
            for (int bl = 4; bl < 8; ++bl) { const int base = 3072 + bl * 128; f0[bl] = bf2f(q[base + lane]); f1[bl] = bf2f(q[base + 64 + lane]); } }
#pragma unroll
        for (int hd = 8; hd < 10; ++hd) {
            const int base = hd < 8 ? 1536 + hd * 128 : 2560 + (hd - 8) * 128;
            float x0 = e0[hd], x1 = e1[hd];
            const float r = rsqrtf(wave_sum(x0 * x0 + x1 * x1) * (1.f / 128.f) + EPS);
            x0 = x0 * r * (hd < 8 ? qn0 : kn0); x1 = x1 * r * (hd < 8 ? qn1 : kn1);
            if (lat) { const float p0 = __shfl_xor(x0, 32), p1 = __shfl_xor(x1, 32);
                if (lane < 32) { x0 = x0 * cr - p0 * sr; x1 = x1 * cc - p1 * sc2; } else { x0 = x0 * cr + p0 * sr; x1 = x1 * cc + p1 * sc2; } }
            q[base + lane] = f2bf(x0); q[base + 64 + lane] = f2bf(x1);
        }
        if (lat) {
#pragma unroll
            for (int bl = 4; bl < 8; ++bl) {
                const int base = 3072 + bl * 128;
                float x0 = f0[bl], x1 = f1[bl];
                const float p0 = __shfl_xor(x0, 16), p1 = __shfl_xor(x1, 16);
                if ((lane & 16) == 0) { x0 = x0 * cd - p0 * sd; x1 = x1 * cd - p1 * sd; } else { x0 = x0 * cd + p0 * sd; x1 = x1 * cd + p1 * sd; }
                q[base + lane] = f2bf(x0); q[base + 64 + lane] = f2bf(x1);
            }
        }
    }
}

namespace att {
typedef short s16x4 __attribute__((ext_vector_type(4)));
typedef float f32x16 __attribute__((ext_vector_type(16)));
constexpr int KVBLK = 64;
constexpr int SHM_V = KVBLK * 128 * 2, SHM_K = KVBLK * 128 * 2;
constexpr float THR = 8.f;
#define KSWZ(row, colB) ((row) * 256 + ((colB) ^ (((row) & 7) << 4)))
#define SBAR() __builtin_amdgcn_sched_barrier(0)
__device__ __forceinline__ int crow(int r, int hi) { return (r & 3) + 8 * (r >> 2) + 4 * hi; }
__device__ __forceinline__ unsigned cvtpk(float lo, float hi) { unsigned r; asm volatile("v_cvt_pk_bf16_f32 %0, %1, %2" : "=v"(r) : "v"(lo), "v"(hi)); return r; }
constexpr float THRL = 64.f;
template <int MODE> __device__ __forceinline__ void partialSM(f32x16& p0, f32x16& p1, float& m_reg, float& mn, float& alpha, bool chk = true) {
  mn = m_reg; alpha = 1.f;
  if (chk) {
    float pmax = p0[0];
#pragma unroll
    for (int r = 1; r < 16; ++r) pmax = fmaxf(pmax, p0[r]);
#pragma unroll
    for (int r = 0; r < 16; ++r) pmax = fmaxf(pmax, p1[r]);
    { auto rr = __builtin_amdgcn_permlane32_swap(__float_as_uint(pmax), __float_as_uint(pmax), false, false);
      pmax = fmaxf(__uint_as_float(rr[0]), __uint_as_float(rr[1])); }
    if (!__builtin_expect(__all(pmax - m_reg <= THRL), 1)) { mn = fmaxf(m_reg, pmax); alpha = __builtin_amdgcn_exp2f(m_reg - mn); m_reg = mn; }
  }
  if (__builtin_expect(__any(mn != 0.f), 0)) {
#pragma unroll
    for (int r = 0; r < 16; ++r) { p0[r] -= mn; p1[r] -= mn; }
  }
#pragma unroll
  for (int r = 0; r < 16; ++r) p0[r] = __builtin_amdgcn_exp2f(p0[r]);
}
template <bool LSUM = false> __device__ __forceinline__ void finishSM(f32x16& p0, f32x16& p1, float alpha, float& l_reg, bf16x8& pa0, bf16x8& pa1, bf16x8& pa2, bf16x8& pa3) {
#pragma unroll
  for (int r = 0; r < 16; ++r) p1[r] = __builtin_amdgcn_exp2f(p1[r]);
  if (!LSUM) { float ps = 0;
#pragma unroll
  for (int r = 0; r < 16; ++r) ps += p0[r];
#pragma unroll
  for (int r = 0; r < 16; ++r) ps += p1[r];
  { auto rr = __builtin_amdgcn_permlane32_swap(__float_as_uint(ps), __float_as_uint(ps), false, false);
    ps = __uint_as_float(rr[0]) + __uint_as_float(rr[1]); }
  l_reg = l_reg * alpha + ps; }
#define PK4(P, BASE, OUT) do { unsigned a0 = cvtpk(P[BASE + 0], P[BASE + 1]), a1 = cvtpk(P[BASE + 2], P[BASE + 3]);   \
    unsigned b0 = cvtpk(P[BASE + 4], P[BASE + 5]), b1 = cvtpk(P[BASE + 6], P[BASE + 7]);                              \
    auto r0 = __builtin_amdgcn_permlane32_swap(a0, b0, false, false); auto r1 = __builtin_amdgcn_permlane32_swap(a1, b1, false, false); \
    u32x4 w = {r0[0], r1[0], r0[1], r1[1]}; OUT = *reinterpret_cast<bf16x8*>(&w); } while (0)
  PK4(p0, 0, pa0); PK4(p0, 8, pa1); PK4(p1, 0, pa2); PK4(p1, 8, pa3);
#undef PK4
}
template <int NQ> __device__ __forceinline__ void qkt(f32x16& p0, f32x16& p1, const LAS unsigned char* Ks, const bf16x8* qr, int r32, int hi, int mapoff) {
  p0 = f32x16{}; p1 = f32x16{};
#pragma unroll
  for (int d0 = 0; d0 < NQ; ++d0) { int cb = (mapoff + d0 * 16 + hi * 8) * 2;
    bf16x8 b0 = *reinterpret_cast<const LAS bf16x8*>(Ks + KSWZ(r32, cb));
    bf16x8 b1 = *reinterpret_cast<const LAS bf16x8*>(Ks + KSWZ(32 + r32, cb));
    p0 = __builtin_amdgcn_mfma_f32_32x32x16_bf16(b0, qr[d0], p0, 0, 0, 0);
    p1 = __builtin_amdgcn_mfma_f32_32x32x16_bf16(b1, qr[d0], p1, 0, 0, 0); }
}
__device__ __forceinline__ int v_st(int k, int c) { const int kk = (k & ~0xC) | ((k & 4) << 1) | ((k & 8) >> 1); return ((kk >> 3) * 4 + (c >> 5)) * 512 + ((kk & 7) * 32 + (c & 31)) * 2; }
__device__ __forceinline__ int v_rd_base(int lane) { return ((lane & 3) << 3) | (((lane >> 2) & 3) << 6) | (((lane >> 4) & 1) << 5) | (((lane >> 5) & 1) << 8); }
constexpr int v_rd_off(int d0, int ks, int half) { return d0 * 512 + ks * 4096 + half * 2048; }
template <int OFF> __device__ __forceinline__ s16x4 tr_read(int vb) {
  s16x4 r; asm volatile("ds_read_b64_tr_b16 %0, %1 offset:%2" : "=&v"(r) : "v"(vb), "i"(OFF) : "memory"); return r;
}
template <int D0> __device__ __forceinline__ void pv_one(f32x16& od, int vb, bf16x8 pa0, bf16x8 pa1, bf16x8 pa2, bf16x8 pa3) {
  const s16x4 l0 = tr_read<v_rd_off(D0, 0, 0)>(vb), h0 = tr_read<v_rd_off(D0, 0, 1)>(vb), l1 = tr_read<v_rd_off(D0, 1, 0)>(vb), h1 = tr_read<v_rd_off(D0, 1, 1)>(vb);
  const s16x4 l2 = tr_read<v_rd_off(D0, 2, 0)>(vb), h2 = tr_read<v_rd_off(D0, 2, 1)>(vb), l3 = tr_read<v_rd_off(D0, 3, 0)>(vb), h3 = tr_read<v_rd_off(D0, 3, 1)>(vb);
  asm volatile("s_waitcnt lgkmcnt(0)" ::: "memory"); SBAR();
#define PK(L, H) (bf16x8){L[0], L[1], L[2], L[3], H[0], H[1], H[2], H[3]}
  od = __builtin_amdgcn_mfma_f32_32x32x16_bf16(pa0, PK(l0, h0), od, 0, 0, 0);
  od = __builtin_amdgcn_mfma_f32_32x32x16_bf16(pa1, PK(l1, h1), od, 0, 0, 0);
  od = __builtin_amdgcn_mfma_f32_32x32x16_bf16(pa2, PK(l2, h2), od, 0, 0, 0);
  od = __builtin_amdgcn_mfma_f32_32x32x16_bf16(pa3, PK(l3, h3), od, 0, 0, 0);
#undef PK
}
__device__ __forceinline__ void lsum_mm(f32x16& lacc, bf16x8 onesB, bf16x8 pa0, bf16x8 pa1, bf16x8 pa2, bf16x8 pa3) {
  lacc = __builtin_amdgcn_mfma_f32_32x32x16_bf16(pa0, onesB, lacc, 0, 0, 0); lacc = __builtin_amdgcn_mfma_f32_32x32x16_bf16(pa1, onesB, lacc, 0, 0, 0);
  lacc = __builtin_amdgcn_mfma_f32_32x32x16_bf16(pa2, onesB, lacc, 0, 0, 0); lacc = __builtin_amdgcn_mfma_f32_32x32x16_bf16(pa3, onesB, lacc, 0, 0, 0);
}
__device__ __forceinline__ void pv_d0(f32x16* o, int vb, bf16x8 pa0, bf16x8 pa1, bf16x8 pa2, bf16x8 pa3) {
  pv_one<0>(o[0], vb, pa0, pa1, pa2, pa3); pv_one<1>(o[1], vb, pa0, pa1, pa2, pa3); pv_one<2>(o[2], vb, pa0, pa1, pa2, pa3); pv_one<3>(o[3], vb, pa0, pa1, pa2, pa3);
}
template <int MODE>
__device__ __forceinline__ void attn_body(const bf16_t* __restrict__ Qb, const bf16_t* __restrict__ Kh, const bf16_t* __restrict__ Vh, bf16_t* __restrict__ Ob, int seq, LAS unsigned char* lds,
                                          float lam, float osc, const float* __restrict__ subln, int na_r0 = 0, int na_R0 = 0, int qproc = 0, const float* __restrict__ qnw = nullptr, int trow0 = 0) {
  constexpr int NQ = MODE == 1 ? 4 : 8;
  const int tid = threadIdx.x, wid = __builtin_amdgcn_readfirstlane(tid >> 6), lane = tid & 63, r32 = lane & 31, hi = lane >> 5;
  const int wrow = MODE == 1 ? (wid & 3) : wid, mapoff = MODE == 1 ? (wid >> 2) * 64 : 0;
  LAS unsigned char* V_lds = lds; LAS unsigned char* K_lds = lds + 2 * SHM_V;
  LAS float* wsf = (LAS float*)(lds + 2 * SHM_V + 2 * SHM_K) + wid * 64; LAS float* li_l = wsf; LAS float* al_l = wsf + 32;
  constexpr bool LSUM = (MODE == 1);
  float m_reg = 0.f, l_reg = 0; f32x16 o[4] = {}; bf16x8 qr[NQ]; f32x16 lacc = {};
  bf16x8 onesB; { const short one_ = (r32 == 0) ? (short)0x3F80 : (short)0; onesB = (bf16x8){one_, one_, one_, one_, one_, one_, one_, one_}; }
  const bf16_t* Qw = Qb + (size_t)(wrow * 32 + r32) * INW + mapoff + hi * 8;
  { const LAS f32x2* tg = (const LAS f32x2*)(lds + 73728); const LAS f32x2* td = tg + 64 * 32;
    const int trow = trow0 + wrow * 32 + r32, gr = trow >> 6, gc = trow & 63;
    constexpr float CQ = (MODE == 1 ? 0.125f : 0.088388347648318440f) * 1.4426950408889634f;
#define QLD(X, D0) do { const u32x4 w_ = *reinterpret_cast<const u32x4*>(Qw + (D0) * 16); X[0] = bf_lo(w_.x); X[1] = bf_hi(w_.x); X[2] = bf_lo(w_.y); X[3] = bf_hi(w_.y); X[4] = bf_lo(w_.z); X[5] = bf_hi(w_.z); X[6] = bf_lo(w_.w); X[7] = bf_hi(w_.w); } while (0)
#define QPK(X, D0, SC) do { u32x4 s_; s_.x = cvtpk(X[0] * (SC), X[1] * (SC)); s_.y = cvtpk(X[2] * (SC), X[3] * (SC)); s_.z = cvtpk(X[4] * (SC), X[5] * (SC)); s_.w = cvtpk(X[6] * (SC), X[7] * (SC)); qr[D0] = *reinterpret_cast<bf16x8*>(&s_); } while (0)
    float rr = 1.f;
    if (MODE == 0 && qproc >= 1) { float ss = 0.f;
#pragma unroll
      for (int d0 = 0; d0 < NQ; ++d0) { float x[8]; QLD(x, d0);
#pragma unroll
        for (int e = 0; e < 8; ++e) ss += x[e] * x[e]; }
      ss += __shfl_xor(ss, 32); rr = rsqrtf(ss * (1.f / 128.f) + EPS); }
    constexpr int NPAIR = NQ / 2, PSTEP = MODE == 1 ? 1 : 2;
#pragma unroll
    for (int pr = 0; pr < NPAIR; ++pr) {
      const int da = MODE == 1 ? 2 * pr : 4 * (pr >> 1) + (pr & 1), db = da + PSTEP;
      float xa[8], xb[8]; QLD(xa, da); QLD(xb, db);
      if (MODE == 0 && qproc >= 1) { const f32x4 ga0 = *(const f32x4*)(qnw + 16 * da + 8 * hi), ga1 = *(const f32x4*)(qnw + 16 * da + 8 * hi + 4), gb0 = *(const f32x4*)(qnw + 16 * db + 8 * hi), gb1 = *(const f32x4*)(qnw + 16 * db + 8 * hi + 4);
#pragma unroll
        for (int e = 0; e < 4; ++e) { xa[e] *= rr * ga0[e]; xa[4 + e] *= rr * ga1[e]; xb[e] *= rr * gb0[e]; xb[4 + e] *= rr * gb1[e]; } }
      if (qproc == 2) {
        const LAS f32x2* tb = MODE == 1 ? td + (pr ? gc : gr) * 16 + 8 * hi : tg + ((pr >> 1) ? gc : gr) * 32 + 16 * (pr & 1) + 8 * hi;
#pragma unroll
        for (int e = 0; e < 8; ++e) { const f32x2 cs = tb[e]; const float x1 = xa[e], x2 = xb[e]; xa[e] = x1 * cs.x - x2 * cs.y; xb[e] = x2 * cs.x + x1 * cs.y; } }
      QPK(xa, da, CQ); QPK(xb, db, CQ);
    }
#undef QLD
#undef QPK
  }
  const int sr = tid >> 4, sc = (tid & 15) * 8, vst0 = v_st(sr, sc), vst1 = v_st(32 + sr, sc);
  const int vb0 = (int)(uintptr_t)V_lds + v_rd_base(lane);
  struct { bf16x8 vs0, vs1, ks0, ks1; } sr_[1];
#define TOK(T) (MODE == 2 ? ((T) < 4 ? SEQ + 64 * (T) : (na_R0 + (T) - 4) * 64) : (T) * KVBLK)
  const unsigned kvoff = (unsigned)(sr * INW + sc) * 2u;
#define SLOAD(i, T) do { const size_t tb_ = (size_t)TOK(T) * (INW * 2); const char* vb_ = (const char*)Vh + tb_; const char* kb_ = (const char*)Kh + tb_; \
    sr_[i].vs0 = *(const bf16x8*)(vb_ + kvoff); sr_[i].vs1 = *(const bf16x8*)(vb_ + (size_t)32 * INW * 2 + kvoff); \
    sr_[i].ks0 = *(const bf16x8*)(kb_ + kvoff); sr_[i].ks1 = *(const bf16x8*)(kb_ + (size_t)32 * INW * 2 + kvoff); } while (0)
  LAS float* rpbL = (LAS float*)(lds + 2 * SHM_V + 2 * SHM_K + 2048);
  const int na_rq = na_r0 + (wid >> 1), na_rs = min(max(na_rq - 4, 0), 56);
#define NABIAS(P0, P1, T) do { if (MODE == 2 && (T) >= 4) { const int na_c = ((wid & 1) << 5) + r32, na_t = 4 * hi - min(max(na_c - 8, 0), 48); \
    const int kr_ = na_R0 + (T) - 4; const bool rowok_ = kr_ >= na_rs && kr_ < na_rs + 8; const LAS float* bp_ = rpbL + (172 + (kr_ - na_rq + 7) * 31 + 15 - na_c + 4 * hi); \
    _Pragma("unroll") for (int r = 0; r < 16; ++r) { const int kq_ = (r & 3) + 8 * (r >> 2); \
      { const bool ok_ = rowok_ && (unsigned)(na_t + kq_) < 16u; P0[r] = ok_ ? fmaf(bp_[kq_], 1.4426950408889634f, P0[r]) : -1e30f; } \
      { const bool ok_ = rowok_ && (unsigned)(na_t + kq_ + 32) < 16u; P1[r] = ok_ ? fmaf(bp_[kq_ + 32], 1.4426950408889634f, P1[r]) : -1e30f; } } } } while (0)
#define SWRITE(b, i) do { *(LAS bf16x8*)(V_lds + (b) * SHM_V + vst0) = sr_[i].vs0;          \
    *(LAS bf16x8*)(V_lds + (b) * SHM_V + vst1) = sr_[i].vs1; int kc = sc * 2;               \
    *(LAS bf16x8*)(K_lds + (b) * SHM_K + KSWZ(sr, kc)) = sr_[i].ks0;                       \
    *(LAS bf16x8*)(K_lds + (b) * SHM_K + KSWZ(32 + sr, kc)) = sr_[i].ks1; } while (0)
#define SWAIT() asm volatile("s_waitcnt vmcnt(0)" ::: "memory")
#define RESC(a) do { if (__any((a) < 1.f)) { if (hi == 0) al_l[r32] = (a); asm volatile("s_waitcnt lgkmcnt(0)" ::: "memory"); \
    _Pragma("unroll") for (int d = 0; d < 4; ++d) _Pragma("unroll") for (int r = 0; r < 16; ++r) o[d][r] *= al_l[crow(r, hi)]; \
    if (LSUM) { _Pragma("unroll") for (int r = 0; r < 16; ++r) lacc[r] *= al_l[crow(r, hi)]; } } } while (0)
  f32x16 pA0, pA1, pB0, pB1; float mnA, mnB, alA, alB; bf16x8 pa0, pa1, pa2, pa3; const int NT = seq / KVBLK;
  if (MODE == 2) { for (int i = tid; i < 832; i += 512) { const int q = i - 172, dr = q >= 0 ? q / 31 : -1, dc = q - dr * 31; rpbL[i] = (q >= 0 && dr < 15) ? subln[dr * 31 + dc] : 0.f; } }
  SLOAD(0, 0); SWAIT(); SWRITE(0, 0); SLOAD(0, 1); __syncthreads();
  qkt<NQ>(pA0, pA1, K_lds, qr, r32, hi, mapoff); NABIAS(pA0, pA1, 0); partialSM<MODE>(pA0, pA1, m_reg, mnA, alA);
  SWAIT(); SWRITE(1, 0); if (2 < NT) SLOAD(0, 2); __syncthreads();
  for (int j = 1; j + 1 < NT; j += 2) {
    SBAR(); qkt<NQ>(pB0, pB1, K_lds + SHM_K, qr, r32, hi, mapoff);
    finishSM<LSUM>(pA0, pA1, alA, l_reg, pa0, pa1, pa2, pa3); SBAR();
    pv_d0(o, vb0, pa0, pa1, pa2, pa3); if (LSUM) lsum_mm(lacc, onesB, pa0, pa1, pa2, pa3); NABIAS(pB0, pB1, j); partialSM<MODE>(pB0, pB1, m_reg, mnB, alB, MODE == 2 || (j & 3) == 1);
    __syncthreads(); SWAIT(); SWRITE(0, 0); SLOAD(0, j + 2);
    RESC(alB); __syncthreads();
    SBAR(); qkt<NQ>(pA0, pA1, K_lds, qr, r32, hi, mapoff);
    finishSM<LSUM>(pB0, pB1, alB, l_reg, pa0, pa1, pa2, pa3); SBAR();
    pv_d0(o, vb0 + SHM_V, pa0, pa1, pa2, pa3); if (LSUM) lsum_mm(lacc, onesB, pa0, pa1, pa2, pa3); NABIAS(pA0, pA1, j + 1); partialSM<MODE>(pA0, pA1, m_reg, mnA, alA, MODE == 2);
    __syncthreads(); SWAIT(); SWRITE(1, 0); if (j + 3 < NT) SLOAD(0, j + 3);
    RESC(alA); __syncthreads();
  }
  SBAR(); qkt<NQ>(pB0, pB1, K_lds + SHM_K, qr, r32, hi, mapoff);
  finishSM<LSUM>(pA0, pA1, alA, l_reg, pa0, pa1, pa2, pa3); SBAR();
  pv_d0(o, vb0, pa0, pa1, pa2, pa3); if (LSUM) lsum_mm(lacc, onesB, pa0, pa1, pa2, pa3); NABIAS(pB0, pB1, NT - 1); partialSM<MODE>(pB0, pB1, m_reg, mnB, alB);
  __syncthreads(); RESC(alB);
  finishSM<LSUM>(pB0, pB1, alB, l_reg, pa0, pa1, pa2, pa3); SBAR();
  pv_d0(o, vb0 + SHM_V, pa0, pa1, pa2, pa3); if (LSUM) lsum_mm(lacc, onesB, pa0, pa1, pa2, pa3);
  if (hi == 0) li_l[r32] = l_reg; asm volatile("s_waitcnt lgkmcnt(0)" ::: "memory");
  float rli[16];
#pragma unroll
  for (int r = 0; r < 16; ++r) { if (LSUM) { const float la = __int_as_float(__builtin_amdgcn_readlane(__float_as_int(lacc[r]), 0)), lb = __int_as_float(__builtin_amdgcn_readlane(__float_as_int(lacc[r]), 32)); rli[r] = __builtin_amdgcn_rcpf(hi ? lb : la); }
    else rli[r] = __builtin_amdgcn_rcpf(li_l[crow(r, hi)]); }
  bf16_t* Ow = Ob + (size_t)(wrow * 32) * D;
  if (MODE != 1) {
#pragma unroll
    for (int r = 0; r < 16; ++r) { const int orow = crow(r, hi);
#pragma unroll
      for (int d0 = 0; d0 < 4; ++d0) Ow[(size_t)orow * D + d0 * 32 + r32] = f2bf(o[d0][r] * rli[r]); }
    __syncthreads();
  } else {
#pragma unroll
    for (int r = 0; r < 16; ++r)
#pragma unroll
      for (int d0 = 0; d0 < 4; ++d0) o[d0][r] *= rli[r];
    __syncthreads();
    LAS float* xb = (LAS float*)lds + (wid & 3) * 4096;
    if (wid >= 4) {
#pragma unroll
      for (int r = 0; r < 16; ++r)
#pragma unroll
        for (int d0 = 0; d0 < 4; ++d0) xb[crow(r, hi) * 128 + d0 * 32 + r32] = o[d0][r];
    }
    __syncthreads();
    if (wid < 4) {
      float sg[4];
#pragma unroll
      for (int d0 = 0; d0 < 4; ++d0) sg[d0] = subln[d0 * 32 + r32] * osc;
#pragma unroll
      for (int r = 0; r < 16; ++r) { float ss = 0.f;
#pragma unroll
        for (int d0 = 0; d0 < 4; ++d0) { o[d0][r] -= lam * xb[crow(r, hi) * 128 + d0 * 32 + r32]; ss += o[d0][r] * o[d0][r]; }
#pragma unroll
        for (int x = 1; x < 32; x <<= 1) ss += __shfl_xor(ss, x);
        const float rr = rsqrtf(ss * (1.f / 128.f) + EPS); const int orow = crow(r, hi);
#pragma unroll
        for (int d0 = 0; d0 < 4; ++d0) Ow[(size_t)orow * D + d0 * 32 + r32] = f2bf(o[d0][r] * rr * sg[d0]); }
    }
    __syncthreads();
  }
#undef SLOAD
#undef TOK
#undef NABIAS
#undef SWRITE
#undef SWAIT
#undef RESC
}
}

namespace pg8 {
constexpr int BM = 256, BK = 64, HALF = 128, HTB = HALF * BK * 2, STAGE_BYTES = 8 * HTB, NXCD = 8, WGM = 8;
__host__ __device__ __forceinline__ int lds_byte(int r, int c) { const int st = (r >> 4) * 2 + (c >> 5), rr = r & 15, cc = c & 31, ob = rr * 64 + cc * 2; return st * 1024 + (ob ^ (((ob >> 9) & 1) << 5)); }
__host__ __device__ __forceinline__ void stage_rc(int b, int& R, int& C) { const int st = b / 1024, sb = b % 1024, swz = sb ^ (((sb >> 9) & 1) << 5); R = (st >> 1) * 16 + swz / 64; C = (st & 1) * 32 + (swz % 64) / 2; }
__host__ __device__ __forceinline__ int perm32(int rho) { const int n = rho >> 4, i = rho & 15; return 8 * (i >> 2) + 4 * n + (i & 3); }
struct Unit { int pm, pn; size_t boff; int kt0, nt, split; };
struct Gemm { const void* A; const void* Bt; int KB; const int* idx = nullptr; };
typedef int v8i __attribute__((ext_vector_type(8))); typedef int v4i __attribute__((ext_vector_type(4)));
template <bool SKIPCTX> struct StaticOrder {
    int nM, nN, nwg, G, c, ntk;
    __device__ void init(int nM_, int nN_, int G_, int c_, int ntk_) { nM = nM_; nN = nN_; nwg = nM * nN; G = G_; c = c_; ntk = ntk_; }
    __device__ bool next(int i, Unit& u) const {
        const long L = (long)i * G + c; if (L >= nwg) return false;
        int wgid = (int)L; { const int q = nwg / NXCD, r = nwg % NXCD, xcd = wgid % NXCD, off = wgid / NXCD; wgid = (xcd < r ? xcd * (q + 1) : r * (q + 1) + (xcd - r) * q) + off; }
        const int nig = WGM * nN, gid = wgid / nig, fm = gid * WGM, gsz = (nM - fm) < WGM ? (nM - fm) : WGM;
        int pm = fm + ((wgid % nig) % gsz); u.pn = (wgid % nig) / gsz; if (SKIPCTX) pm += pm >> 4; u.pm = pm; u.boff = 0; u.kt0 = 0; u.nt = ntk; u.split = -1; return true;
    }
};
struct SplitCtxOrder {
    StaticOrder<true> lat; int ntk;
    __device__ void init(int G_, int c_, int ntk_) { lat.init(NTOK / 256, D / 256, G_, c_, ntk_); ntk = ntk_; }
    __device__ bool next(int i, Unit& u) const {
        const long L = (long)i * lat.G + lat.c;
        if (L < lat.nwg) return lat.next(i, u);
        const int q = (int)(L - lat.nwg); if (q >= 256) return false;
        const int s = q >> 5, pc = (q >> 3) & 3; u.pn = q & 7; u.pm = 17 * pc + 16; u.boff = 0; u.split = s;
        const int pairs = ntk >> 1, base = pairs >> 3, rem = pairs & 7;
        u.kt0 = 2 * (s * base + (s < rem ? s : rem)); u.nt = 2 * (base + (s < rem ? 1 : 0)); return true;
    }
};
struct MoeOrder {
    int nM, nN, nwg, G, c, ntk; int toff[8]; size_t bstride;
    __device__ void init(const LAS int* t, int nN_, int G_, int c_, size_t bstride_, int ntk_) { ntk = ntk_; for (int e = 0; e < 8; ++e) toff[e] = __builtin_amdgcn_readfirstlane(t[e]); nM = __builtin_amdgcn_readfirstlane(t[8]); nN = nN_; nwg = nM * nN; G = G_; c = c_; bstride = bstride_; }
    __device__ bool next(int i, Unit& u) const {
        const long L = (long)i * G + c; if (L >= nwg) return false;
        int wgid = (int)L; { const int q = nwg / NXCD, r = nwg % NXCD, xcd = wgid % NXCD, off = wgid / NXCD; wgid = (xcd < r ? xcd * (q + 1) : r * (q + 1) + (xcd - r) * q) + off; }
        const int nig = WGM * nN, gid = wgid / nig, fm = gid * WGM, gsz = (nM - fm) < WGM ? (nM - fm) : WGM;
        const int pm = fm + ((wgid % nig) % gsz); u.pn = (wgid % nig) / gsz; u.pm = pm;
        int e = 0;
#pragma unroll
        for (int q = 1; q < 8; ++q) e += (pm >= toff[q]) ? 1 : 0;
        u.boff = (size_t)e * bstride; u.kt0 = 0; u.nt = ntk; u.split = -1; return true;
    }
};
template <bool SCALED> struct EpiBf16T {
    bf16_t* O; int ldc; float scale;
    __device__ __forceinline__ void operator()(const f32x4 (&acc)[2][2][4][2], const Unit& u, int wr, int wc, int fr, int fq) const {
        const int row0 = u.pm * BM + wr * 64 + fr, col0 = u.pn * BM + wc * 32 + 8 * fq;
#pragma unroll
        for (int ai = 0; ai < 2; ++ai)
#pragma unroll
            for (int m = 0; m < 4; ++m) { bf16_t* rowp = O + (size_t)(row0 + ai * HALF + m * 16) * ldc + col0;
#pragma unroll
                for (int bj = 0; bj < 2; ++bj) { f32x4 v0 = acc[ai][bj][m][0], v1 = acc[ai][bj][m][1]; if (SCALED) { v0 = v0 * scale; v1 = v1 * scale; }
                    u32x4 w; w.x = cvt_pk_bf16(v0[0], v0[1]); w.y = cvt_pk_bf16(v0[2], v0[3]); w.z = cvt_pk_bf16(v1[0], v1[1]); w.w = cvt_pk_bf16(v1[2], v1[3]);
                    *(u32x4*)(rowp + bj * HALF) = w; } }
    }
};
__device__ __forceinline__ float silu_mul(float g, float u) { return g * __builtin_amdgcn_rcpf(1.f + __expf(-g)) * u; }
template <bool SCALED> struct EpiSwigluT {
    bf16_t* O; int ldc;
    __device__ __forceinline__ void operator()(const f32x4 (&acc)[2][2][4][2], const Unit& u, int wr, int wc, int fr, int fq) const {
        const int row0 = u.pm * BM + wr * 64 + fr, col0 = u.pn * HALF + wc * 32 + 8 * fq;
#pragma unroll
        for (int ai = 0; ai < 2; ++ai)
#pragma unroll
            for (int m = 0; m < 4; ++m) { bf16_t* rowp = O + (size_t)(row0 + ai * HALF + m * 16) * ldc + col0;
                constexpr float SI = SCALED ? 1.f / (F8_SH * F8_SW) : 1.f;
                const f32x4 g0 = acc[ai][0][m][0] * SI, g1 = acc[ai][0][m][1] * SI, u0 = acc[ai][1][m][0] * SI, u1 = acc[ai][1][m][1] * SI;
                u32x4 w; w.x = cvt_pk_bf16(silu_mul(g0[0], u0[0]), silu_mul(g0[1], u0[1])); w.y = cvt_pk_bf16(silu_mul(g0[2], u0[2]), silu_mul(g0[3], u0[3]));
                w.z = cvt_pk_bf16(silu_mul(g1[0], u1[0]), silu_mul(g1[1], u1[1])); w.w = cvt_pk_bf16(silu_mul(g1[2], u1[2]), silu_mul(g1[3], u1[3]));
                *(u32x4*)rowp = w; }
    }
};
typedef EpiBf16T<false> EpiBf16;
typedef EpiSwigluT<false> EpiSwiglu;
struct EpiBf16OrPart {
    bf16_t* O; int ldc; bf16_t* PART;
    __device__ __forceinline__ void operator()(const f32x4 (&acc)[2][2][4][2], const Unit& u, int wr, int wc, int fr, int fq) const {
        if (u.split < 0) { EpiBf16 e{O, ldc, 1.f}; e(acc, u, wr, wc, fr, fq); return; }
        Unit v = u; v.pm = u.pm / 17;
        EpiBf16 e{PART + (size_t)u.split * (NB * CTX) * D, D, 1.f}; e(acc, v, wr, wc, fr, fq);
    }
};
struct EpiSwigluF8 {
    unsigned char* O; int ldc;
    __device__ __forceinline__ void operator()(const f32x4 (&acc)[2][2][4][2], const Unit& u, int wr, int wc, int fr, int fq) const {
        const int row0 = u.pm * BM + wr * 64 + fr, col0 = u.pn * HALF + wc * 32 + 8 * fq; constexpr float SI = 1.f / (F8_SH * F8_SW);
#pragma unroll
        for (int ai = 0; ai < 2; ++ai)
#pragma unroll
            for (int m = 0; m < 4; ++m) { unsigned char* rowp = O + (size_t)(row0 + ai * HALF + m * 16) * ldc + col0;
                const f32x4 g0 = acc[ai][0][m][0] * SI, g1 = acc[ai][0][m][1] * SI, u0 = acc[ai][1][m][0] * (SI * F8_SA), u1 = acc[ai][1][m][1] * (SI * F8_SA);
                u32x2 w; w.x = pk4_fp8(silu_mul(g0[0], u0[0]), silu_mul(g0[1], u0[1]), silu_mul(g0[2], u0[2]), silu_mul(g0[3], u0[3]));
                w.y = pk4_fp8(silu_mul(g1[0], u1[0]), silu_mul(g1[1], u1[1]), silu_mul(g1[2], u1[2]), silu_mul(g1[3], u1[3]));
                *(u32x2*)rowp = w; }
    }
};
#ifndef GEMM_SP2
#define GEMM_SP2 1
#endif
#ifndef GEMM_ALIGN
#define GEMM_ALIGN 1
#endif
template <bool FP8, bool GATHER = false, class Epi, class Sched>
__device__ __forceinline__ void gemm_phase(LAS unsigned char* lds, const Gemm g, const Sched& S, const Epi& E) {
    const int tid = threadIdx.x, wid = __builtin_amdgcn_readfirstlane(tid >> 6), lane = tid & 63, wr = wid >> 2, wc = wid & 3, fr = lane & 15, fq = lane >> 4;
    const int KB = g.KB;
    unsigned voffA[2], voffB[2];
#pragma unroll
    for (int i = 0; i < 2; ++i) { int R, C; stage_rc(tid * 16 + i * 8192, R, C); const int Rb = (R & ~31) + perm32(R & 31);
        voffA[i] = (unsigned)(R * KB + C * 2); voffB[i] = (unsigned)(Rb * KB + C * 2); }
    const size_t kstep = (size_t)(BK * 2);
    const size_t hstep = (size_t)HALF * KB;
    const size_t tstep = 2 * hstep;
    const unsigned ldsw = (unsigned)wid * 1024u;
    const int aoff = lds_byte(wr * 64 + fr, fq * 8), boff = lds_byte(wc * 32 + fr, fq * 8);
#define PG8_SA(b, h) (((b) * 2 + (h)) * HTB)
#define PG8_SB(b, h) ((4 + (b) * 2 + (h)) * HTB)
#define PG8_STAGE(bufoff, gbase, voff) do { _Pragma("unroll") for (int _i = 0; _i < 2; ++_i) \
        __builtin_amdgcn_global_load_lds((const unsigned*)((const char*)(gbase) + (voff)[_i]), (LAS unsigned*)(lds + (bufoff) + ldsw + _i * 8192), 16, 0, 0); } while (0)
#define PG8_STG(bufoff, kp, vv) do { _Pragma("unroll") for (int _i = 0; _i < 2; ++_i) \
        __builtin_amdgcn_global_load_lds((const unsigned*)((const char*)(kp) + (vv)[_i]), (LAS unsigned*)(lds + (bufoff) + ldsw + _i * 8192), 16, 0, 0); } while (0)
#define PG8_STA_CUR(bufoff, kp, h) do { if (GATHER) PG8_STG(bufoff, kp, gA[h]); else PG8_STAGE(bufoff, (kp) + (h) * hstep, voffA); } while (0)
#define PG8_STA_NX(bufoff, kp, h) do { if (GATHER) { unsigned _v[2] = {last ? nG[h][0] : gA[h][0], last ? nG[h][1] : gA[h][1]}; PG8_STG(bufoff, kp, _v); } else PG8_STAGE(bufoff, (kp) + (h) * hstep, voffA); } while (0)
#define PG8_LDA(dst, b, h) do { _Pragma("unroll") for (int m = 0; m < 4; ++m) { const v4i _l = *(const LAS v4i*)(lds + PG8_SA(b, h) + aoff + m * 2048), _h = *(const LAS v4i*)(lds + PG8_SA(b, h) + aoff + m * 2048 + 1024); \
        dst[m] = __builtin_shufflevector(_l, _h, 0, 1, 2, 3, 4, 5, 6, 7); } } while (0)
#define PG8_LDB(dst, b, h) do { _Pragma("unroll") for (int n = 0; n < 2; ++n) { const v4i _l = *(const LAS v4i*)(lds + PG8_SB(b, h) + boff + n * 2048), _h = *(const LAS v4i*)(lds + PG8_SB(b, h) + boff + n * 2048 + 1024); \
        dst[n] = __builtin_shufflevector(_l, _h, 0, 1, 2, 3, 4, 5, 6, 7); } } while (0)
#define PG8_H(v, k) __builtin_bit_cast(bf16x8, __builtin_shufflevector(v, v, 4 * (k), 4 * (k) + 1, 4 * (k) + 2, 4 * (k) + 3))
#define PG8_MMA(ai, bj, At, Bt) do { __builtin_amdgcn_s_setprio(1); _Pragma("unroll") for (int m = 0; m < 4; ++m) _Pragma("unroll") for (int n = 0; n < 2; ++n) { \
        if (FP8) asm volatile("v_mfma_f32_16x16x128_f8f6f4 %0, %1, %2, %0" : "+v"(acc[ai][bj][m][n]) : "v"(Bt[n]), "v"(At[m])); \
        else { acc[ai][bj][m][n] = __builtin_amdgcn_mfma_f32_16x16x32_bf16(PG8_H(Bt[n], 0), PG8_H(At[m], 0), acc[ai][bj][m][n], 0, 0, 0); \
               acc[ai][bj][m][n] = __builtin_amdgcn_mfma_f32_16x16x32_bf16(PG8_H(Bt[n], 1), PG8_H(At[m], 1), acc[ai][bj][m][n], 0, 0, 0); } } \
        __builtin_amdgcn_s_setprio(0); } while (0)
#define PG8_WAIT_V(n) asm volatile("s_waitcnt vmcnt(" #n ")" ::: "memory")
#define PG8_WAIT_L(n) asm volatile("s_waitcnt lgkmcnt(" #n ")" ::: "memory")
#define PG8_BAR __builtin_amdgcn_s_barrier()
#define PG8_SCHED __builtin_amdgcn_sched_barrier(0)
    Unit cur, nxt; int ui = 0;
    if (!S.next(0, cur)) return;
    f32x4 acc[2][2][4][2];
#pragma unroll
    for (int a = 0; a < 2; ++a)
#pragma unroll
        for (int b = 0; b < 2; ++b)
#pragma unroll
            for (int m = 0; m < 4; ++m)
#pragma unroll
                for (int n = 0; n < 2; ++n) acc[a][b][m][n] = (f32x4){0.f, 0.f, 0.f, 0.f};
    v8i At[4], B0[2], B1[2];
    unsigned gA[2][2], nG[2][2]; int gR[2], gC[2];
#pragma unroll
    for (int i = 0; i < 2; ++i) { stage_rc(tid * 16 + i * 8192, gR[i], gC[i]); gC[i] *= 2; }
    LAS int* gidx = (LAS int*)(lds + 131072 + 2048);
#pragma unroll
    for (int h = 0; h < 2; ++h)
#pragma unroll
        for (int i = 0; i < 2; ++i) { gA[h][i] = GATHER ? (unsigned)(g.idx[cur.pm * 256 + h * 128 + gR[i]] * KB + gC[i]) : 0u; nG[h][i] = 0u; }
    const char* cA = (const char*)g.A + (GATHER ? (size_t)0 : (size_t)cur.pm * tstep) + (size_t)cur.kt0 * kstep; const char* cB = (const char*)g.Bt + cur.boff + (size_t)cur.pn * tstep + (size_t)cur.kt0 * kstep;
    if (GEMM_SP2) {
        PG8_STAGE(PG8_SB(0, 0), cB, voffB); PG8_STAGE(PG8_SB(0, 1), cB + hstep, voffB); PG8_STA_CUR(PG8_SA(0, 0), cA, 0); PG8_STA_CUR(PG8_SA(0, 1), cA, 1);
        if (wr == 1) PG8_BAR;
        PG8_WAIT_V(2); PG8_BAR;
        PG8_STAGE(PG8_SB(1, 0), cB + kstep, voffB); PG8_STA_CUR(PG8_SA(1, 0), cA + kstep, 0); PG8_STAGE(PG8_SB(1, 1), cB + hstep + kstep, voffB);
        PG8_WAIT_V(6); PG8_BAR;
    } else {
    PG8_STAGE(PG8_SB(0, 0), cB, voffB); PG8_STAGE(PG8_SA(0, 0), cA, voffA); PG8_STAGE(PG8_SB(0, 1), cB + hstep, voffB); PG8_STAGE(PG8_SA(0, 1), cA + hstep, voffA);
    if (wr == 1) PG8_BAR;
    PG8_WAIT_V(4); PG8_BAR;
    PG8_STAGE(PG8_SB(1, 0), cB + kstep, voffB); PG8_STAGE(PG8_SA(1, 0), cA + kstep, voffA); PG8_STAGE(PG8_SB(1, 1), cB + hstep + kstep, voffB);
    PG8_WAIT_V(6); PG8_BAR;
    }
    for (;;) {
        const bool has_next = S.next(ui + 1, nxt);
        const char* nA = has_next ? (const char*)g.A + (GATHER ? (size_t)0 : (size_t)nxt.pm * tstep) + (size_t)nxt.kt0 * kstep : cA;
        if (GATHER && has_next) __builtin_amdgcn_global_load_lds((const unsigned*)(g.idx + nxt.pm * 256 + (wid & 3) * 64 + lane), (LAS unsigned*)(gidx + (wid & 3) * 64), 4, 0, 0); const char* nB = has_next ? (const char*)g.Bt + nxt.boff + (size_t)nxt.pn * tstep + (size_t)nxt.kt0 * kstep : cB;
        const int nt = cur.nt;
        for (int t = 0; t < nt; t += 2) {
            const bool last = (t == nt - 2);
            if (GATHER && last && has_next) {
#pragma unroll
                for (int h = 0; h < 2; ++h)
#pragma unroll
                    for (int i = 0; i < 2; ++i) nG[h][i] = (unsigned)(gidx[h * 128 + gR[i]] * KB + gC[i]); }
            const char* a1 = cA + (size_t)(t + 1) * kstep;
            const char* a2 = last ? nA : cA + (size_t)(t + 2) * kstep; const char* b2 = last ? nB : cB + (size_t)(t + 2) * kstep;
            const char* a3 = a2 + kstep; const char* b3 = b2 + kstep;
            if (GEMM_SP2) {
            PG8_LDB(B0, 0, 0); PG8_LDB(B1, 0, 1); PG8_SCHED; PG8_LDA(At, 0, 0); PG8_STA_CUR(PG8_SA(1, 1), a1, 1);
            PG8_WAIT_V(8); PG8_WAIT_L(0); PG8_BAR; PG8_MMA(0, 0, At, B0); PG8_MMA(0, 1, At, B1); PG8_BAR; PG8_SCHED;
            PG8_LDA(At, 0, 1); PG8_STAGE(PG8_SB(0, 0), b2, voffB); PG8_STAGE(PG8_SB(0, 1), b2 + hstep, voffB); PG8_STA_NX(PG8_SA(0, 0), a2, 0);
            PG8_WAIT_V(8); PG8_WAIT_L(0); PG8_BAR; PG8_MMA(1, 0, At, B0); PG8_MMA(1, 1, At, B1); PG8_BAR; PG8_SCHED;
            PG8_LDB(B0, 1, 0); PG8_LDB(B1, 1, 1); PG8_SCHED; PG8_LDA(At, 1, 0); PG8_STA_NX(PG8_SA(0, 1), a2, 1);
            PG8_WAIT_V(8); PG8_WAIT_L(0); PG8_BAR; PG8_MMA(0, 0, At, B0); PG8_MMA(0, 1, At, B1); PG8_BAR; PG8_SCHED;
            PG8_LDA(At, 1, 1); PG8_STAGE(PG8_SB(1, 0), b3, voffB); PG8_STAGE(PG8_SB(1, 1), b3 + hstep, voffB); PG8_STA_NX(PG8_SA(1, 0), a3, 0);
            PG8_WAIT_V(8); PG8_WAIT_L(0); PG8_BAR; PG8_MMA(1, 0, At, B0); PG8_MMA(1, 1, At, B1); PG8_BAR; PG8_SCHED;
            } else {
            PG8_LDB(B0, 0, 0); PG8_SCHED; PG8_LDA(At, 0, 0); PG8_STAGE(PG8_SA(1, 1), a1 + hstep, voffA);
            PG8_WAIT_L(8); PG8_BAR; PG8_WAIT_L(0); PG8_MMA(0, 0, At, B0); PG8_BAR; PG8_SCHED;
            PG8_LDB(B1, 0, 1); PG8_STAGE(PG8_SB(0, 0), b2, voffB);
            PG8_BAR; PG8_WAIT_L(0); PG8_MMA(0, 1, At, B1); PG8_BAR;
            PG8_LDA(At, 0, 1); PG8_STAGE(PG8_SA(0, 0), a2, voffA);
            PG8_BAR; PG8_WAIT_L(0); PG8_MMA(1, 0, At, B0); PG8_BAR; PG8_SCHED;
            PG8_STAGE(PG8_SB(0, 1), b2 + hstep, voffB);
            PG8_WAIT_V(6); PG8_BAR; PG8_MMA(1, 1, At, B1); PG8_BAR;
            PG8_LDB(B0, 1, 0); PG8_SCHED; PG8_LDA(At, 1, 0); PG8_STAGE(PG8_SA(0, 1), a2 + hstep, voffA);
            PG8_WAIT_L(8); PG8_BAR; PG8_WAIT_L(0); PG8_MMA(0, 0, At, B0); PG8_BAR; PG8_SCHED;
            PG8_LDB(B1, 1, 1); PG8_STAGE(PG8_SB(1, 0), b3, voffB);
            PG8_BAR; PG8_WAIT_L(0); PG8_MMA(0, 1, At, B1); PG8_BAR;
            PG8_LDA(At, 1, 1); PG8_STAGE(PG8_SA(1, 0), a3, voffA);
            PG8_BAR; PG8_WAIT_L(0); PG8_MMA(1, 0, At, B0); PG8_BAR; PG8_SCHED;
            PG8_STAGE(PG8_SB(1, 1), b3 + hstep, voffB);
            PG8_WAIT_V(6); PG8_BAR; PG8_MMA(1, 1, At, B1); PG8_BAR;
            }
        }
        if (GEMM_ALIGN) { if (wr == 0) PG8_BAR; }
        if (FP8) asm volatile("s_nop 15\n\ts_nop 15" ::: "memory");
        E(acc, cur, wr, wc, fr, fq);
        if (!has_next) break;
#pragma unroll
        for (int a = 0; a < 2; ++a)
#pragma unroll
            for (int b = 0; b < 2; ++b)
#pragma unroll
                for (int m = 0; m < 4; ++m)
#pragma unroll
                    for (int n = 0; n < 2; ++n) acc[a][b][m][n] = (f32x4){0.f, 0.f, 0.f, 0.f};
        cur = nxt; cA = nA; cB = nB; ++ui;
        if (GATHER) {
#pragma unroll
            for (int h = 0; h < 2; ++h)
#pragma unroll
                for (int i = 0; i < 2; ++i) gA[h][i] = nG[h][i]; }
        if (GEMM_ALIGN) { if (wr == 1) PG8_BAR; }
    }
    PG8_WAIT_V(0);
    if (!GEMM_ALIGN) { if (wr == 0) PG8_BAR; }
    PG8_BAR;
#undef PG8_SA
#undef PG8_SB
#undef PG8_STAGE
#undef PG8_STG
#undef PG8_STA_CUR
#undef PG8_STA_NX
#undef PG8_LDA
#undef PG8_LDB
#undef PG8_MMA
#undef PG8_H
#undef PG8_WAIT_V
#undef PG8_WAIT_L
#undef PG8_BAR
#undef PG8_SCHED
}
}

template <int L> __device__ __forceinline__ void phase_attn(ArgsP a, LAS unsigned char* lds, int gw, int ngw, int wave, int lane) {
    const bf16_t* QKV = (const bf16_t*)(a->ws + WS_QKV); bf16_t* ATT = (bf16_t*)(a->ws + WS_ATT);
    const float lambda_init = L == 0 ? 0.2f : 0.8f - 0.6f * 0.74081822068171786607f;
    {
      const float L2T = 13.287712379549449f; LAS f32x2* tg = (LAS f32x2*)(lds + 73728); LAS f32x2* td = tg + 64 * 32;
      for (int i = threadIdx.x; i < 64 * 32 + 64 * 16; i += NTHREADS) { float s_, c_;
        if (i < 64 * 32) { sincosf((float)(i >> 5) * exp2f(-(float)(i & 31) * (1.f / 32.f) * L2T), &s_, &c_); tg[i] = (f32x2){c_, s_}; }
        else { const int q_ = i - 64 * 32; sincosf((float)(q_ >> 4) * exp2f(-(float)(q_ & 15) * (1.f / 16.f) * L2T), &s_, &c_); td[q_] = (f32x2){c_, s_}; } }
      __syncthreads(); }
    {
    constexpr int REP2 = ((PROBE_DUP >> 2) & 1) + 1, NUQ = 512 + (L == 0 ? 48 : 0);
    for (int uu = blockIdx.x; uu < NUQ * REP2; uu += gridDim.x) { const int u = REP2 == 1 ? uu : uu % NUQ;
        int seq; size_t qrow, krow; int qcol, kcol, vcol, ocol, qproc = 0, trow0 = 0;
        if (u < 512) { const int grp = u & 7, idx = u >> 3, b = grp >> 1, hq = (grp & 1) * 4 + (idx & 3), kvh = hq >> 2; seq = TPB; qrow = (size_t)b * TPB + (idx >> 2) * 256; krow = (size_t)b * TPB; qproc = 2; trow0 = (idx >> 2) * 256;
            qcol = 1536 + hq * 128; kcol = 2560 + kvh * 128; vcol = 2816 + kvh * 128; ocol = 512 + hq * 128; }
        else if (u < 544) { const int v = u - 512, b = v >> 3, hq = v & 7, kvh = hq >> 2; seq = CTX; qrow = (size_t)b * TPB + SEQ; krow = qrow; qproc = 1;
            qcol = 1536 + hq * 128; kcol = 2560 + kvh * 128; vcol = 2816 + kvh * 128; ocol = 512 + hq * 128; }
        else { const int v = u - 544, b = v >> 2, h = v & 3; seq = CTX; qrow = (size_t)b * TPB + SEQ; krow = qrow; qcol = h * 128; kcol = 512 + h * 128; vcol = 1024 + h * 128; ocol = h * 128; }
        att::attn_body<0>(QKV + qrow * INW + qcol, QKV + krow * INW + kcol, QKV + krow * INW + vcol, ATT + qrow * D + ocol, seq, lds, 0.f, 0.f, nullptr, 0, 0, qproc, a->in[I_QNORM] + L * 128, trow0);
    }
    float lam;
    { const int ln = threadIdx.x & 63; const float d1 = wave_sum(a->in[I_LQ1][L * 64 + ln] * a->in[I_LK1][L * 64 + ln]), d2 = wave_sum(a->in[I_LQ2][L * 64 + ln] * a->in[I_LK2][L * 64 + ln]); lam = __expf(d1) - __expf(d2) + lambda_init; lam = __int_as_float(__builtin_amdgcn_readfirstlane(__float_as_int(lam))); }
    constexpr int NUD = 512 + (L == 0 ? 64 : 0);
    for (int uu = blockIdx.x; uu < NUD * REP2; uu += gridDim.x) { const int u = REP2 == 1 ? uu : uu % NUD;
        int seq; size_t qrow, krow; int h, qproc = 0, trow0 = 0;
        if (u < 512) { const int idx = u >> 3, grp = (u & 7) + 8 * (idx >> 5), b = grp >> 2; h = grp & 3; seq = TPB; qrow = (size_t)b * TPB + (idx & 31) * 128; krow = (size_t)b * TPB; qproc = 2; trow0 = (idx & 31) * 128; }
        else { const int v = u - 544; if (v < 0) continue; const int b = v >> 3; h = (v >> 1) & 3; seq = CTX; krow = (size_t)b * TPB + SEQ; qrow = krow + (v & 1) * 128; }
        att::attn_body<1>(QKV + qrow * INW + 3072 + h * 128, QKV + krow * INW + 3584 + h * 128, QKV + krow * INW + 4096 + h * 128, ATT + qrow * D + 1536 + h * 128, seq, lds, lam, 1.f - lambda_init, a->in[I_SUBLN] + L * 128, 0, 0, qproc, nullptr, trow0);
    }
    constexpr int REP3 = ((PROBE_DUP >> 3) & 1) + 1;
    for (int uu = blockIdx.x; uu < 256 * REP3; uu += gridDim.x) { const int u = uu & 255;
        const int grp = u & 15, b = grp >> 2, h = grp & 3, r0 = (u >> 4) * 4, R0 = min(max(r0 - 4, 0), 52);
        const size_t qrow = (size_t)b * TPB + r0 * 64, krow = (size_t)b * TPB;
        att::attn_body<2>(QKV + qrow * INW + h * 128, QKV + krow * INW + 512 + h * 128, QKV + krow * INW + 1024 + h * 128, ATT + qrow * D + h * 128, 1024, lds, 0.f, 0.f, a->in[I_RPB] + (size_t)(L * 4 + h) * 465, r0, R0);
    }
    }
    __syncthreads();
}

template <int L> __device__ __forceinline__ void layer_program(LAS unsigned char* lds, const XcdBarrier& bar, int lo, int hi) {
    constexpr int P = 2 + 9 * L; const int G = gridDim.x, cid = blockIdx.x;
#define PHASE_IDS const int tid = fresh_tid(), lane = tid & 63, wave = __builtin_amdgcn_readfirstlane(tid >> 6), gw = blockIdx.x * NWAVES + wave, ngw = gridDim.x * NWAVES; (void)lane; (void)gw; (void)ngw
#define IN(k) (lo <= (k) && (k) < hi)
#define SEAM(k) do { if (IN(k) && IN((k) + 1)) xcd_barrier(bar); STAMP((k) + 1); } while (0)
    if (IN(P + 0)) DUP(1) { ArgsP a = get_args(); unsigned char* ws = a->ws;
        pg8::Gemm g{ws + WS_H, (const bf16_t*)(ws + WS_WIN) + (size_t)L * INW * D, 2 * D}; pg8::StaticOrder<false> S; S.init(NR / 256, INW / 256, G, cid, D / 64);
        pg8::EpiBf16 E{(bf16_t*)(ws + WS_QKV), INW, 1.f}; pg8::gemm_phase<false>(lds, g, S, E); }
    SEAM(P + 0);
    if (IN(P + 1)) { ArgsP a = get_args(); PHASE_IDS; phase_qkpost<L>(a, lds, gw, ngw, tid, lane); }
    SEAM(P + 1);
    if (IN(P + 2)) { ArgsP a = get_args(); PHASE_IDS; phase_attn<L>(a, lds, gw, ngw, wave, lane); }
    SEAM(P + 2);
    if (IN(P + 3)) DUP(4) { ArgsP a = get_args(); unsigned char* ws = a->ws;
        pg8::Gemm g{ws + WS_ATT, (const bf16_t*)(ws + WS_WOUT) + (size_t)L * D * D, 2 * D};
        if (L == 0) { pg8::EpiBf16OrPart E{(bf16_t*)(ws + WS_O), D, (bf16_t*)(ws + WS_PART_A)}; pg8::SplitCtxOrder S; S.init(G, cid, D / 64); pg8::gemm_phase<false>(lds, g, S, E); }
        else { pg8::EpiBf16 E{(bf16_t*)(ws + WS_O), D, 1.f}; pg8::StaticOrder<true> S; S.init(NTOK / 256, D / 256, G, cid, D / 64); pg8::gemm_phase<false>(lds, g, S, E); } }
    SEAM(P + 3);
    if (IN(P + 4)) { ArgsP a = get_args(); PHASE_IDS; phase_row_mid<L>(a, lds, gw, ngw, tid, lane); }
    SEAM(P + 4);
    if (IN(P + 5)) { if (L == 1) { ArgsP a = get_args(); PHASE_IDS; phase_moe_slots(a, lds, gw, ngw, tid, lane); } }
    if (L == 1) SEAM(P + 5); else STAMP(P + 6);
    if (IN(P + 6)) DUP(5) { ArgsP a = get_args(); unsigned char* ws = a->ws;
        if (L == 0 && FP8_UP0) { pg8::EpiSwigluT<true> E{(bf16_t*)(ws + WS_ACT), DFF}; pg8::Gemm g{ws + WS_H8, ws + WS_W13, D}; pg8::StaticOrder<false> S; S.init(NR / 256, 2 * DFF / 256, G, cid, D / 128); pg8::gemm_phase<true>(lds, g, S, E); }
        else if (L == 0) { pg8::EpiSwiglu E{(bf16_t*)(ws + WS_ACT), DFF}; pg8::Gemm g{ws + WS_H, ws + WS_W13, 2 * D}; pg8::StaticOrder<false> S; S.init(NR / 256, 2 * DFF / 256, G, cid, D / 64); pg8::gemm_phase<false>(lds, g, S, E); }
        else { LAS int* toff = moe_offsets(a, lds, fresh_tid()); pg8::EpiSwigluF8 E{ws + WS_ACT, DFF}; pg8::Gemm g{ws + WS_H8, ws + WS_MW13, D, (const int*)(ws + WS_IDX)}; pg8::MoeOrder S; S.init(toff, 2 * DFF / 256, G, cid, (size_t)2 * DFF * D, D / 128); pg8::gemm_phase<true, true>(lds, g, S, E); }
    }
    SEAM(P + 6);
    if (IN(P + 7)) DUP(6) { ArgsP a = get_args(); unsigned char* ws = a->ws;
        if (L == 0) { pg8::EpiBf16OrPart E{(bf16_t*)(ws + WS_Y), D, (bf16_t*)(ws + WS_PART_B)}; pg8::Gemm g{ws + WS_ACT, ws + WS_W2, 2 * DFF}; pg8::SplitCtxOrder S; S.init(G, cid, DFF / 64); pg8::gemm_phase<false>(lds, g, S, E); }
        else { LAS int* toff = moe_offsets(a, lds, fresh_tid()); pg8::EpiBf16T<true> E{(bf16_t*)(ws + WS_Y), D, 1.f / (F8_SA * F8_SW)}; pg8::Gemm g{ws + WS_ACT, ws + WS_MW2, DFF}; pg8::MoeOrder S; S.init(toff, D / 256, G, cid, (size_t)D * DFF, DFF / 128); pg8::gemm_phase<true>(lds, g, S, E); }
    }
    SEAM(P + 7);
    if (IN(P + 8)) { ArgsP a = get_args(); PHASE_IDS; phase_row_end<L>(a, gw, ngw, lane); }
    if (L == 0) SEAM(P + 8);
#undef IN
#undef SEAM
}
constexpr int NPHASE = 20;


__global__ void __launch_bounds__(NTHREADS, 2) fwd_kernel(Args kargs_unused) {
    extern __shared__ __attribute__((aligned(16))) unsigned char lds_raw[];
    LAS unsigned char* lds = (LAS unsigned char*)lds_raw;
    volatile LAS unsigned* xbw = (volatile LAS unsigned*)(lds + LDS_BYTES - 16);
    { const int t0 = fresh_tid(); if (t0 < 4) xbw[t0] = 0u; }
    __syncthreads();
    STAMP(0); const unsigned long long probe_c0 = PROBE_STAMP == 100 ? (unsigned long long)clock64() : 0ull;
    int lo, hi; XcdBarrier bar;
    { ArgsP a = get_args(); lo = a->lo; hi = a->hi; bar.bar = (unsigned*)(a->ws + WS_CTL) + CW_BAR; bar.x = 0; bar.st = xbw;
      if (hi - lo > 1) bar = xcd_barrier_post((unsigned*)(a->ws + WS_CTL) + CW_BAR, xbw); }
#define IN(k) (lo <= (k) && (k) < hi)
    { const int tid = fresh_tid(), lane = tid & 63, wave = __builtin_amdgcn_readfirstlane(tid >> 6), gw = blockIdx.x * NWAVES + wave, ngw = gridDim.x * NWAVES;
      if (IN(0)) DUP(0) { ArgsP a = get_args(); phase_adaln(a, lds, tid, wave, lane); phase_convert(a, lds, gw, ngw, wave, lane); __syncthreads(); }
      if (IN(0) && IN(1)) xcd_barrier(bar);
      STAMP(1);
      if (IN(1)) { ArgsP a = get_args(); phase_row_entry(a, gw, ngw, lane); }
      if (IN(1) && IN(2)) xcd_barrier(bar);
      STAMP(2); }
#undef IN
    layer_program<0>(lds, bar, lo, hi);
    layer_program<1>(lds, bar, lo, hi);
    if (PROBE_STAMP >= 0 && blockIdx.x == 0 && threadIdx.x == 0) {
        STAMP(NPHASE);
        volatile LAS unsigned long long* st = (volatile LAS unsigned long long*)(lds + 131072 + 1024);
        const unsigned long long d = PROBE_STAMP == 100 ? ((unsigned long long)clock64() - probe_c0) / 20ull : (PROBE_STAMP >= 200 ? (st[32 + PROBE_STAMP - 200 + 1] - st[32 + PROBE_STAMP - 200]) / 20ull : st[PROBE_STAMP + 1] - st[PROBE_STAMP]);
        const unsigned long long t0 = (unsigned long long)wall_clock64();
        while ((unsigned long long)wall_clock64() - t0 < d) __builtin_amdgcn_s_sleep(10);
    }
}

#ifndef MK_PER_PHASE
#define MK_PER_PHASE 0
#endif
extern "C" void kernel_launch(void* const* d_in, const int* in_sizes, int n_in, void* d_out, int out_size, void* d_ws, size_t ws_size, hipStream_t stream) {
    static int grid = 0;
    if (grid == 0) {
        if (n_in != 27 || out_size != NB * SEQ * D || ws_size < WS_H8 + (size_t)NR * D) { fprintf(stderr, "kernel_launch: unexpected shapes: n_in %d out %d ws %zu (need %zu)\n", n_in, out_size, ws_size, (size_t)WS_END); grid = -1; return; }
        int dev = 0, cus = 0, per_cu = 0;
        if (hipGetDevice(&dev) != hipSuccess || hipDeviceGetAttribute(&cus, hipDeviceAttributeMultiprocessorCount, dev) != hipSuccess) { grid = -1; return; }
        if (hipFuncSetAttribute((const void*)fwd_kernel, hipFuncAttributeMaxDynamicSharedMemorySize, LDS_BYTES) != hipSuccess) { fprintf(stderr, "kernel_launch: hipFuncSetAttribute failed\n"); grid = -1; return; }
        if (hipOccupancyMaxActiveBlocksPerMultiprocessor(&per_cu, (const void*)fwd_kernel, NTHREADS, LDS_BYTES) != hipSuccess || per_cu < 1) fprintf(stderr, "kernel_launch: occupancy query says %d\n", per_cu);
        (void)hipGetLastError();
        grid = cus;
    }
    if (grid < 0) return;
    (void)hipMemsetAsync((char*)d_ws + WS_CTL, 0, CTL_ZERO_BYTES, stream);
    Args a{};
    for (int i = 0; i < 27; ++i) a.in[i] = (const float*)d_in[i];
    a.out = (float*)d_out; a.ws = (unsigned char*)d_ws;
#if MK_PER_PHASE
    for (int p = 0; p < NPHASE; ++p) { if (p == 7) continue; a.lo = p; a.hi = p + 1; hipLaunchKernelGGL(fwd_kernel, dim3(grid), dim3(NTHREADS), LDS_BYTES, stream, a); }
#else
    a.lo = 0; a.hi = NPHASE; hipLaunchKernelGGL(fwd_kernel, dim3(grid), dim3(NTHREADS), LDS_BYTES, stream, a);
#endif
}
```

```cpp
#include <hip/hip_runtime.h>
#include <stdint.h>
#include <stdio.h>

#define GAS __attribute__((address_space(1)))
#define LAS __attribute__((address_space(3)))
typedef unsigned short bf16_t;
typedef short bf16x8 __attribute__((ext_vector_type(8)));
typedef float f32x4 __attribute__((ext_vector_type(4)));
typedef float f32x2 __attribute__((ext_vector_type(2)));
typedef unsigned u32x4 __attribute__((ext_vector_type(4)));
typedef unsigned u32x2 __attribute__((ext_vector_type(2)));

#ifndef PROBE_DUP
#define PROBE_DUP 0
#endif
#define DUP(bit) for (int _rep = 0; _rep < (((PROBE_DUP) >> (bit)) & 1) + 1; ++_rep)
#ifndef PROBE_STAMP
#define PROBE_STAMP -1
#endif
#define STAMP(i) do { if (PROBE_STAMP >= 0 && blockIdx.x == 0 && threadIdx.x == 0) { ((volatile LAS unsigned long long*)(lds + 131072 + 1024))[i] = (unsigned long long)wall_clock64(); ((volatile LAS unsigned long long*)(lds + 131072 + 1024))[32 + (i)] = (unsigned long long)clock64(); } } while (0)
constexpr int D = 2048, NB = 4, SEQ = 4096, CTX = 256, TPB = SEQ + CTX, NR = NB * TPB;
constexpr int INW = 4608, DFF = 5632, NE = 8, MODW = 6 * D, NTOK = NB * SEQ;
constexpr int MAXSLOT = 34816;
constexpr float EPS = 1e-6f;
constexpr int NWAVES = 8, NTHREADS = 512;
constexpr int LDS_BYTES = 147456;

constexpr size_t MiB = 1u << 20;
constexpr size_t WS_CTL = 0, CTL_ZERO_BYTES = 128 * 1024;
constexpr size_t WS_MOD = 1 * MiB;
constexpr size_t WS_TOPK = 2 * MiB;
constexpr size_t WS_SLOT = WS_TOPK + 512 * 1024;
constexpr size_t WS_IDX = 3 * MiB;
constexpr size_t WS_WIN = 4 * MiB;
constexpr size_t WS_WOUT = 40 * MiB;
constexpr size_t WS_W13 = 56 * MiB;
constexpr size_t WS_W2 = 100 * MiB;
constexpr size_t WS_MW13 = 122 * MiB;
constexpr size_t WS_MW2 = 474 * MiB;
constexpr size_t WS_X = 650 * MiB;
constexpr size_t WS_H = 786 * MiB;
constexpr size_t WS_Y = 854 * MiB;
constexpr size_t WS_HG = WS_Y;
constexpr size_t WS_R1 = 990 * MiB;
constexpr size_t WS_QKV = WS_R1, WS_VT = WS_R1 + 153 * MiB, WS_ATT = WS_R1 + 170 * MiB, WS_O = WS_R1 + 238 * MiB, WS_ACT = WS_R1;
constexpr size_t WS_END = WS_R1 + (size_t)MAXSLOT * DFF * 2;
constexpr size_t WS_H8 = WS_END;
constexpr size_t WS_PART_A = WS_QKV;
constexpr size_t WS_PART_B = WS_Y + 68 * MiB;
static_assert((size_t)NR * INW * 2 <= 153 * MiB && (size_t)16 * 128 * TPB * 2 <= 17 * MiB && (size_t)NR * D * 2 <= 68 * MiB, "R1 map");
constexpr int CW_BAR = 4096;
constexpr int CW_CNT = 16384;
constexpr int CW_CUR = 16384 + 64;

__device__ __forceinline__ unsigned cvt_pk_bf16(float lo, float hi) { unsigned r; asm("v_cvt_pk_bf16_f32 %0, %1, %2" : "=v"(r) : "v"(lo), "v"(hi)); return r; }
__device__ __forceinline__ float bf_lo(unsigned w) { return __uint_as_float(w << 16); }
__device__ __forceinline__ float bf_hi(unsigned w) { return __uint_as_float(w & 0xffff0000u); }
__device__ __forceinline__ float bf2f(bf16_t b) { return __uint_as_float(((unsigned)b) << 16); }
__device__ __forceinline__ bf16_t f2bf(float f) { return (bf16_t)(cvt_pk_bf16(f, 0.f) & 0xffffu); }
__device__ __forceinline__ float wave_sum(float v) {
#pragma unroll
    for (int o = 1; o < 64; o <<= 1) v += __shfl_xor(v, o);
    return v;
}
__device__ __forceinline__ float wave_max(float v) {
#pragma unroll
    for (int o = 1; o < 64; o <<= 1) v = fmaxf(v, __shfl_xor(v, o));
    return v;
}
#define LDS_WAIT() asm volatile("s_waitcnt lgkmcnt(0)" ::: "memory")
__device__ __forceinline__ unsigned pk4_fp8(float a, float b, float c, float d) {
    a = fminf(fmaxf(a, -448.f), 448.f); b = fminf(fmaxf(b, -448.f), 448.f); c = fminf(fmaxf(c, -448.f), 448.f); d = fminf(fmaxf(d, -448.f), 448.f);
    int w = 0; w = __builtin_amdgcn_cvt_pk_fp8_f32(a, b, w, false); w = __builtin_amdgcn_cvt_pk_fp8_f32(c, d, w, true); return (unsigned)w; }
#ifndef FP8_UP0
#define FP8_UP0 1
#endif
constexpr float F8_SW = 64.f, F8_SH = 16.f, F8_SA = 8.f;

#define XB_TMO      128
#define XB_XCNT(j)  (256  + 64 * (j))
#define XB_XSUB(j)  (1280 + 64 * (j))
#define XB_XGEN(j)  (2304 + 64 * (j))
#define XB_TOP      3328
#define XB_TOPGEN   3392
#define XCD_BAR_WORDS 3456
#define XB_SPIN_CAP (1u << 18)
__device__ __forceinline__ unsigned xb_ld(unsigned* p)              { return __hip_atomic_load(p, __ATOMIC_RELAXED, __HIP_MEMORY_SCOPE_AGENT); }
__device__ __forceinline__ unsigned xb_add(unsigned* p, unsigned v) { return __hip_atomic_fetch_add(p, v, __ATOMIC_RELAXED, __HIP_MEMORY_SCOPE_AGENT); }
__device__ __forceinline__ unsigned xb_xcc_id() { return (unsigned)__builtin_amdgcn_s_getreg((3 << 11) | 20) & 0xFu; }
#define XB_SPIN(cond, bar) do { unsigned _sp = 0; while (cond) { __builtin_amdgcn_s_sleep(1); \
    if ((++_sp & 255u) == 0u) { if (xb_ld(&(bar)[XB_TMO])) break; if (_sp > XB_SPIN_CAP) { atomicAdd(&(bar)[XB_TMO], 1u); break; } } } } while (0)
struct XcdBarrier { unsigned* bar; unsigned x; volatile LAS unsigned* st; };
__device__ __forceinline__ XcdBarrier xcd_barrier_post(unsigned* bar, volatile LAS unsigned* st) {
    XcdBarrier b; b.bar = bar; b.x = xb_xcc_id(); b.st = st;
    if (threadIdx.x == 0) (void)xb_add(&bar[XB_XCNT(b.x)], 1u);
    return b;
}
__device__ __forceinline__ void xcd_barrier_complete(unsigned* bar, unsigned x, unsigned& nloc, unsigned& nx) {
    const unsigned G = gridDim.x * gridDim.y * gridDim.z;
    unsigned sum, cnt, mine, sp = 0u;
    for (;;) {
        sum = 0u; cnt = 0u; mine = 0u;
#pragma unroll
        for (unsigned j = 0; j < 16; ++j) { const unsigned c = xb_ld(&bar[XB_XCNT(j)]); sum += c; cnt += (c > 0u) ? 1u : 0u; mine = (j == x) ? c : mine; }
        if (sum == G) break;
        __builtin_amdgcn_s_sleep(1);
        if ((++sp & 255u) == 0u) { if (xb_ld(&bar[XB_TMO])) break; if (sp > XB_SPIN_CAP) { atomicAdd(&bar[XB_TMO], 1u); break; } }
    }
    nloc = mine > 0u ? mine : 1u; nx = cnt > 0u ? cnt : 1u;
}
__device__ __forceinline__ void xcd_barrier(const XcdBarrier& b) {
    asm volatile("s_waitcnt vmcnt(0)" ::: "memory");
    __syncthreads();
    if (threadIdx.x == 0) {
        unsigned* bar = b.bar;
        __builtin_amdgcn_s_waitcnt(0);
        unsigned nloc = b.st[0], nx = b.st[1];
        if (nloc == 0u) { xcd_barrier_complete(bar, b.x, nloc, nx); b.st[0] = nloc; b.st[1] = nx; }
        const unsigned old = xb_add(&bar[XB_XSUB(b.x)], 1u);
        const unsigned gen = old / nloc;
        if (old + 1u == (gen + 1u) * nloc) {
            __builtin_amdgcn_fence(__ATOMIC_RELEASE, "agent");
            asm volatile("s_waitcnt vmcnt(0)" ::: "memory");
            const unsigned og = xb_add(&bar[XB_TOP], 1u);
            const unsigned tg = og / nx;
            if (og + 1u == (tg + 1u) * nx) xb_add(&bar[XB_TOPGEN], 1u);
            else XB_SPIN(xb_ld(&bar[XB_TOPGEN]) == tg, bar);
            __builtin_amdgcn_fence(__ATOMIC_ACQUIRE, "agent");
            xb_add(&bar[XB_XGEN(b.x)], 1u);
            asm volatile("s_waitcnt vmcnt(0)" ::: "memory");
        } else {
            XB_SPIN(xb_ld(&bar[XB_XGEN(b.x)]) == gen, bar);
            __builtin_amdgcn_fence(__ATOMIC_ACQUIRE, "agent");
            asm volatile("s_waitcnt vmcnt(0)" ::: "memory");
        }
    }
    __syncthreads();
}

struct Args { const float* in[27]; float* out; unsigned char* ws; int lo, hi; };
typedef const __attribute__((address_space(4))) Args* ArgsP;
__device__ __forceinline__ int fresh_tid() { int t = threadIdx.x; asm volatile("" : "+v"(t)); return t; }
__device__ __forceinline__ ArgsP get_args() { ArgsP p = (ArgsP)__builtin_amdgcn_kernarg_segment_ptr(); asm volatile("" : "+s"(p)); return p; }
enum { I_X = 0, I_C, I_CTX, I_CCTX, I_WMOD, I_BMOD, I_GMIXPRE, I_GMIXPOST, I_GFFNPRE, I_GFFNPOST, I_WIN, I_WOUT, I_RPB, I_QNORM, I_KNORM,
       I_LQ1, I_LK1, I_LQ2, I_LK2, I_SUBLN, I_FW1, I_FW3, I_FW2, I_ROUTER, I_MW1, I_MW3, I_MW2 };

__device__ __forceinline__ void transpose_item(const float* W, int K, int N, bf16_t* WT, int item, int mode, LAS float* scr, int lane) {
    const int nblk = N / 32, kb = item / nblk, nb = item % nblk, k0 = 64 * kb, n0 = 32 * nb;
#pragma unroll 8
    for (int i = 0; i < 32; ++i) { const int kk = 2 * i + (lane >> 5); scr[kk * 33 + (lane & 31)] = W[(size_t)(k0 + kk) * N + n0 + (lane & 31)]; }
    LDS_WAIT(); asm volatile("" ::: "memory");
    const int c = lane & 7;
    const int drow0 = mode == 0 ? n0 : (256 * (n0 >> 7) + (n0 & 127) + (mode == 2 ? 128 : 0));
#pragma unroll
    for (int j = 0; j < 4; ++j) { const int n = (lane >> 3) + 8 * j; const LAS float* s = scr + (8 * c) * 33 + n;
        u32x4 o; o.x = cvt_pk_bf16(s[0 * 33], s[1 * 33]); o.y = cvt_pk_bf16(s[2 * 33], s[3 * 33]); o.z = cvt_pk_bf16(s[4 * 33], s[5 * 33]); o.w = cvt_pk_bf16(s[6 * 33], s[7 * 33]);
        *(u32x4*)(WT + (size_t)(drow0 + n) * K + k0 + 8 * c) = o; }
    LDS_WAIT(); asm volatile("" ::: "memory");
}
__device__ __forceinline__ void transpose_item_f8(const float* W, int K, int N, unsigned char* WT, int item, int mode, LAS float* scr, int lane) {
    const int nblk = N / 32, kb = item / nblk, nb = item % nblk, k0 = 64 * kb, n0 = 32 * nb;
#pragma unroll 8
    for (int i = 0; i < 32; ++i) { const int kk = 2 * i + (lane >> 5); scr[kk * 33 + (lane & 31)] = W[(size_t)(k0 + kk) * N + n0 + (lane & 31)]; }
    LDS_WAIT(); asm volatile("" ::: "memory");
    const int c = lane & 7;
    const int drow0 = mode == 0 ? n0 : (256 * (n0 >> 7) + (n0 & 127) + (mode == 2 ? 128 : 0));
#pragma unroll
    for (int j = 0; j < 4; ++j) { const int n = (lane >> 3) + 8 * j; const LAS float* s = scr + (8 * c) * 33 + n;
        u32x2 o; o.x = pk4_fp8(s[0 * 33] * F8_SW, s[1 * 33] * F8_SW, s[2 * 33] * F8_SW, s[3 * 33] * F8_SW); o.y = pk4_fp8(s[4 * 33] * F8_SW, s[5 * 33] * F8_SW, s[6 * 33] * F8_SW, s[7 * 33] * F8_SW);
        *(u32x2*)(WT + (size_t)(drow0 + n) * K + k0 + 8 * c) = o; }
    LDS_WAIT(); asm volatile("" ::: "memory");
}
struct CvtItem { const float* src; unsigned char* dst; int N, K, f8; };
__device__ __forceinline__ CvtItem cvt_decode(ArgsP a, int it, int lane) {
    unsigned char* ws = a->ws;
    constexpr int I_IN = 32 * 144, I_OUT = 32 * 64, I_F = 5632;
    const float* W; unsigned char* WT; int K, N, mode, f8 = 0, q;
    int r = it;
    if (r < 2 * I_IN) { const int l = r / I_IN; W = a->in[I_WIN] + (size_t)l * D * INW; K = D; N = INW; WT = ws + WS_WIN + (size_t)l * INW * D * 2; mode = 0; q = r % I_IN; }
    else if (r < 2 * I_IN + 2 * I_OUT) { r -= 2 * I_IN; const int l = r / I_OUT; W = a->in[I_WOUT] + (size_t)l * D * D; K = D; N = D; WT = ws + WS_WOUT + (size_t)l * D * D * 2; mode = 0; q = r % I_OUT; }
    else { r -= 2 * I_IN + 2 * I_OUT; const int m = r / I_F; q = r % I_F;
        if (m == 0) { W = a->in[I_FW1]; K = D; N = DFF; WT = ws + WS_W13; mode = 1; f8 = FP8_UP0; }
        else if (m == 1) { W = a->in[I_FW3]; K = D; N = DFF; WT = ws + WS_W13; mode = 2; f8 = FP8_UP0; }
        else if (m == 2) { W = a->in[I_FW2]; K = DFF; N = D; WT = ws + WS_W2; mode = 0; }
        else if (m < 11) { const int e = m - 3; W = a->in[I_MW1] + (size_t)e * D * DFF; K = D; N = DFF; WT = ws + WS_MW13 + (size_t)e * 2 * DFF * D; mode = 1; f8 = 1; }
        else if (m < 19) { const int e = m - 11; W = a->in[I_MW3] + (size_t)e * D * DFF; K = D; N = DFF; WT = ws + WS_MW13 + (size_t)e * 2 * DFF * D; mode = 2; f8 = 1; }
        else { const int e = m - 19; W = a->in[I_MW2] + (size_t)e * DFF * D; K = DFF; N = D; WT = ws + WS_MW2 + (size_t)e * D * DFF; mode = 0; f8 = 1; } }
    const int nblk = N / 32, kb = q / nblk, nb = q % nblk, k0 = 64 * kb, n0 = 32 * nb;
    const int drow0 = mode == 0 ? n0 : (256 * (n0 >> 7) + (n0 & 127) + (mode == 2 ? 128 : 0));
    CvtItem c; c.src = W + (size_t)k0 * N + n0; c.N = N; c.K = K; c.f8 = f8; c.dst = WT + ((size_t)drow0 * K + k0) * (f8 ? 1 : 2); return c;
}
__device__ __forceinline__ void cvt_load(const CvtItem& c, int lane, float (&v)[32]) {
    const float* p = c.src + (size_t)(lane >> 5) * c.N + (lane & 31);
#pragma unroll
    for (int i = 0; i < 32; ++i) v[i] = p[(size_t)(2 * i) * c.N];
}
__device__ __forceinline__ void cvt_store(const CvtItem& c, int lane, const float (&v)[32], LAS float* scr) {
#pragma unroll
    for (int i = 0; i < 32; ++i) scr[(2 * i + (lane >> 5)) * 33 + (lane & 31)] = v[i];
    LDS_WAIT(); asm volatile("" ::: "memory");
    const int cc = lane & 7;
#pragma unroll
    for (int j = 0; j < 4; ++j) { const int n = (lane >> 3) + 8 * j; const LAS float* s = scr + (8 * cc) * 33 + n;
        if (c.f8) { u32x2 o; o.x = pk4_fp8(s[0 * 33] * F8_SW, s[1 * 33] * F8_SW, s[2 * 33] * F8_SW, s[3 * 33] * F8_SW); o.y = pk4_fp8(s[4 * 33] * F8_SW, s[5 * 33] * F8_SW, s[6 * 33] * F8_SW, s[7 * 33] * F8_SW);
            *(u32x2*)(c.dst + (size_t)n * c.K + 8 * cc) = o; }
        else { u32x4 o; o.x = cvt_pk_bf16(s[0 * 33], s[1 * 33]); o.y = cvt_pk_bf16(s[2 * 33], s[3 * 33]); o.z = cvt_pk_bf16(s[4 * 33], s[5 * 33]); o.w = cvt_pk_bf16(s[6 * 33], s[7 * 33]);
            *(u32x4*)(c.dst + ((size_t)n * c.K + 8 * cc) * 2) = o; } }
    LDS_WAIT(); asm volatile("" ::: "memory");
}
__device__ __forceinline__ void phase_convert(ArgsP a, LAS unsigned char* lds, int gw, int ngw, int wave, int lane) {
    LAS float* scr = (LAS float*)(lds + wave * 16384);
    constexpr int NITEMS = 2 * 32 * 144 + 2 * 32 * 64 + 27 * 5632;
    int it = gw; if (it >= NITEMS) return;
    CvtItem cur = cvt_decode(a, it, lane); float va[32], vb[32];
    cvt_load(cur, lane, va);
    for (;;) {
        const int n1 = it + ngw; const bool h1 = n1 < NITEMS; CvtItem nx = cur;
        if (h1) { nx = cvt_decode(a, n1, lane); cvt_load(nx, lane, vb); }
        cvt_store(cur, lane, va, scr);
        if (!h1) break;
        const int n2 = n1 + ngw; const bool h2 = n2 < NITEMS;
        if (h2) { cur = cvt_decode(a, n2, lane); cvt_load(cur, lane, va); }
        cvt_store(nx, lane, vb, scr);
        if (!h2) break;
        it = n2;
    }
}
__device__ __forceinline__ void phase_adaln(ArgsP a, LAS unsigned char* lds, int tid, int wave, int lane) {
    LAS float* sc = (LAS float*)lds;
    LAS float* red = (LAS float*)(lds + 5 * 2048 * 4);
    float* MOD = (float*)(a->ws + WS_MOD);
    for (int task = blockIdx.x; task < 192; task += gridDim.x) {
        const int l = task / 96, j0 = (task % 96) * 128;
        for (int i = tid; i < 5 * 2048; i += NTHREADS) { const int v = i >> 11, k = i & 2047; const float c = v < 4 ? a->in[I_C][v * D + k] : a->in[I_CCTX][k]; sc[i] = c / (1.f + __expf(-c)); }
        __syncthreads();
        float acc[5][2];
#pragma unroll
        for (int v = 0; v < 5; ++v) { acc[v][0] = 0.f; acc[v][1] = 0.f; }
        const float* wp = a->in[I_WMOD] + ((size_t)l * D + wave * 256) * MODW + j0 + 2 * lane;
        for (int k = 0; k < 256; ++k) { const f32x2 w = *(const f32x2*)(wp + (size_t)k * MODW);
#pragma unroll
            for (int v = 0; v < 5; ++v) { const float s = sc[v * 2048 + wave * 256 + k]; acc[v][0] += s * w.x; acc[v][1] += s * w.y; } }
#pragma unroll
        for (int v = 0; v < 5; ++v) { red[(wave * 5 + v) * 128 + 2 * lane] = acc[v][0]; red[(wave * 5 + v) * 128 + 2 * lane + 1] = acc[v][1]; }
        __syncthreads();
        for (int i = tid; i < 640; i += NTHREADS) { const int v = i >> 7, j = i & 127; float s = a->in[I_BMOD][l * MODW + j0 + j];
#pragma unroll
            for (int w = 0; w < 8; ++w) s += red[(w * 5 + v) * 128 + j];
            MOD[(size_t)(l * 5 + v) * MODW + j0 + j] = s; }
        __syncthreads();
    }
}

__device__ __forceinline__ void ld_row_f32(const float* p, int lane, f32x4 (&v)[8]) {
#pragma unroll
    for (int j = 0; j < 8; ++j) v[j] = *(const f32x4*)(p + 4 * lane + 256 * j);
}
__device__ __forceinline__ void ld_row_bf16(const bf16_t* p, int lane, f32x4 (&v)[8]) {
#pragma unroll
    for (int j = 0; j < 8; ++j) { const u32x2 w = *(const u32x2*)(p + 4 * lane + 256 * j); v[j] = (f32x4){bf_lo(w.x), bf_hi(w.x), bf_lo(w.y), bf_hi(w.y)}; }
}
__device__ __forceinline__ void st_row_f32(float* p, int lane, const f32x4 (&v)[8]) {
#pragma unroll
    for (int j = 0; j < 8; ++j) *(f32x4*)(p + 4 * lane + 256 * j) = v[j];
}
__device__ __forceinline__ void st_row_bf16(bf16_t* p, int lane, const f32x4 (&v)[8]) {
#pragma unroll
    for (int j = 0; j < 8; ++j) { u32x2 w; w.x = cvt_pk_bf16(v[j].x, v[j].y); w.y = cvt_pk_bf16(v[j].z, v[j].w); *(u32x2*)(p + 4 * lane + 256 * j) = w; }
}
__device__ __forceinline__ float row_rstd(const f32x4 (&v)[8]) {
    float s = 0.f;
#pragma unroll
    for (int j = 0; j < 8; ++j) s += (v[j].x * v[j].x + v[j].y * v[j].y) + (v[j].z * v[j].z + v[j].w * v[j].w);
    return rsqrtf(wave_sum(s) * (1.f / D) + EPS);
}
template <bool STORE = true> __device__ __forceinline__ void norm_mod_store(const f32x4 (&x)[8], const float* g, const float* sh, const float* sc, bf16_t* hrow, int lane, f32x4 (&h)[8]) {
    const float r = row_rstd(x);
#pragma unroll
    for (int j = 0; j < 8; ++j) { const int c = 4 * lane + 256 * j; const f32x4 gv = *(const f32x4*)(g + c), sv = *(const f32x4*)(sc + c), hv = *(const f32x4*)(sh + c);
        h[j] = (x[j] * r * gv) * (sv + 1.f) + hv; }
    if (STORE) st_row_bf16(hrow, lane, h);
}
__device__ __forceinline__ void phase_row_entry(ArgsP a, int gw, int ngw, int lane) {
    bf16_t* X = (bf16_t*)(a->ws + WS_X); bf16_t* H = (bf16_t*)(a->ws + WS_H); const float* MOD = (const float*)(a->ws + WS_MOD);
    for (int row = gw; row < NR; row += ngw) {
        const int b = row / TPB, t = row % TPB; const bool lat = t < SEQ; const int v = lat ? b : 4;
        const float* src = lat ? a->in[I_X] + ((size_t)b * SEQ + t) * D : a->in[I_CTX] + ((size_t)b * CTX + (t - SEQ)) * D;
        f32x4 x[8], h[8]; ld_row_f32(src, lane, x); st_row_bf16(X + (size_t)row * D, lane, x);
        const float* mv = MOD + (size_t)(0 * 5 + v) * MODW;
        norm_mod_store(x, a->in[I_GMIXPRE], mv + 0 * D, mv + 1 * D, H + (size_t)row * D, lane, h);
    }
}
template <int L> __device__ __forceinline__ void phase_row_mid(ArgsP a, LAS unsigned char* lds, int gw, int ngw, int tid, int lane) {
    bf16_t* X = (bf16_t*)(a->ws + WS_X); bf16_t* H = (bf16_t*)(a->ws + WS_H); const float* MOD = (const float*)(a->ws + WS_MOD); const bf16_t* O = (const bf16_t*)(a->ws + WS_O);
    LAS unsigned* lcnt = (LAS unsigned*)(lds + 131072 + 64); LAS float* rt = (LAS float*)lds;
    if (L == 1) { if (tid < 8) lcnt[tid] = 0u;
        for (int i = tid; i < D * NE; i += NTHREADS) rt[(i & 7) * D + (i >> 3)] = a->in[I_ROUTER][i];
        __syncthreads(); }
    for (int row = gw; row < NR; row += ngw) {
        const int b = row / TPB, t = row % TPB; const bool lat = t < SEQ; const int v = lat ? b : 4;
        if (L == 1 && !lat) continue;
        const float* mv = MOD + (size_t)(L * 5 + v) * MODW;
        f32x4 o[8], x[8], h[8];
        if (L == 0 && !lat) { const bf16_t* P = (const bf16_t*)(a->ws + WS_PART_A) + (size_t)(b * CTX + (t - SEQ)) * D; ld_row_bf16(P, lane, o);
#pragma unroll
            for (int s = 1; s < 8; ++s) { f32x4 p[8]; ld_row_bf16(P + (size_t)s * (NB * CTX) * D, lane, p);
#pragma unroll
                for (int j = 0; j < 8; ++j) o[j] = o[j] + p[j]; } }
        else ld_row_bf16(O + (size_t)row * D, lane, o);
        ld_row_bf16(X + (size_t)row * D, lane, x);
        const float r1 = row_rstd(o);
#pragma unroll
        for (int j = 0; j < 8; ++j) { const int c = 4 * lane + 256 * j; const f32x4 gv = *(const f32x4*)(a->in[I_GMIXPOST] + L * D + c), gt = *(const f32x4*)(mv + 2 * D + c);
            x[j] = x[j] + gt * (o[j] * r1 * gv); }
        st_row_bf16(X + (size_t)row * D, lane, x);
        norm_mod_store<(L == 0 && !FP8_UP0)>(x, a->in[I_GFFNPRE] + L * D, mv + 3 * D, mv + 4 * D, H + (size_t)row * D, lane, h);
        { unsigned char* h8 = a->ws + WS_H8 + (size_t)row * D;
#pragma unroll
            for (int j = 0; j < 8; ++j) *(unsigned*)(h8 + 4 * lane + 256 * j) = pk4_fp8(h[j].x * F8_SH, h[j].y * F8_SH, h[j].z * F8_SH, h[j].w * F8_SH); }
        if (L == 1) {
            float lg[8];
#pragma unroll
            for (int e = 0; e < 8; ++e) lg[e] = 0.f;
#pragma unroll
            for (int j = 0; j < 8; ++j)
#pragma unroll
                for (int e = 0; e < 8; ++e) { const f32x4 r = *(const LAS f32x4*)(rt + e * D + 4 * lane + 256 * j); lg[e] += (h[j].x * r.x + h[j].y * r.y) + (h[j].z * r.z + h[j].w * r.w); }
#pragma unroll
            for (int e = 0; e < 8; ++e) lg[e] = wave_sum(lg[e]);
            int i1 = 0; float v1 = lg[0];
#pragma unroll
            for (int e = 1; e < 8; ++e) if (lg[e] > v1) { v1 = lg[e]; i1 = e; }
            int i2 = -1; float v2 = -3.0e38f;
#pragma unroll
            for (int e = 0; e < 8; ++e) if (e != i1 && lg[e] > v2) { v2 = lg[e]; i2 = e; }
            const float e2 = __expf(v2 - v1), g1 = 1.f / (1.f + e2), g2 = e2 / (1.f + e2);
            if (lane == 0) { const int tok = b * SEQ + t; int* tk = (int*)(a->ws + WS_TOPK) + (size_t)tok * 4; tk[0] = i1; tk[1] = i2; ((float*)tk)[2] = g1; ((float*)tk)[3] = g2;
                atomicAdd((unsigned*)&lcnt[i1], 1u); atomicAdd((unsigned*)&lcnt[i2], 1u); }
        }
    }
    if (L == 1) { __syncthreads(); if (tid < 8) { const unsigned c = lcnt[tid]; if (c) __hip_atomic_fetch_add((unsigned*)(a->ws + WS_CTL) + CW_CNT + tid, c, __ATOMIC_RELAXED, __HIP_MEMORY_SCOPE_AGENT); } __syncthreads(); }
}
constexpr int LDS_CTL_OFF = 131072;
__device__ __forceinline__ LAS int* moe_offsets(ArgsP a, LAS unsigned char* lds, int tid) {
    LAS int* toff = (LAS int*)(lds + LDS_CTL_OFF);
    __syncthreads();
    if (tid == 0) { int acc = 0;
        for (int e = 0; e < 8; ++e) { toff[e] = acc; const unsigned c = __hip_atomic_load((unsigned*)(a->ws + WS_CTL) + CW_CNT + e, __ATOMIC_RELAXED, __HIP_MEMORY_SCOPE_AGENT); toff[16 + e] = (int)c; acc += (int)((c + 255u) >> 8); }
        toff[8] = acc; }
    __syncthreads();
    return toff;
}
__device__ __forceinline__ void phase_moe_slots(ArgsP a, LAS unsigned char* lds, int gw, int ngw, int tid, int lane) {
    LAS int* toff = moe_offsets(a, lds, fresh_tid());
    unsigned* ctl = (unsigned*)(a->ws + WS_CTL); int* SLOT = (int*)(a->ws + WS_SLOT); int* IDX = (int*)(a->ws + WS_IDX); const int* TOPK = (const int*)(a->ws + WS_TOPK);
    const int wave = tid >> 6;
    for (int e = blockIdx.x; e < 8; e += gridDim.x) { const int c = toff[16 + e], s0 = toff[e] * 256 + c, n = ((c + 255) & ~255) - c;
        for (int i = tid; i < n; i += NTHREADS) IDX[s0 + i] = 0; }
    for (int grp = blockIdx.x; grp < NTOK / 64; grp += gridDim.x) {
        if (wave == 0) {
            const int tok = grp * 64 + lane, b = tok / SEQ, t = tok % SEQ, row = b * TPB + t;
            const int e1 = TOPK[tok * 4], e2 = TOPK[tok * 4 + 1]; int s0 = 0, s1 = 0;
            unsigned long long msk[8]; int nmine = 0;
#pragma unroll
            for (int e = 0; e < 8; ++e) { msk[e] = __ballot((e1 == e) || (e2 == e)); nmine = (lane == e) ? __popcll(msk[e]) : nmine; }
            unsigned base = 0; if (lane < 8 && nmine) base = __hip_atomic_fetch_add(ctl + CW_CUR + lane, (unsigned)nmine, __ATOMIC_RELAXED, __HIP_MEMORY_SCOPE_AGENT);
#pragma unroll
            for (int e = 0; e < 8; ++e) { const unsigned be = __shfl(base, e);
                const int slot = toff[e] * 256 + (int)be + __popcll(msk[e] & ((1ull << lane) - 1ull));
                if (e1 == e) s0 = slot; if (e2 == e) s1 = slot; }
            SLOT[tok * 2] = s0; SLOT[tok * 2 + 1] = s1; IDX[s0] = row; IDX[s1] = row;
        }
    }
    __syncthreads();
}
template <int L> __device__ __forceinline__ void phase_row_end(ArgsP a, int gw, int ngw, int lane) {
    bf16_t* X = (bf16_t*)(a->ws + WS_X); bf16_t* H = (bf16_t*)(a->ws + WS_H); const float* MOD = (const float*)(a->ws + WS_MOD); const bf16_t* Y = (const bf16_t*)(a->ws + WS_Y);
    for (int row = gw; row < NR; row += ngw) {
        const int b = row / TPB, t = row % TPB; const bool lat = t < SEQ; const int v = lat ? b : 4;
        if (L == 1 && !lat) continue;
        const float* mv = MOD + (size_t)(L * 5 + v) * MODW;
        f32x4 y[8], x[8], h[8];
        if (L == 0 && !lat) { const bf16_t* P = (const bf16_t*)(a->ws + WS_PART_B) + (size_t)(b * CTX + (t - SEQ)) * D; ld_row_bf16(P, lane, y);
#pragma unroll
            for (int s = 1; s < 8; ++s) { f32x4 p[8]; ld_row_bf16(P + (size_t)s * (NB * CTX) * D, lane, p);
#pragma unroll
                for (int j = 0; j < 8; ++j) y[j] = y[j] + p[j]; } }
        else if (L == 0) ld_row_bf16(Y + (size_t)row * D, lane, y);
        else { const int tok = b * SEQ + t; const int* sl = (const int*)(a->ws + WS_SLOT) + tok * 2; const float* tk = (const float*)(a->ws + WS_TOPK) + (size_t)tok * 4; const float g1 = tk[2], g2 = tk[3];
            f32x4 y2[8]; ld_row_bf16(Y + (size_t)sl[0] * D, lane, y); ld_row_bf16(Y + (size_t)sl[1] * D, lane, y2);
#pragma unroll
            for (int j = 0; j < 8; ++j) y[j] = y[j] * g1 + y2[j] * g2; }
        ld_row_bf16(X + (size_t)row * D, lane, x);
        const float r1 = row_rstd(y);
#pragma unroll
        for (int j = 0; j < 8; ++j) { const int c = 4 * lane + 256 * j; const f32x4 gv = *(const f32x4*)(a->in[I_GFFNPOST] + L * D + c), gt = *(const f32x4*)(mv + 5 * D + c);
            x[j] = x[j] + gt * (y[j] * r1 * gv); }
        if (L == 0) { st_row_bf16(X + (size_t)row * D, lane, x); const float* mn = MOD + (size_t)(1 * 5 + v) * MODW;
            norm_mod_store(x, a->in[I_GMIXPRE] + D, mn + 0 * D, mn + 1 * D, H + (size_t)row * D, lane, h); }
        else st_row_f32(a->out + ((size_t)b * SEQ + t) * D, lane, x);
    }
}

template <int L> __device__ __forceinline__ void phase_qkpost(ArgsP a, LAS unsigned char* lds, int gw, int ngw, int tid, int lane) {
    bf16_t* QKV = (bf16_t*)(a->ws + WS_QKV);
    const float L2T = 13.287712379549449f;
    LAS f32x2* tg = (LAS f32x2*)lds; LAS f32x2* td = tg + 64 * 32;
    for (int i = tid; i < 64 * 32 + 64 * 16; i += NTHREADS) { float s_, c_;
        if (i < 64 * 32) { sincosf((float)(i >> 5) * exp2f(-(float)(i & 31) * (1.f / 32.f) * L2T), &s_, &c_); tg[i] = (f32x2){c_, s_}; }
        else { const int q_ = i - 64 * 32; sincosf((float)(q_ >> 4) * exp2f(-(float)(q_ & 15) * (1.f / 16.f) * L2T), &s_, &c_); td[q_] = (f32x2){c_, s_}; } }
    __syncthreads();
    const float qn0 = a->in[I_QNORM][L * 128 + lane], qn1 = a->in[I_QNORM][L * 128 + 64 + lane], kn0 = a->in[I_KNORM][L * 128 + lane], kn1 = a->in[I_KNORM][L * 128 + 64 + lane];
    for (int row = gw; row < NR; row += ngw) {
        const int t = row % TPB; const bool lat = t < SEQ; const int gr = t >> 6, gc = t & 63;
        bf16_t* q = QKV + (size_t)row * INW;
        const f32x2 t_r = tg[gr * 32 + (lane & 31)], t_c = tg[gc * 32 + (lane & 31)], t_d = td[(lane < 32 ? gr : gc) * 16 + (lane & 15)];
        const float cr = t_r.x, sr = t_r.y, cc = t_c.x, sc2 = t_c.y, cd = t_d.x, sd = t_d.y;
        float e0[10], e1[10], f0[8], f1[8];
#pragma unroll
        for (int hd = 8; hd < 10; ++hd) { const int base = hd < 8 ? 1536 + hd * 128 : 2560 + (hd - 8) * 128; e0[hd] = bf2f(q[base + lane]); e1[hd] = bf2f(q[base + 64 + lane]); }
        if (lat) {
#pragma unroll
            for (int bl = 4; bl < 8; ++bl) { const int base = 3072 + bl * 128; f0[bl] = bf2f(q[base + lane]); f1[bl] = bf2f(q[base + 64 + lane]); } }
#pragma unroll
        for (int hd = 8; hd < 10; ++hd) {
            const int base = hd < 8 ? 1536 + hd * 128 : 2560 + (hd - 8) * 128;
            float x0 = e0[hd], x1 = e1[hd];
            const float r = rsqrtf(wave_sum(x0 * x0 + x1 * x1) * (1.f / 128.f) + EPS);
            x0 = x0 * r * (hd < 8 ? qn0 : kn0); x1 = x1 * r * (hd < 8 ? qn1 : kn1);
            if (lat) { const float p0 = __shfl_xor(x0, 32), p1 = __shfl_xor(x1, 32);
                if (lane < 32) { x0 = x0 * cr - p0 * sr; x1 = x1 * cc - p1 * sc2; } else { x0 = x0 * cr + p0 * sr; x1 = x1 * cc + p1 * sc2; } }
            q[base + lane] = f2bf(x0); q[base + 64 + lane] = f2bf(x1);
        }
        if (lat) {
#pragma unroll
            for (int bl = 4; bl < 8; ++bl) {
                const int base = 3072 + bl * 128;
                float x0 = f0[bl], x1 = f1[bl];
                const float p0 = __shfl_xor(x0, 16), p1 = __shfl_xor(x1, 16);
                if ((lane & 16) == 0) { x0 = x0 * cd - p0 * sd; x1 = x1 * cd - p1 * sd; } else { x0 = x0 * cd + p0 * sd; x1 = x1 * cd + p1 * sd; }
                q[base + lane] = f2bf(x0); q[base + 64 + lane] = f2bf(x1);
            }
        }
    }
}

namespace att {
typedef short s16x4 __attribute__((ext_vector_type(4)));
typedef float f32x16 __attribute__((ext_vector_type(16)));
constexpr int KVBLK = 64;
constexpr int SHM_V = KVBLK * 128 * 2, SHM_K = KVBLK * 128 * 2;
constexpr float THR = 8.f;
#define KSWZ(row, colB) ((row) * 256 + ((colB) ^ (((row) & 7) << 4)))
#define SBAR() __builtin_amdgcn_sched_barrier(0)
__device__ __forceinline__ int crow(int r, int hi) { return (r & 3) + 8 * (r >> 2) + 4 * hi; }
__device__ __forceinline__ unsigned cvtpk(float lo, float hi) { unsigned r; asm volatile("v_cvt_pk_bf16_f32 %0, %1, %2" : "=v"(r) : "v"(lo), "v"(hi)); return r; }
constexpr float THRL = 64.f;
template <int MODE> __device__ __forceinline__ void partialSM(f32x16& p0, f32x16& p1, float& m_reg, float& mn, float& alpha, bool chk = true) {
  mn = m_reg; alpha = 1.f;
  if (chk) {
    float pmax = p0[0];
#pragma unroll
    for (int r = 1; r < 16; ++r) pmax = fmaxf(pmax, p0[r]);
#pragma unroll
    for (int r = 0; r < 16; ++r) pmax = fmaxf(pmax, p1[r]);
    { auto rr = __builtin_amdgcn_permlane32_swap(__float_as_uint(pmax), __float_as_uint(pmax), false, false);
      pmax = fmaxf(__uint_as_float(rr[0]), __uint_as_float(rr[1])); }
    if (!__builtin_expect(__all(pmax - m_reg <= THRL), 1)) { mn = fmaxf(m_reg, pmax); alpha = __builtin_amdgcn_exp2f(m_reg - mn); m_reg = mn; }
  }
  if (__builtin_expect(__any(mn != 0.f), 0)) {
#pragma unroll
    for (int r = 0; r < 16; ++r) { p0[r] -= mn; p1[r] -= mn; }
  }
#pragma unroll
  for (int r = 0; r < 16; ++r) p0[r] = __builtin_amdgcn_exp2f(p0[r]);
}
template <bool LSUM = false> __device__ __forceinline__ void finishSM(f32x16& p0, f32x16& p1, float alpha, float& l_reg, bf16x8& pa0, bf16x8& pa1, bf16x8& pa2, bf16x8& pa3) {
#pragma unroll
  for (int r = 0; r < 16; ++r) p1[r] = __builtin_amdgcn_exp2f(p1[r]);
  if (!LSUM) { float ps = 0;
#pragma unroll
  for (int r = 0; r < 16; ++r) ps += p0[r];
#pragma unroll
  for (int r = 0; r < 16; ++r) ps += p1[r];
  { auto rr = __builtin_amdgcn_permlane32_swap(__float_as_uint(ps), __float_as_uint(ps), false, false);
    ps = __uint_as_float(rr[0]) + __uint_as_float(rr[1]); }
  l_reg = l_reg * alpha + ps; }
#define PK4(P, BASE, OUT) do { unsigned a0 = cvtpk(P[BASE + 0], P[BASE + 1]), a1 = cvtpk(P[BASE + 2], P[BASE + 3]);   \
    unsigned b0 = cvtpk(P[BASE + 4], P[BASE + 5]), b1 = cvtpk(P[BASE + 6], P[BASE + 7]);                              \
    auto r0 = __builtin_amdgcn_permlane32_swap(a0, b0, false, false); auto r1 = __builtin_amdgcn_permlane32_swap(a1, b1, false, false); \
    u32x4 w = {r0[0], r1[0], r0[1], r1[1]}; OUT = *reinterpret_cast<bf16x8*>(&w); } while (0)
  PK4(p0, 0, pa0); PK4(p0, 8, pa1); PK4(p1, 0, pa2); PK4(p1, 8, pa3);
#undef PK4
}
template <int NQ> __device__ __forceinline__ void qkt(f32x16& p0, f32x16& p1, const LAS unsigned char* Ks, const bf16x8* qr, int r32, int hi, int mapoff) {
  p0 = f32x16{}; p1 = f32x16{};
#pragma unroll
  for (int d0 = 0; d0 < NQ; ++d0) { int cb = (mapoff + d0 * 16 + hi * 8) * 2;
    bf16x8 b0 = *reinterpret_cast<const LAS bf16x8*>(Ks + KSWZ(r32, cb));
    bf16x8 b1 = *reinterpret_cast<const LAS bf16x8*>(Ks + KSWZ(32 + r32, cb));
    p0 = __builtin_amdgcn_mfma_f32_32x32x16_bf16(b0, qr[d0], p0, 0, 0, 0);
    p1 = __builtin_amdgcn_mfma_f32_32x32x16_bf16(b1, qr[d0], p1, 0, 0, 0); }
}
__device__ __forceinline__ int v_st(int k, int c) { const int kk = (k & ~0xC) | ((k & 4) << 1) | ((k & 8) >> 1); return ((kk >> 3) * 4 + (c >> 5)) * 512 + ((kk & 7) * 32 + (c & 31)) * 2; }
__device__ __forceinline__ int v_rd_base(int lane) { return ((lane & 3) << 3) | (((lane >> 2) & 3) << 6) | (((lane >> 4) & 1) << 5) | (((lane >> 5) & 1) << 8); }
constexpr int v_rd_off(int d0, int ks, int half) { return d0 * 512 + ks * 4096 + half * 2048; }
template <int OFF> __device__ __forceinline__ s16x4 tr_read(int vb) {
  s16x4 r; asm volatile("ds_read_b64_tr_b16 %0, %1 offset:%2" : "=&v"(r) : "v"(vb), "i"(OFF) : "memory"); return r;
}
template <int D0> __device__ __forceinline__ void pv_one(f32x16& od, int vb, bf16x8 pa0, bf16x8 pa1, bf16x8 pa2, bf16x8 pa3) {
  const s16x4 l0 = tr_read<v_rd_off(D0, 0, 0)>(vb), h0 = tr_read<v_rd_off(D0, 0, 1)>(vb), l1 = tr_read<v_rd_off(D0, 1, 0)>(vb), h1 = tr_read<v_rd_off(D0, 1, 1)>(vb);
  const s16x4 l2 = tr_read<v_rd_off(D0, 2, 0)>(vb), h2 = tr_read<v_rd_off(D0, 2, 1)>(vb), l3 = tr_read<v_rd_off(D0, 3, 0)>(vb), h3 = tr_read<v_rd_off(D0, 3, 1)>(vb);
  asm volatile("s_waitcnt lgkmcnt(0)" ::: "memory"); SBAR();
#define PK(L, H) (bf16x8){L[0], L[1], L[2], L[3], H[0], H[1], H[2], H[3]}
  od = __builtin_amdgcn_mfma_f32_32x32x16_bf16(pa0, PK(l0, h0), od, 0, 0, 0);
  od = __builtin_amdgcn_mfma_f32_32x32x16_bf16(pa1, PK(l1, h1), od, 0, 0, 0);
  od = __builtin_amdgcn_mfma_f32_32x32x16_bf16(pa2, PK(l2, h2), od, 0, 0, 0);
  od = __builtin_amdgcn_mfma_f32_32x32x16_bf16(pa3, PK(l3, h3), od, 0, 0, 0);
#undef PK
}
__device__ __forceinline__ void lsum_mm(f32x16& lacc, bf16x8 onesB, bf16x8 pa0, bf16x8 pa1, bf16x8 pa2, bf16x8 pa3) {
  lacc = __builtin_amdgcn_mfma_f32_32x32x16_bf16(pa0, onesB, lacc, 0, 0, 0); lacc = __builtin_amdgcn_mfma_f32_32x32x16_bf16(pa1, onesB, lacc, 0, 0, 0);
  lacc = __builtin_amdgcn_mfma_f32_32x32x16_bf16(pa2, onesB, lacc, 0, 0, 0); lacc = __builtin_amdgcn_mfma_f32_32x32x16_bf16(pa3, onesB, lacc, 0, 0, 0);
}
__device__ __forceinline__ void pv_d0(f32x16* o, int vb, bf16x8 pa0, bf16x8 pa1, bf16x8 pa2, bf16x8 pa3) {
  pv_one<0>(o[0], vb, pa0, pa1, pa2, pa3); pv_one<1>(o[1], vb, pa0, pa1, pa2, pa3); pv_one<2>(o[2], vb, pa0, pa1, pa2, pa3); pv_one<3>(o[3], vb, pa0, pa1, pa2, pa3);
}
template <int MODE>
__device__ __forceinline__ void attn_body(const bf16_t* __restrict__ Qb, const bf16_t* __restrict__ Kh, const bf16_t* __restrict__ Vh, bf16_t* __restrict__ Ob, int seq, LAS unsigned char* lds,
                                          float lam, float osc, const float* __restrict__ subln, int na_r0 = 0, int na_R0 = 0, int qproc = 0, const float* __restrict__ qnw = nullptr, int trow0 = 0) {
  constexpr int NQ = MODE == 1 ? 4 : 8;
  const int tid = threadIdx.x, wid = __builtin_amdgcn_readfirstlane(tid >> 6), lane = tid & 63, r32 = lane & 31, hi = lane >> 5;
  const int wrow = MODE == 1 ? (wid & 3) : wid, mapoff = MODE == 1 ? (wid >> 2) * 64 : 0;
  LAS unsigned char* V_lds = lds; LAS unsigned char* K_lds = lds + 2 * SHM_V;
  LAS float* wsf = (LAS float*)(lds + 2 * SHM_V + 2 * SHM_K) + wid * 64; LAS float* li_l = wsf; LAS float* al_l = wsf + 32;
  constexpr bool LSUM = (MODE == 1);
  float m_reg = 0.f, l_reg = 0; f32x16 o[4] = {}; bf16x8 qr[NQ]; f32x16 lacc = {};
  bf16x8 onesB; { const short one_ = (r32 == 0) ? (short)0x3F80 : (short)0; onesB = (bf16x8){one_, one_, one_, one_, one_, one_, one_, one_}; }
  const bf16_t* Qw = Qb + (size_t)(wrow * 32 + r32) * INW + mapoff + hi * 8;
  { const LAS f32x2* tg = (const LAS f32x2*)(lds + 73728); const LAS f32x2* td = tg + 64 * 32;
    const int trow = trow0 + wrow * 32 + r32, gr = trow >> 6, gc = trow & 63;
    constexpr float CQ = (MODE == 1 ? 0.125f : 0.088388347648318440f) * 1.4426950408889634f;
#define QLD(X, D0) do { const u32x4 w_ = *reinterpret_cast<const u32x4*>(Qw + (D0) * 16); X[0] = bf_lo(w_.x); X[1] = bf_hi(w_.x); X[2] = bf_lo(w_.y); X[3] = bf_hi(w_.y); X[4] = bf_lo(w_.z); X[5] = bf_hi(w_.z); X[6] = bf_lo(w_.w); X[7] = bf_hi(w_.w); } while (0)
#define QPK(X, D0, SC) do { u32x4 s_; s_.x = cvtpk(X[0] * (SC), X[1] * (SC)); s_.y = cvtpk(X[2] * (SC), X[3] * (SC)); s_.z = cvtpk(X[4] * (SC), X[5] * (SC)); s_.w = cvtpk(X[6] * (SC), X[7] * (SC)); qr[D0] = *reinterpret_cast<bf16x8*>(&s_); } while (0)
    float rr = 1.f;
    if (MODE == 0 && qproc >= 1) { float ss = 0.f;
#pragma unroll
      for (int d0 = 0; d0 < NQ; ++d0) { float x[8]; QLD(x, d0);
#pragma unroll
        for (int e = 0; e < 8; ++e) ss += x[e] * x[e]; }
      ss += __shfl_xor(ss, 32); rr = rsqrtf(ss * (1.f / 128.f) + EPS); }
    constexpr int NPAIR = NQ / 2, PSTEP = MODE == 1 ? 1 : 2;
#pragma unroll
    for (int pr = 0; pr < NPAIR; ++pr) {
      const int da = MODE == 1 ? 2 * pr : 4 * (pr >> 1) + (pr & 1), db = da + PSTEP;
      float xa[8], xb[8]; QLD(xa, da); QLD(xb, db);
      if (MODE == 0 && qproc >= 1) { const f32x4 ga0 = *(const f32x4*)(qnw + 16 * da + 8 * hi), ga1 = *(const f32x4*)(qnw + 16 * da + 8 * hi + 4), gb0 = *(const f32x4*)(qnw + 16 * db + 8 * hi), gb1 = *(const f32x4*)(qnw + 16 * db + 8 * hi + 4);
#pragma unroll
        for (int e = 0; e < 4; ++e) { xa[e] *= rr * ga0[e]; xa[4 + e] *= rr * ga1[e]; xb[e] *= rr * gb0[e]; xb[4 + e] *= rr * gb1[e]; } }
      if (qproc == 2) {
        const LAS f32x2* tb = MODE == 1 ? td + (pr ? gc : gr) * 16 + 8 * hi : tg + ((pr >> 1) ? gc : gr) * 32 + 16 * (pr & 1) + 8 * hi;
#pragma unroll
        for (int e = 0; e < 8; ++e) { const f32x2 cs = tb[e]; const float x1 = xa[e], x2 = xb[e]; xa[e] = x1 * cs.x - x2 * cs.y; xb[e] = x2 * cs.x + x1 * cs.y; } }
      QPK(xa, da, CQ); QPK(xb, db, CQ);
    }
#undef QLD
#undef QPK
  }
  const int sr = tid >> 4, sc = (tid & 15) * 8, vst0 = v_st(sr, sc), vst1 = v_st(32 + sr, sc);
  const int vb0 = (int)(uintptr_t)V_lds + v_rd_base(lane);
  struct { bf16x8 vs0, vs1, ks0, ks1; } sr_[1];
#define TOK(T) (MODE == 2 ? ((T) < 4 ? SEQ + 64 * (T) : (na_R0 + (T) - 4) * 64) : (T) * KVBLK)
  const unsigned kvoff = (unsigned)(sr * INW + sc) * 2u;
#define SLOAD(i, T) do { const size_t tb_ = (size_t)TOK(T) * (INW * 2); const char* vb_ = (const char*)Vh + tb_; const char* kb_ = (const char*)Kh + tb_; \
    sr_[i].vs0 = *(const bf16x8*)(vb_ + kvoff); sr_[i].vs1 = *(const bf16x8*)(vb_ + (size_t)32 * INW * 2 + kvoff); \
    sr_[i].ks0 = *(const bf16x8*)(kb_ + kvoff); sr_[i].ks1 = *(const bf16x8*)(kb_ + (size_t)32 * INW * 2 + kvoff); } while (0)
  LAS float* rpbL = (LAS float*)(lds + 2 * SHM_V + 2 * SHM_K + 2048);
  const int na_rq = na_r0 + (wid >> 1), na_rs = min(max(na_rq - 4, 0), 56);
#define NABIAS(P0, P1, T) do { if (MODE == 2 && (T) >= 4) { const int na_c = ((wid & 1) << 5) + r32, na_t = 4 * hi - min(max(na_c - 8, 0), 48); \
    const int kr_ = na_R0 + (T) - 4; const bool rowok_ = kr_ >= na_rs && kr_ < na_rs + 8; const LAS float* bp_ = rpbL + (172 + (kr_ - na_rq + 7) * 31 + 15 - na_c + 4 * hi); \
    _Pragma("unroll") for (int r = 0; r < 16; ++r) { const int kq_ = (r & 3) + 8 * (r >> 2); \
      { const bool ok_ = rowok_ && (unsigned)(na_t + kq_) < 16u; P0[r] = ok_ ? fmaf(bp_[kq_], 1.4426950408889634f, P0[r]) : -1e30f; } \
      { const bool ok_ = rowok_ && (unsigned)(na_t + kq_ + 32) < 16u; P1[r] = ok_ ? fmaf(bp_[kq_ + 32], 1.4426950408889634f, P1[r]) : -1e30f; } } } } while (0)
#define SWRITE(b, i) do { *(LAS bf16x8*)(V_lds + (b) * SHM_V + vst0) = sr_[i].vs0;          \
    *(LAS bf16x8*)(V_lds + (b) * SHM_V + vst1) = sr_[i].vs1; int kc = sc * 2;               \
    *(LAS bf16x8*)(K_lds + (b) * SHM_K + KSWZ(sr, kc)) = sr_[i].ks0;                       \
    *(LAS bf16x8*)(K_lds + (b) * SHM_K + KSWZ(32 + sr, kc)) = sr_[i].ks1; } while (0)
#define SWAIT() asm volatile("s_waitcnt vmcnt(0)" ::: "memory")
#define RESC(a) do { if (__any((a) < 1.f)) { if (hi == 0) al_l[r32] = (a); asm volatile("s_waitcnt lgkmcnt(0)" ::: "memory"); \
    _Pragma("unroll") for (int d = 0; d < 4; ++d) _Pragma("unroll") for (int r = 0; r < 16; ++r) o[d][r] *= al_l[crow(r, hi)]; \
    if (LSUM) { _Pragma("unroll") for (int r = 0; r < 16; ++r) lacc[r] *= al_l[crow(r, hi)]; } } } while (0)
  f32x16 pA0, pA1, pB0, pB1; float mnA, mnB, alA, alB; bf16x8 pa0, pa1, pa2, pa3; const int NT = seq / KVBLK;
  if (MODE == 2) { for (int i = tid; i < 832; i += 512) { const int q = i - 172, dr = q >= 0 ? q / 31 : -1, dc = q - dr * 31; rpbL[i] = (q >= 0 && dr < 15) ? subln[dr * 31 + dc] : 0.f; } }
  SLOAD(0, 0); SWAIT(); SWRITE(0, 0); SLOAD(0, 1); __syncthreads();
  qkt<NQ>(pA0, pA1, K_lds, qr, r32, hi, mapoff); NABIAS(pA0, pA1, 0); partialSM<MODE>(pA0, pA1, m_reg, mnA, alA);
  SWAIT(); SWRITE(1, 0); if (2 < NT) SLOAD(0, 2); __syncthreads();
  for (int j = 1; j + 1 < NT; j += 2) {
    SBAR(); qkt<NQ>(pB0, pB1, K_lds + SHM_K, qr, r32, hi, mapoff);
    finishSM<LSUM>(pA0, pA1, alA, l_reg, pa0, pa1, pa2, pa3); SBAR();
    pv_d0(o, vb0, pa0, pa1, pa2, pa3); if (LSUM) lsum_mm(lacc, onesB, pa0, pa1, pa2, pa3); NABIAS(pB0, pB1, j); partialSM<MODE>(pB0, pB1, m_reg, mnB, alB, MODE == 2 || (j & 3) == 1);
    __syncthreads(); SWAIT(); SWRITE(0, 0); SLOAD(0, j + 2);
    RESC(alB); __syncthreads();
    SBAR(); qkt<NQ>(pA0, pA1, K_lds, qr, r32, hi, mapoff);
    finishSM<LSUM>(pB0, pB1, alB, l_reg, pa0, pa1, pa2, pa3); SBAR();
    pv_d0(o, vb0 + SHM_V, pa0, pa1, pa2, pa3); if (LSUM) lsum_mm(lacc, onesB, pa0, pa1, pa2, pa3); NABIAS(pA0, pA1, j + 1); partialSM<MODE>(pA0, pA1, m_reg, mnA, alA, MODE == 2);
    __syncthreads(); SWAIT(); SWRITE(1, 0); if (j + 3 < NT) SLOAD(0, j + 3);
    RESC(alA); __syncthreads();
  }
  SBAR(); qkt<NQ>(pB0, pB1, K_lds + SHM_K, qr, r32, hi, mapoff);
  finishSM<LSUM>(pA0, pA1, alA, l_reg, pa0, pa1, pa2, pa3); SBAR();
  pv_d0(o, vb0, pa0, pa1, pa2, pa3); if (LSUM) lsum_mm(lacc, onesB, pa0, pa1, pa2, pa3); NABIAS(pB0, pB1, NT - 1); partialSM<MODE>(pB0, pB1, m_reg, mnB, alB);
  __syncthreads(); RESC(alB);
  finishSM<LSUM>(pB0, pB1, alB, l_reg, pa0, pa1, pa2, pa3); SBAR();
  pv_d0(o, vb0 + SHM_V, pa0, pa1, pa2, pa3); if (LSUM) lsum_mm(lacc, onesB, pa0, pa1, pa2, pa3);
  if (hi == 0) li_l[r32] = l_reg; asm volatile("s_waitcnt lgkmcnt(0)" ::: "memory");
  float rli[16];
#pragma unroll
  for (int r = 0; r < 16; ++r) { if (LSUM) { const float la = __int_as_float(__builtin_amdgcn_readlane(__float_as_int(lacc[r]), 0)), lb = __int_as_float(__builtin_amdgcn_readlane(__float_as_int(lacc[r]), 32)); rli[r] = __builtin_amdgcn_rcpf(hi ? lb : la); }
    else rli[r] = __builtin_amdgcn_rcpf(li_l[crow(r, hi)]); }
  bf16_t* Ow = Ob + (size_t)(wrow * 32) * D;
  if (MODE != 1) {
#pragma unroll
    for (int r = 0; r < 16; ++r) { const int orow = crow(r, hi);
#pragma unroll
      for (int d0 = 0; d0 < 4; ++d0) Ow[(size_t)orow * D + d0 * 32 + r32] = f2bf(o[d0][r] * rli[r]); }
    __syncthreads();
  } else {
#pragma unroll
    for (int r = 0; r < 16; ++r)
#pragma unroll
      for (int d0 = 0; d0 < 4; ++d0) o[d0][r] *= rli[r];
    __syncthreads();
    LAS float* xb = (LAS float*)lds + (wid & 3) * 4096;
    if (wid >= 4) {
#pragma unroll
      for (int r = 0; r < 16; ++r)
#pragma unroll
        for (int d0 = 0; d0 < 4; ++d0) xb[crow(r, hi) * 128 + d0 * 32 + r32] = o[d0][r];
    }
    __syncthreads();
    if (wid < 4) {
      float sg[4];
#pragma unroll
      for (int d0 = 0; d0 < 4; ++d0) sg[d0] = subln[d0 * 32 + r32] * osc;
#pragma unroll
      for (int r = 0; r < 16; ++r) { float ss = 0.f;
#pragma unroll
        for (int d0 = 0; d0 < 4; ++d0) { o[d0][r] -= lam * xb[crow(r, hi) * 128 + d0 * 32 + r32]; ss += o[d0][r] * o[d0][r]; }
#pragma unroll
        for (int x = 1; x < 32; x <<= 1) ss += __shfl_xor(ss, x);
        const float rr = rsqrtf(ss * (1.f / 128.f) + EPS); const int orow = crow(r, hi);
#pragma unroll
        for (int d0 = 0; d0 < 4; ++d0) Ow[(size_t)orow * D + d0 * 32 + r32] = f2bf(o[d0][r] * rr * sg[d0]); }
    }
    __syncthreads();
  }
#undef SLOAD
#undef TOK
#undef NABIAS
#undef SWRITE
#undef SWAIT
#undef RESC
}
}

namespace pg8 {
constexpr int BM = 256, BK = 64, HALF = 128, HTB = HALF * BK * 2, STAGE_BYTES = 8 * HTB, NXCD = 8, WGM = 8;
__host__ __device__ __forceinline__ int lds_byte(int r, int c) { const int st = (r >> 4) * 2 + (c >> 5), rr = r & 15, cc = c & 31, ob = rr * 64 + cc * 2; return st * 1024 + (ob ^ (((ob >> 9) & 1) << 5)); }
__host__ __device__ __forceinline__ void stage_rc(int b, int& R, int& C) { const int st = b / 1024, sb = b % 1024, swz = sb ^ (((sb >> 9) & 1) << 5); R = (st >> 1) * 16 + swz / 64; C = (st & 1) * 32 + (swz % 64) / 2; }
__host__ __device__ __forceinline__ int perm32(int rho) { const int n = rho >> 4, i = rho & 15; return 8 * (i >> 2) + 4 * n + (i & 3); }
struct Unit { int pm, pn; size_t boff; int kt0, nt, split; };
struct Gemm { const void* A; const void* Bt; int KB; const int* idx = nullptr; };
typedef int v8i __attribute__((ext_vector_type(8))); typedef int v4i __attribute__((ext_vector_type(4)));
template <bool SKIPCTX> struct StaticOrder {
    int nM, nN, nwg, G, c, ntk;
    __device__ void init(int nM_, int nN_, int G_, int c_, int ntk_) { nM = nM_; nN = nN_; nwg = nM * nN; G = G_; c = c_; ntk = ntk_; }
    __device__ bool next(int i, Unit& u) const {
        const long L = (long)i * G + c; if (L >= nwg) return false;
        int wgid = (int)L; { const int q = nwg / NXCD, r = nwg % NXCD, xcd = wgid % NXCD, off = wgid / NXCD; wgid = (xcd < r ? xcd * (q + 1) : r * (q + 1) + (xcd - r) * q) + off; }
        const int nig = WGM * nN, gid = wgid / nig, fm = gid * WGM, gsz = (nM - fm) < WGM ? (nM - fm) : WGM;
        int pm = fm + ((wgid % nig) % gsz); u.pn = (wgid % nig) / gsz; if (SKIPCTX) pm += pm >> 4; u.pm = pm; u.boff = 0; u.kt0 = 0; u.nt = ntk; u.split = -1; return true;
    }
};
struct SplitCtxOrder {
    StaticOrder<true> lat; int ntk;
    __device__ void init(int G_, int c_, int ntk_) { lat.init(NTOK / 256, D / 256, G_, c_, ntk_); ntk = ntk_; }
    __device__ bool next(int i, Unit& u) const {
        const long L = (long)i * lat.G + lat.c;
        if (L < lat.nwg) return lat.next(i, u);
        const int q = (int)(L - lat.nwg); if (q >= 256) return false;
        const int s = q >> 5, pc = (q >> 3) & 3; u.pn = q & 7; u.pm = 17 * pc + 16; u.boff = 0; u.split = s;
        const int pairs = ntk >> 1, base = pairs >> 3, rem = pairs & 7;
        u.kt0 = 2 * (s * base + (s < rem ? s : rem)); u.nt = 2 * (base + (s < rem ? 1 : 0)); return true;
    }
};
struct MoeOrder {
    int nM, nN, nwg, G, c, ntk; int toff[8]; size_t bstride;
    __device__ void init(const LAS int* t, int nN_, int G_, int c_, size_t bstride_, int ntk_) { ntk = ntk_; for (int e = 0; e < 8; ++e) toff[e] = __builtin_amdgcn_readfirstlane(t[e]); nM = __builtin_amdgcn_readfirstlane(t[8]); nN = nN_; nwg = nM * nN; G = G_; c = c_; bstride = bstride_; }
    __device__ bool next(int i, Unit& u) const {
        const long L = (long)i * G + c; if (L >= nwg) return false;
        int wgid = (int)L; { const int q = nwg / NXCD, r = nwg % NXCD, xcd = wgid % NXCD, off = wgid / NXCD; wgid = (xcd < r ? xcd * (q + 1) : r * (q + 1) + (xcd - r) * q) + off; }
        const int nig = WGM * nN, gid = wgid / nig, fm = gid * WGM, gsz = (nM - fm) < WGM ? (nM - fm) : WGM;
        const int pm = fm + ((wgid % nig) % gsz); u.pn = (wgid % nig) / gsz; u.pm = pm;
        int e = 0;
#pragma unroll
        for (int q = 1; q < 8; ++q) e += (pm >= toff[q]) ? 1 : 0;
        u.boff = (size_t)e * bstride; u.kt0 = 0; u.nt = ntk; u.split = -1; return true;
    }
};
template <bool SCALED> struct EpiBf16T {
    bf16_t* O; int ldc; float scale;
    __device__ __forceinline__ void operator()(const f32x4 (&acc)[2][2][4][2], const Unit& u, int wr, int wc, int fr, int fq) const {
        const int row0 = u.pm * BM + wr * 64 + fr, col0 = u.pn * BM + wc * 32 + 8 * fq;
#pragma unroll
        for (int ai = 0; ai < 2; ++ai)
#pragma unroll
            for (int m = 0; m < 4; ++m) { bf16_t* rowp = O + (size_t)(row0 + ai * HALF + m * 16) * ldc + col0;
#pragma unroll
                for (int bj = 0; bj < 2; ++bj) { f32x4 v0 = acc[ai][bj][m][0], v1 = acc[ai][bj][m][1]; if (SCALED) { v0 = v0 * scale; v1 = v1 * scale; }
                    u32x4 w; w.x = cvt_pk_bf16(v0[0], v0[1]); w.y = cvt_pk_bf16(v0[2], v0[3]); w.z = cvt_pk_bf16(v1[0], v1[1]); w.w = cvt_pk_bf16(v1[2], v1[3]);
                    *(u32x4*)(rowp + bj * HALF) = w; } }
    }
};
__device__ __forceinline__ float silu_mul(float g, float u) { return g * __builtin_amdgcn_rcpf(1.f + __expf(-g)) * u; }
typedef float f32x2 __attribute__((ext_vector_type(2)));
__device__ __forceinline__ f32x2 swiglu2(f32x2 g, f32x2 u, float c1, float c3) {
    const f32x2 t = g * c1; f32x2 e; e.x = __builtin_amdgcn_exp2f(t.x); e.y = __builtin_amdgcn_exp2f(t.y);
    const f32x2 d = __builtin_elementwise_fma(e, (f32x2){c3, c3}, (f32x2){c3, c3}); f32x2 r; r.x = __builtin_amdgcn_rcpf(d.x); r.y = __builtin_amdgcn_rcpf(d.y);
    return (g * u) * r; }
template <bool SCALED> struct EpiSwigluT {
    bf16_t* O; int ldc;
    __device__ __forceinline__ void operator()(const f32x4 (&acc)[2][2][4][2], const Unit& u, int wr, int wc, int fr, int fq) const {
        const int row0 = u.pm * BM + wr * 64 + fr, col0 = u.pn * HALF + wc * 32 + 8 * fq;
#pragma unroll
        for (int ai = 0; ai < 2; ++ai)
#pragma unroll
            for (int m = 0; m < 4; ++m) { bf16_t* rowp = O + (size_t)(row0 + ai * HALF + m * 16) * ldc + col0;
                constexpr float SI = SCALED ? 1.f / (F8_SH * F8_SW) : 1.f, C1 = -SI * 1.4426950408889634f, C3 = 1.f / (SI * SI);
                const f32x4 g0 = acc[ai][0][m][0], g1 = acc[ai][0][m][1], u0 = acc[ai][1][m][0], u1 = acc[ai][1][m][1];
                const f32x2 a = swiglu2(g0.xy, u0.xy, C1, C3), b = swiglu2(g0.zw, u0.zw, C1, C3), c = swiglu2(g1.xy, u1.xy, C1, C3), d = swiglu2(g1.zw, u1.zw, C1, C3);
                u32x4 w; w.x = cvt_pk_bf16(a.x, a.y); w.y = cvt_pk_bf16(b.x, b.y); w.z = cvt_pk_bf16(c.x, c.y); w.w = cvt_pk_bf16(d.x, d.y);
                *(u32x4*)rowp = w; }
    }
};
typedef EpiBf16T<false> EpiBf16;
typedef EpiSwigluT<false> EpiSwiglu;
struct EpiBf16OrPart {
    bf16_t* O; int ldc; bf16_t* PART;
    __device__ __forceinline__ void operator()(const f32x4 (&acc)[2][2][4][2], const Unit& u, int wr, int wc, int fr, int fq) const {
        if (u.split < 0) { EpiBf16 e{O, ldc, 1.f}; e(acc, u, wr, wc, fr, fq); return; }
        Unit v = u; v.pm = u.pm / 17;
        EpiBf16 e{PART + (size_t)u.split * (NB * CTX) * D, D, 1.f}; e(acc, v, wr, wc, fr, fq);
    }
};
struct EpiSwigluF8 {
    unsigned char* O; int ldc;
    __device__ __forceinline__ void operator()(const f32x4 (&acc)[2][2][4][2], const Unit& u, int wr, int wc, int fr, int fq) const {
        const int row0 = u.pm * BM + wr * 64 + fr, col0 = u.pn * HALF + wc * 32 + 8 * fq; constexpr float SI = 1.f / (F8_SH * F8_SW);
#pragma unroll
        for (int ai = 0; ai < 2; ++ai)
#pragma unroll
            for (int m = 0; m < 4; ++m) { unsigned char* rowp = O + (size_t)(row0 + ai * HALF + m * 16) * ldc + col0;
                constexpr float C1 = -SI * 1.4426950408889634f, C3 = 1.f / (SI * SI * F8_SA);
                const f32x4 g0 = acc[ai][0][m][0], g1 = acc[ai][0][m][1], u0 = acc[ai][1][m][0], u1 = acc[ai][1][m][1];
                const f32x2 a = swiglu2(g0.xy, u0.xy, C1, C3), b = swiglu2(g0.zw, u0.zw, C1, C3), c = swiglu2(g1.xy, u1.xy, C1, C3), d = swiglu2(g1.zw, u1.zw, C1, C3);
                u32x2 w; w.x = pk4_fp8(a.x, a.y, b.x, b.y); w.y = pk4_fp8(c.x, c.y, d.x, d.y);
                *(u32x2*)rowp = w; }
    }
};
#ifndef GEMM_SP2
#define GEMM_SP2 1
#endif
#ifndef GEMM_ALIGN
#define GEMM_ALIGN 1
#endif
template <bool FP8, bool GATHER = false, class Epi, class Sched>
__device__ __forceinline__ void gemm_phase(LAS unsigned char* lds, const Gemm g, const Sched& S, const Epi& E) {
    const int tid = threadIdx.x, wid = __builtin_amdgcn_readfirstlane(tid >> 6), lane = tid & 63, wr = wid >> 2, wc = wid & 3, fr = lane & 15, fq = lane >> 4;
    const int KB = g.KB;
    unsigned voffA[2], voffB[2];
#pragma unroll
    for (int i = 0; i < 2; ++i) { int R, C; stage_rc(tid * 16 + i * 8192, R, C); const int Rb = (R & ~31) + perm32(R & 31);
        voffA[i] = (unsigned)(R * KB + C * 2); voffB[i] = (unsigned)(Rb * KB + C * 2); }
    const size_t kstep = (size_t)(BK * 2);
    const size_t hstep = (size_t)HALF * KB;
    const size_t tstep = 2 * hstep;
    const unsigned ldsw = (unsigned)wid * 1024u;
    const int aoff = lds_byte(wr * 64 + fr, fq * 8), boff = lds_byte(wc * 32 + fr, fq * 8);
#define PG8_SA(b, h) (((b) * 2 + (h)) * HTB)
#define PG8_SB(b, h) ((4 + (b) * 2 + (h)) * HTB)
#define PG8_STAGE(bufoff, gbase, voff) do { _Pragma("unroll") for (int _i = 0; _i < 2; ++_i) \
        __builtin_amdgcn_global_load_lds((const unsigned*)((const char*)(gbase) + (voff)[_i]), (LAS unsigned*)(lds + (bufoff) + ldsw + _i * 8192), 16, 0, 0); } while (0)
#define PG8_STG(bufoff, kp, vv) do { _Pragma("unroll") for (int _i = 0; _i < 2; ++_i) \
        __builtin_amdgcn_global_load_lds((const unsigned*)((const char*)(kp) + (vv)[_i]), (LAS unsigned*)(lds + (bufoff) + ldsw + _i * 8192), 16, 0, 0); } while (0)
#define PG8_STA_CUR(bufoff, kp, h) do { if (GATHER) PG8_STG(bufoff, kp, gA[h]); else PG8_STAGE(bufoff, (kp) + (h) * hstep, voffA); } while (0)
#define PG8_STA_NX(bufoff, kp, h) do { if (GATHER) { unsigned _v[2] = {last ? nG[h][0] : gA[h][0], last ? nG[h][1] : gA[h][1]}; PG8_STG(bufoff, kp, _v); } else PG8_STAGE(bufoff, (kp) + (h) * hstep, voffA); } while (0)
#define PG8_LDA(dst, b, h) do { _Pragma("unroll") for (int m = 0; m < 4; ++m) { const v4i _l = *(const LAS v4i*)(lds + PG8_SA(b, h) + aoff + m * 2048), _h = *(const LAS v4i*)(lds + PG8_SA(b, h) + aoff + m * 2048 + 1024); \
        dst[m] = __builtin_shufflevector(_l, _h, 0, 1, 2, 3, 4, 5, 6, 7); } } while (0)
#define PG8_LDB(dst, b, h) do { _Pragma("unroll") for (int n = 0; n < 2; ++n) { const v4i _l = *(const LAS v4i*)(lds + PG8_SB(b, h) + boff + n * 2048), _h = *(const LAS v4i*)(lds + PG8_SB(b, h) + boff + n * 2048 + 1024); \
        dst[n] = __builtin_shufflevector(_l, _h, 0, 1, 2, 3, 4, 5, 6, 7); } } while (0)
#define PG8_H(v, k) __builtin_bit_cast(bf16x8, __builtin_shufflevector(v, v, 4 * (k), 4 * (k) + 1, 4 * (k) + 2, 4 * (k) + 3))
#define PG8_MMA(ai, bj, At, Bt) do { __builtin_amdgcn_s_setprio(1); _Pragma("unroll") for (int m = 0; m < 4; ++m) _Pragma("unroll") for (int n = 0; n < 2; ++n) { \
        if (FP8) asm volatile("v_mfma_f32_16x16x128_f8f6f4 %0, %1, %2, %0" : "+v"(acc[ai][bj][m][n]) : "v"(Bt[n]), "v"(At[m])); \
        else { acc[ai][bj][m][n] = __builtin_amdgcn_mfma_f32_16x16x32_bf16(PG8_H(Bt[n], 0), PG8_H(At[m], 0), acc[ai][bj][m][n], 0, 0, 0); \
               acc[ai][bj][m][n] = __builtin_amdgcn_mfma_f32_16x16x32_bf16(PG8_H(Bt[n], 1), PG8_H(At[m], 1), acc[ai][bj][m][n], 0, 0, 0); } } \
        __builtin_amdgcn_s_setprio(0); } while (0)
#define PG8_WAIT_V(n) asm volatile("s_waitcnt vmcnt(" #n ")" ::: "memory")
#define PG8_WAIT_L(n) asm volatile("s_waitcnt lgkmcnt(" #n ")" ::: "memory")
#define PG8_BAR __builtin_amdgcn_s_barrier()
#define PG8_SCHED __builtin_amdgcn_sched_barrier(0)
    Unit cur, nxt; int ui = 0;
    if (!S.next(0, cur)) return;
    f32x4 acc[2][2][4][2];
#pragma unroll
    for (int a = 0; a < 2; ++a)
#pragma unroll
        for (int b = 0; b < 2; ++b)
#pragma unroll
            for (int m = 0; m < 4; ++m)
#pragma unroll
                for (int n = 0; n < 2; ++n) acc[a][b][m][n] = (f32x4){0.f, 0.f, 0.f, 0.f};
    v8i At[4], B0[2], B1[2];
    unsigned gA[2][2], nG[2][2]; int gR[2], gC[2];
#pragma unroll
    for (int i = 0; i < 2; ++i) { stage_rc(tid * 16 + i * 8192, gR[i], gC[i]); gC[i] *= 2; }
    LAS int* gidx = (LAS int*)(lds + 131072 + 2048);
#pragma unroll
    for (int h = 0; h < 2; ++h)
#pragma unroll
        for (int i = 0; i < 2; ++i) { gA[h][i] = GATHER ? (unsigned)(g.idx[cur.pm * 256 + h * 128 + gR[i]] * KB + gC[i]) : 0u; nG[h][i] = 0u; }
    const char* cA = (const char*)g.A + (GATHER ? (size_t)0 : (size_t)cur.pm * tstep) + (size_t)cur.kt0 * kstep; const char* cB = (const char*)g.Bt + cur.boff + (size_t)cur.pn * tstep + (size_t)cur.kt0 * kstep;
    if (GEMM_SP2) {
        PG8_STAGE(PG8_SB(0, 0), cB, voffB); PG8_STAGE(PG8_SB(0, 1), cB + hstep, voffB); PG8_STA_CUR(PG8_SA(0, 0), cA, 0); PG8_STA_CUR(PG8_SA(0, 1), cA, 1);
        if (wr == 1) PG8_BAR;
        PG8_WAIT_V(2); PG8_BAR;
        PG8_STAGE(PG8_SB(1, 0), cB + kstep, voffB); PG8_STA_CUR(PG8_SA(1, 0), cA + kstep, 0); PG8_STAGE(PG8_SB(1, 1), cB + hstep + kstep, voffB);
        PG8_WAIT_V(6); PG8_BAR;
    } else {
    PG8_STAGE(PG8_SB(0, 0), cB, voffB); PG8_STAGE(PG8_SA(0, 0), cA, voffA); PG8_STAGE(PG8_SB(0, 1), cB + hstep, voffB); PG8_STAGE(PG8_SA(0, 1), cA + hstep, voffA);
    if (wr == 1) PG8_BAR;
    PG8_WAIT_V(4); PG8_BAR;
    PG8_STAGE(PG8_SB(1, 0), cB + kstep, voffB); PG8_STAGE(PG8_SA(1, 0), cA + kstep, voffA); PG8_STAGE(PG8_SB(1, 1), cB + hstep + kstep, voffB);
    PG8_WAIT_V(6); PG8_BAR;
    }
    for (;;) {
        const bool has_next = S.next(ui + 1, nxt);
        const char* nA = has_next ? (const char*)g.A + (GATHER ? (size_t)0 : (size_t)nxt.pm * tstep) + (size_t)nxt.kt0 * kstep : cA;
        if (GATHER && has_next) __builtin_amdgcn_global_load_lds((const unsigned*)(g.idx + nxt.pm * 256 + (wid & 3) * 64 + lane), (LAS unsigned*)(gidx + (wid & 3) * 64), 4, 0, 0); const char* nB = has_next ? (const char*)g.Bt + nxt.boff + (size_t)nxt.pn * tstep + (size_t)nxt.kt0 * kstep : cB;
        const int nt = cur.nt;
        for (int t = 0; t < nt; t += 2) {
            const bool last = (t == nt - 2);
            if (GATHER && last && has_next) {
#pragma unroll
                for (int h = 0; h < 2; ++h)
#pragma unroll
                    for (int i = 0; i < 2; ++i) nG[h][i] = (unsigned)(gidx[h * 128 + gR[i]] * KB + gC[i]); }
            const char* a1 = cA + (size_t)(t + 1) * kstep;
            const char* a2 = last ? nA : cA + (size_t)(t + 2) * kstep; const char* b2 = last ? nB : cB + (size_t)(t + 2) * kstep;
            const char* a3 = a2 + kstep; const char* b3 = b2 + kstep;
            if (GEMM_SP2) {
            PG8_LDB(B0, 0, 0); PG8_LDB(B1, 0, 1); PG8_SCHED; PG8_LDA(At, 0, 0); PG8_STA_CUR(PG8_SA(1, 1), a1, 1);
            PG8_WAIT_V(8); PG8_WAIT_L(0); PG8_BAR; PG8_MMA(0, 0, At, B0); PG8_MMA(0, 1, At, B1); PG8_BAR; PG8_SCHED;
            PG8_LDA(At, 0, 1); PG8_STAGE(PG8_SB(0, 0), b2, voffB); PG8_STAGE(PG8_SB(0, 1), b2 + hstep, voffB); PG8_STA_NX(PG8_SA(0, 0), a2, 0);
            PG8_WAIT_V(8); PG8_WAIT_L(0); PG8_BAR; PG8_MMA(1, 0, At, B0); PG8_MMA(1, 1, At, B1); PG8_BAR; PG8_SCHED;
            PG8_LDB(B0, 1, 0); PG8_LDB(B1, 1, 1); PG8_SCHED; PG8_LDA(At, 1, 0); PG8_STA_NX(PG8_SA(0, 1), a2, 1);
            PG8_WAIT_V(8); PG8_WAIT_L(0); PG8_BAR; PG8_MMA(0, 0, At, B0); PG8_MMA(0, 1, At, B1); PG8_BAR; PG8_SCHED;
            PG8_LDA(At, 1, 1); PG8_STAGE(PG8_SB(1, 0), b3, voffB); PG8_STAGE(PG8_SB(1, 1), b3 + hstep, voffB); PG8_STA_NX(PG8_SA(1, 0), a3, 0);
            PG8_WAIT_V(8); PG8_WAIT_L(0); PG8_BAR; PG8_MMA(1, 0, At, B0); PG8_MMA(1, 1, At, B1); PG8_BAR; PG8_SCHED;
            } else {
            PG8_LDB(B0, 0, 0); PG8_SCHED; PG8_LDA(At, 0, 0); PG8_STAGE(PG8_SA(1, 1), a1 + hstep, voffA);
            PG8_WAIT_L(8); PG8_BAR; PG8_WAIT_L(0); PG8_MMA(0, 0, At, B0); PG8_BAR; PG8_SCHED;
            PG8_LDB(B1, 0, 1); PG8_STAGE(PG8_SB(0, 0), b2, voffB);
            PG8_BAR; PG8_WAIT_L(0); PG8_MMA(0, 1, At, B1); PG8_BAR;
            PG8_LDA(At, 0, 1); PG8_STAGE(PG8_SA(0, 0), a2, voffA);
            PG8_BAR; PG8_WAIT_L(0); PG8_MMA(1, 0, At, B0); PG8_BAR; PG8_SCHED;
            PG8_STAGE(PG8_SB(0, 1), b2 + hstep, voffB);
            PG8_WAIT_V(6); PG8_BAR; PG8_MMA(1, 1, At, B1); PG8_BAR;
            PG8_LDB(B0, 1, 0); PG8_SCHED; PG8_LDA(At, 1, 0); PG8_STAGE(PG8_SA(0, 1), a2 + hstep, voffA);
            PG8_WAIT_L(8); PG8_BAR; PG8_WAIT_L(0); PG8_MMA(0, 0, At, B0); PG8_BAR; PG8_SCHED;
            PG8_LDB(B1, 1, 1); PG8_STAGE(PG8_SB(1, 0), b3, voffB);
            PG8_BAR; PG8_WAIT_L(0); PG8_MMA(0, 1, At, B1); PG8_BAR;
            PG8_LDA(At, 1, 1); PG8_STAGE(PG8_SA(1, 0), a3, voffA);
            PG8_BAR; PG8_WAIT_L(0); PG8_MMA(1, 0, At, B0); PG8_BAR; PG8_SCHED;
            PG8_STAGE(PG8_SB(1, 1), b3 + hstep, voffB);
            PG8_WAIT_V(6); PG8_BAR; PG8_MMA(1, 1, At, B1); PG8_BAR;
            }
        }
        if (GEMM_ALIGN) { if (wr == 0) PG8_BAR; }
        if (FP8) asm volatile("s_nop 15\n\ts_nop 15" ::: "memory");
        E(acc, cur, wr, wc, fr, fq);
        if (!has_next) break;
#pragma unroll
        for (int a = 0; a < 2; ++a)
#pragma unroll
            for (int b = 0; b < 2; ++b)
#pragma unroll
                for (int m = 0; m < 4; ++m)
#pragma unroll
                    for (int n = 0; n < 2; ++n) acc[a][b][m][n] = (f32x4){0.f, 0.f, 0.f, 0.f};
        cur = nxt; cA = nA; cB = nB; ++ui;
        if (GATHER) {
#pragma unroll
            for (int h = 0; h < 2; ++h)
#pragma unroll
                for (int i = 0; i < 2; ++i) gA[h][i] = nG[h][i]; }
        if (GEMM_ALIGN) { if (wr == 1) PG8_BAR; }
    }
    PG8_WAIT_V(0);
    if (!GEMM_ALIGN) { if (wr == 0) PG8_BAR; }
    PG8_BAR;
#undef PG8_SA
#undef PG8_SB
#undef PG8_STAGE
#undef PG8_STG
#undef PG8_STA_CUR
#undef PG8_STA_NX
#undef PG8_LDA
#undef PG8_LDB
#undef PG8_MMA
#undef PG8_H
#undef PG8_WAIT_V
#undef PG8_WAIT_L
#undef PG8_BAR
#undef PG8_SCHED
}
}

template <int L> __device__ __forceinline__ void phase_attn(ArgsP a, LAS unsigned char* lds, int gw, int ngw, int wave, int lane) {
    const bf16_t* QKV = (const bf16_t*)(a->ws + WS_QKV); bf16_t* ATT = (bf16_t*)(a->ws + WS_ATT);
    const float lambda_init = L == 0 ? 0.2f : 0.8f - 0.6f * 0.74081822068171786607f;
    {
      const float L2T = 13.287712379549449f; LAS f32x2* tg = (LAS f32x2*)(lds + 73728); LAS f32x2* td = tg + 64 * 32;
      for (int i = threadIdx.x; i < 64 * 32 + 64 * 16; i += NTHREADS) { float s_, c_;
        if (i < 64 * 32) { sincosf((float)(i >> 5) * exp2f(-(float)(i & 31) * (1.f / 32.f) * L2T), &s_, &c_); tg[i] = (f32x2){c_, s_}; }
        else { const int q_ = i - 64 * 32; sincosf((float)(q_ >> 4) * exp2f(-(float)(q_ & 15) * (1.f / 16.f) * L2T), &s_, &c_); td[q_] = (f32x2){c_, s_}; } }
      __syncthreads(); }
    {
    constexpr int REP2 = ((PROBE_DUP >> 2) & 1) + 1, NUQ = 512 + (L == 0 ? 48 : 0);
    for (int uu = blockIdx.x; uu < NUQ * REP2; uu += gridDim.x) { const int u = REP2 == 1 ? uu : uu % NUQ;
        int seq; size_t qrow, krow; int qcol, kcol, vcol, ocol, qproc = 0, trow0 = 0;
        if (u < 512) { const int grp = u & 7, idx = u >> 3, b = grp >> 1, hq = (grp & 1) * 4 + (idx & 3), kvh = hq >> 2; seq = TPB; qrow = (size_t)b * TPB + (idx >> 2) * 256; krow = (size_t)b * TPB; qproc = 2; trow0 = (idx >> 2) * 256;
            qcol = 1536 + hq * 128; kcol = 2560 + kvh * 128; vcol = 2816 + kvh * 128; ocol = 512 + hq * 128; }
        else if (u < 544) { const int v = u - 512, b = v >> 3, hq = v & 7, kvh = hq >> 2; seq = CTX; qrow = (size_t)b * TPB + SEQ; krow = qrow; qproc = 1;
            qcol = 1536 + hq * 128; kcol = 2560 + kvh * 128; vcol = 2816 + kvh * 128; ocol = 512 + hq * 128; }
        else { const int v = u - 544, b = v >> 2, h = v & 3; seq = CTX; qrow = (size_t)b * TPB + SEQ; krow = qrow; qcol = h * 128; kcol = 512 + h * 128; vcol = 1024 + h * 128; ocol = h * 128; }
        att::attn_body<0>(QKV + qrow * INW + qcol, QKV + krow * INW + kcol, QKV + krow * INW + vcol, ATT + qrow * D + ocol, seq, lds, 0.f, 0.f, nullptr, 0, 0, qproc, a->in[I_QNORM] + L * 128, trow0);
    }
    float lam;
    { const int ln = threadIdx.x & 63; const float d1 = wave_sum(a->in[I_LQ1][L * 64 + ln] * a->in[I_LK1][L * 64 + ln]), d2 = wave_sum(a->in[I_LQ2][L * 64 + ln] * a->in[I_LK2][L * 64 + ln]); lam = __expf(d1) - __expf(d2) + lambda_init; lam = __int_as_float(__builtin_amdgcn_readfirstlane(__float_as_int(lam))); }
    constexpr int NUD = 512 + (L == 0 ? 64 : 0);
    for (int uu = blockIdx.x; uu < NUD * REP2; uu += gridDim.x) { const int u = REP2 == 1 ? uu : uu % NUD;
        int seq; size_t qrow, krow; int h, qproc = 0, trow0 = 0;
        if (u < 512) { const int idx = u >> 3, grp = (u & 7) + 8 * (idx >> 5), b = grp >> 2; h = grp & 3; seq = TPB; qrow = (size_t)b * TPB + (idx & 31) * 128; krow = (size_t)b * TPB; qproc = 2; trow0 = (idx & 31) * 128; }
        else { const int v = u - 544; if (v < 0) continue; const int b = v >> 3; h = (v >> 1) & 3; seq = CTX; krow = (size_t)b * TPB + SEQ; qrow = krow + (v & 1) * 128; }
        att::attn_body<1>(QKV + qrow * INW + 3072 + h * 128, QKV + krow * INW + 3584 + h * 128, QKV + krow * INW + 4096 + h * 128, ATT + qrow * D + 1536 + h * 128, seq, lds, lam, 1.f - lambda_init, a->in[I_SUBLN] + L * 128, 0, 0, qproc, nullptr, trow0);
    }
    constexpr int REP3 = ((PROBE_DUP >> 3) & 1) + 1;
    for (int uu = blockIdx.x; uu < 256 * REP3; uu += gridDim.x) { const int u = uu & 255;
        const int grp = u & 15, b = grp >> 2, h = grp & 3, r0 = (u >> 4) * 4, R0 = min(max(r0 - 4, 0), 52);
        const size_t qrow = (size_t)b * TPB + r0 * 64, krow = (size_t)b * TPB;
        att::attn_body<2>(QKV + qrow * INW + h * 128, QKV + krow * INW + 512 + h * 128, QKV + krow * INW + 1024 + h * 128, ATT + qrow * D + h * 128, 1024, lds, 0.f, 0.f, a->in[I_RPB] + (size_t)(L * 4 + h) * 465, r0, R0);
    }
    }
    __syncthreads();
}

template <int L> __device__ __forceinline__ void layer_program(LAS unsigned char* lds, const XcdBarrier& bar, int lo, int hi) {
    constexpr int P = 2 + 9 * L; const int G = gridDim.x, cid = blockIdx.x;
#define PHASE_IDS const int tid = fresh_tid(), lane = tid & 63, wave = __builtin_amdgcn_readfirstlane(tid >> 6), gw = blockIdx.x * NWAVES + wave, ngw = gridDim.x * NWAVES; (void)lane; (void)gw; (void)ngw
#define IN(k) (lo <= (k) && (k) < hi)
#define SEAM(k) do { if (IN(k) && IN((k) + 1)) xcd_barrier(bar); STAMP((k) + 1); } while (0)
    if (IN(P + 0)) DUP(1) { ArgsP a = get_args(); unsigned char* ws = a->ws;
        pg8::Gemm g{ws + WS_H, (const bf16_t*)(ws + WS_WIN) + (size_t)L * INW * D, 2 * D}; pg8::StaticOrder<false> S; S.init(NR / 256, INW / 256, G, cid, D / 64);
        pg8::EpiBf16 E{(bf16_t*)(ws + WS_QKV), INW, 1.f}; pg8::gemm_phase<false>(lds, g, S, E); }
    SEAM(P + 0);
    if (IN(P + 1)) { ArgsP a = get_args(); PHASE_IDS; phase_qkpost<L>(a, lds, gw, ngw, tid, lane); }
    SEAM(P + 1);
    if (IN(P + 2)) { ArgsP a = get_args(); PHASE_IDS; phase_attn<L>(a, lds, gw, ngw, wave, lane); }
    SEAM(P + 2);
    if (IN(P + 3)) DUP(4) { ArgsP a = get_args(); unsigned char* ws = a->ws;
        pg8::Gemm g{ws + WS_ATT, (const bf16_t*)(ws + WS_WOUT) + (size_t)L * D * D, 2 * D};
        if (L == 0) { pg8::EpiBf16OrPart E{(bf16_t*)(ws + WS_O), D, (bf16_t*)(ws + WS_PART_A)}; pg8::SplitCtxOrder S; S.init(G, cid, D / 64); pg8::gemm_phase<false>(lds, g, S, E); }
        else { pg8::EpiBf16 E{(bf16_t*)(ws + WS_O), D, 1.f}; pg8::StaticOrder<true> S; S.init(NTOK / 256, D / 256, G, cid, D / 64); pg8::gemm_phase<false>(lds, g, S, E); } }
    SEAM(P + 3);
    if (IN(P + 4)) { ArgsP a = get_args(); PHASE_IDS; phase_row_mid<L>(a, lds, gw, ngw, tid, lane); }
    SEAM(P + 4);
    if (IN(P + 5)) { if (L == 1) { ArgsP a = get_args(); PHASE_IDS; phase_moe_slots(a, lds, gw, ngw, tid, lane); } }
    if (L == 1) SEAM(P + 5); else STAMP(P + 6);
    if (IN(P + 6)) DUP(5) { ArgsP a = get_args(); unsigned char* ws = a->ws;
        if (L == 0 && FP8_UP0) { pg8::EpiSwigluT<true> E{(bf16_t*)(ws + WS_ACT), DFF}; pg8::Gemm g{ws + WS_H8, ws + WS_W13, D}; pg8::StaticOrder<false> S; S.init(NR / 256, 2 * DFF / 256, G, cid, D / 128); pg8::gemm_phase<true>(lds, g, S, E); }
        else if (L == 0) { pg8::EpiSwiglu E{(bf16_t*)(ws + WS_ACT), DFF}; pg8::Gemm g{ws + WS_H, ws + WS_W13, 2 * D}; pg8::StaticOrder<false> S; S.init(NR / 256, 2 * DFF / 256, G, cid, D / 64); pg8::gemm_phase<false>(lds, g, S, E); }
        else { LAS int* toff = moe_offsets(a, lds, fresh_tid()); pg8::EpiSwigluF8 E{ws + WS_ACT, DFF}; pg8::Gemm g{ws + WS_H8, ws + WS_MW13, D, (const int*)(ws + WS_IDX)}; pg8::MoeOrder S; S.init(toff, 2 * DFF / 256, G, cid, (size_t)2 * DFF * D, D / 128); pg8::gemm_phase<true, true>(lds, g, S, E); }
    }
    SEAM(P + 6);
    if (IN(P + 7)) DUP(6) { ArgsP a = get_args(); unsigned char* ws = a->ws;
        if (L == 0) { pg8::EpiBf16OrPart E{(bf16_t*)(ws + WS_Y), D, (bf16_t*)(ws + WS_PART_B)}; pg8::Gemm g{ws + WS_ACT, ws + WS_W2, 2 * DFF}; pg8::SplitCtxOrder S; S.init(G, cid, DFF / 64); pg8::gemm_phase<false>(lds, g, S, E); }
        else { LAS int* toff = moe_offsets(a, lds, fresh_tid()); pg8::EpiBf16T<true> E{(bf16_t*)(ws + WS_Y), D, 1.f / (F8_SA * F8_SW)}; pg8::Gemm g{ws + WS_ACT, ws + WS_MW2, DFF}; pg8::MoeOrder S; S.init(toff, D / 256, G, cid, (size_t)D * DFF, DFF / 128); pg8::gemm_phase<true>(lds, g, S, E); }
    }
    SEAM(P + 7);
    if (IN(P + 8)) { ArgsP a = get_args(); PHASE_IDS; phase_row_end<L>(a, gw, ngw, lane); }
    if (L == 0) SEAM(P + 8);
#undef IN
#undef SEAM
}
constexpr int NPHASE = 20;


__global__ void __launch_bounds__(NTHREADS, 2) fwd_kernel(Args kargs_unused) {
    extern __shared__ __attribute__((aligned(16))) unsigned char lds_raw[];
    LAS unsigned char* lds = (LAS unsigned char*)lds_raw;
    volatile LAS unsigned* xbw = (volatile LAS unsigned*)(lds + LDS_BYTES - 16);
    { const int t0 = fresh_tid(); if (t0 < 4) xbw[t0] = 0u; }
    __syncthreads();
    STAMP(0); const unsigned long long probe_c0 = PROBE_STAMP == 100 ? (unsigned long long)clock64() : 0ull;
    int lo, hi; XcdBarrier bar;
    { ArgsP a = get_args(); lo = a->lo; hi = a->hi; bar.bar = (unsigned*)(a->ws + WS_CTL) + CW_BAR; bar.x = 0; bar.st = xbw;
      if (hi - lo > 1) bar = xcd_barrier_post((unsigned*)(a->ws + WS_CTL) + CW_BAR, xbw); }
#define IN(k) (lo <= (k) && (k) < hi)
    { const int tid = fresh_tid(), lane = tid & 63, wave = __builtin_amdgcn_readfirstlane(tid >> 6), gw = blockIdx.x * NWAVES + wave, ngw = gridDim.x * NWAVES;
      if (IN(0)) DUP(0) { ArgsP a = get_args(); phase_adaln(a, lds, tid, wave, lane); phase_convert(a, lds, gw, ngw, wave, lane); __syncthreads(); }
      if (IN(0) && IN(1)) xcd_barrier(bar);
      STAMP(1);
      if (IN(1)) { ArgsP a = get_args(); phase_row_entry(a, gw, ngw, lane); }
      if (IN(1) && IN(2)) xcd_barrier(bar);
      STAMP(2); }
#undef IN
    layer_program<0>(lds, bar, lo, hi);
    layer_program<1>(lds, bar, lo, hi);
    if (PROBE_STAMP >= 0 && blockIdx.x == 0 && threadIdx.x == 0) {
        STAMP(NPHASE);
        volatile LAS unsigned long long* st = (volatile LAS unsigned long long*)(lds + 131072 + 1024);
        const unsigned long long d = PROBE_STAMP == 100 ? ((unsigned long long)clock64() - probe_c0) / 20ull : (PROBE_STAMP >= 200 ? (st[32 + PROBE_STAMP - 200 + 1] - st[32 + PROBE_STAMP - 200]) / 20ull : st[PROBE_STAMP + 1] - st[PROBE_STAMP]);
        const unsigned long long t0 = (unsigned long long)wall_clock64();
        while ((unsigned long long)wall_clock64() - t0 < d) __builtin_amdgcn_s_sleep(10);
    }
}

#ifndef MK_PER_PHASE
#define MK_PER_PHASE 0
#endif
extern "C" void kernel_launch(void* const* d_in, const int* in_sizes, int n_in, void* d_out, int out_size, void* d_ws, size_t ws_size, hipStream_t stream) {
    static int grid = 0;
    if (grid == 0) {
        if (n_in != 27 || out_size != NB * SEQ * D || ws_size < WS_H8 + (size_t)NR * D) { fprintf(stderr, "kernel_launch: unexpected shapes: n_in %d out %d ws %zu (need %zu)\n", n_in, out_size, ws_size, (size_t)WS_END); grid = -1; return; }
        int dev = 0, cus = 0, per_cu = 0;
        if (hipGetDevice(&dev) != hipSuccess || hipDeviceGetAttribute(&cus, hipDeviceAttributeMultiprocessorCount, dev) != hipSuccess) { grid = -1; return; }
        if (hipFuncSetAttribute((const void*)fwd_kernel, hipFuncAttributeMaxDynamicSharedMemorySize, LDS_BYTES) != hipSuccess) { fprintf(stderr, "kernel_launch: hipFuncSetAttribute failed\n"); grid = -1; return; }
        if (hipOccupancyMaxActiveBlocksPerMultiprocessor(&per_cu, (const void*)fwd_kernel, NTHREADS, LDS_BYTES) != hipSuccess || per_cu < 1) fprintf(stderr, "kernel_launch: occupancy query says %d\n", per_cu);
        (void)hipGetLastError();
        grid = cus;
    }
    if (grid < 0) return;
    (void)hipMemsetAsync((char*)d_ws + WS_CTL, 0, CTL_ZERO_BYTES, stream);
    Args a{};
    for (int i = 0; i < 27; ++i) a.in[i] = (const float*)d_in[i];
    a.out = (float*)d_out; a.ws = (unsigned char*)d_ws;
#if MK_PER_PHASE
    for (int p = 0; p < NPHASE; ++p) { if (p == 7) continue; a.lo = p; a.hi = p + 1; hipLaunchKernelGGL(fwd_kernel, dim3(grid), dim3(NTHREADS), LDS_BYTES, stream, a); }
#else
    a.lo = 0; a.hi = NPHASE; hipLaunchKernelGGL(fwd_kernel, dim3(grid), dim3(NTHREADS), LDS_BYTES, stream, a);
#endif
}
```

```cpp
#include <hip/hip_runtime.h>
#include <stdint.h>
#include <stdio.h>

#define GAS __attribute__((address_space(1)))
#define LAS __attribute__((address_space(3)))
typedef unsigned short bf16_t;
typedef short bf16x8 __attribute__((ext_vector_type(8)));
typedef float f32x4 __attribute__((ext_vector_type(4)));
typedef float f32x2 __attribute__((ext_vector_type(2)));
typedef unsigned u32x4 __attribute__((ext_vector_type(4)));
typedef unsigned u32x2 __attribute__((ext_vector_type(2)));

#ifndef PROBE_DUP
#define PROBE_DUP 0
#endif
#define DUP(bit) for (int _rep = 0; _rep < (((PROBE_DUP) >> (bit)) & 1) + 1; ++_rep)
#ifndef PROBE_STAMP
#define PROBE_STAMP -1
#endif
#define STAMP(i) do { if (PROBE_STAMP >= 0 && blockIdx.x == 0 && threadIdx.x == 0) { ((volatile LAS unsigned long long*)(lds + 131072 + 1024))[i] = (unsigned long long)wall_clock64(); ((volatile LAS unsigned long long*)(lds + 131072 + 1024))[32 + (i)] = (unsigned long long)clock64(); } } while (0)
constexpr int D = 2048, NB = 4, SEQ = 4096, CTX = 256, TPB = SEQ + CTX, NR = NB * TPB;
constexpr int INW = 4608, DFF = 5632, NE = 8, MODW = 6 * D, NTOK = NB * SEQ;
constexpr int MAXSLOT = 34816;
constexpr float EPS = 1e-6f;
constexpr int NWAVES = 8, NTHREADS = 512;
constexpr int LDS_BYTES = 147456;

constexpr size_t MiB = 1u << 20;
constexpr size_t WS_CTL = 0, CTL_ZERO_BYTES = 128 * 1024;
constexpr size_t WS_MOD = 1 * MiB;
constexpr size_t WS_TOPK = 2 * MiB;
constexpr size_t WS_SLOT = WS_TOPK + 512 * 1024;
constexpr size_t WS_IDX = 3 * MiB;
constexpr size_t WS_WIN = 4 * MiB;
constexpr size_t WS_WOUT = 40 * MiB;
constexpr size_t WS_W13 = 56 * MiB;
constexpr size_t WS_W2 = 100 * MiB;
constexpr size_t WS_MW13 = 122 * MiB;
constexpr size_t WS_MW2 = 474 * MiB;
constexpr size_t WS_X = 650 * MiB;
constexpr size_t WS_H = 786 * MiB;
constexpr size_t WS_Y = 854 * MiB;
constexpr size_t WS_HG = WS_Y;
constexpr size_t WS_R1 = 990 * MiB;
constexpr size_t WS_QKV = WS_R1, WS_VT = WS_R1 + 153 * MiB, WS_ATT = WS_R1 + 170 * MiB, WS_O = WS_R1 + 238 * MiB, WS_ACT = WS_R1;
constexpr size_t WS_END = WS_R1 + (size_t)MAXSLOT * DFF * 2;
constexpr size_t WS_H8 = WS_END;
constexpr size_t WS_PART_A = WS_QKV;
constexpr size_t WS_PART_M = WS_R1 + 256 * MiB;
constexpr size_t WS_PART_B = WS_Y + 68 * MiB;
static_assert((size_t)NR * INW * 2 <= 153 * MiB && (size_t)16 * 128 * TPB * 2 <= 17 * MiB && (size_t)NR * D * 2 <= 68 * MiB, "R1 map");
constexpr int CW_BAR = 4096;
constexpr int CW_CNT = 16384;
constexpr int CW_CUR = 16384 + 64;

__device__ __forceinline__ unsigned cvt_pk_bf16(float lo, float hi) { unsigned r; asm("v_cvt_pk_bf16_f32 %0, %1, %2" : "=v"(r) : "v"(lo), "v"(hi)); return r; }
__device__ __forceinline__ float bf_lo(unsigned w) { return __uint_as_float(w << 16); }
__device__ __forceinline__ float bf_hi(unsigned w) { return __uint_as_float(w & 0xffff0000u); }
__device__ __forceinline__ float bf2f(bf16_t b) { return __uint_as_float(((unsigned)b) << 16); }
__device__ __forceinline__ bf16_t f2bf(float f) { return (bf16_t)(cvt_pk_bf16(f, 0.f) & 0xffffu); }
__device__ __forceinline__ float wave_sum(float v) {
#pragma unroll
    for (int o = 1; o < 64; o <<= 1) v += __shfl_xor(v, o);
    return v;
}
__device__ __forceinline__ float wave_max(float v) {
#pragma unroll
    for (int o = 1; o < 64; o <<= 1) v = fmaxf(v, __shfl_xor(v, o));
    return v;
}
#define LDS_WAIT() asm volatile("s_waitcnt lgkmcnt(0)" ::: "memory")
__device__ __forceinline__ unsigned pk4_fp8(float a, float b, float c, float d) {
    a = fminf(fmaxf(a, -448.f), 448.f); b = fminf(fmaxf(b, -448.f), 448.f); c = fminf(fmaxf(c, -448.f), 448.f); d = fminf(fmaxf(d, -448.f), 448.f);
    int w = 0; w = __builtin_amdgcn_cvt_pk_fp8_f32(a, b, w, false); w = __builtin_amdgcn_cvt_pk_fp8_f32(c, d, w, true); return (unsigned)w; }
#ifndef FP8_UP0
#define FP8_UP0 1
#endif
constexpr float F8_SW = 64.f, F8_SH = 16.f, F8_SA = 8.f;

#define XB_TMO      128
#define XB_XCNT(j)  (256  + 64 * (j))
#define XB_XSUB(j)  (1280 + 64 * (j))
#define XB_XGEN(j)  (2304 + 64 * (j))
#define XB_TOP      3328
#define XB_TOPGEN   3392
#define XCD_BAR_WORDS 3456
#define XB_SPIN_CAP (1u << 18)
__device__ __forceinline__ unsigned xb_ld(unsigned* p)              { return __hip_atomic_load(p, __ATOMIC_RELAXED, __HIP_MEMORY_SCOPE_AGENT); }
__device__ __forceinline__ unsigned xb_add(unsigned* p, unsigned v) { return __hip_atomic_fetch_add(p, v, __ATOMIC_RELAXED, __HIP_MEMORY_SCOPE_AGENT); }
__device__ __forceinline__ unsigned xb_xcc_id() { return (unsigned)__builtin_amdgcn_s_getreg((3 << 11) | 20) & 0xFu; }
#define XB_SPIN(cond, bar) do { unsigned _sp = 0; while (cond) { __builtin_amdgcn_s_sleep(1); \
    if ((++_sp & 255u) == 0u) { if (xb_ld(&(bar)[XB_TMO])) break; if (_sp > XB_SPIN_CAP) { atomicAdd(&(bar)[XB_TMO], 1u); break; } } } } while (0)
struct XcdBarrier { unsigned* bar; unsigned x; volatile LAS unsigned* st; };
__device__ __forceinline__ XcdBarrier xcd_barrier_post(unsigned* bar, volatile LAS unsigned* st) {
    XcdBarrier b; b.bar = bar; b.x = xb_xcc_id(); b.st = st;
    if (threadIdx.x == 0) (void)xb_add(&bar[XB_XCNT(b.x)], 1u);
    return b;
}
__device__ __forceinline__ void xcd_barrier_complete(unsigned* bar, unsigned x, unsigned& nloc, unsigned& nx) {
    const unsigned G = gridDim.x * gridDim.y * gridDim.z;
    unsigned sum, cnt, mine, sp = 0u;
    for (;;) {
        sum = 0u; cnt = 0u; mine = 0u;
#pragma unroll
        for (unsigned j = 0; j < 16; ++j) { const unsigned c = xb_ld(&bar[XB_XCNT(j)]); sum += c; cnt += (c > 0u) ? 1u : 0u; mine = (j == x) ? c : mine; }
        if (sum == G) break;
        __builtin_amdgcn_s_sleep(1);
        if ((++sp & 255u) == 0u) { if (xb_ld(&bar[XB_TMO])) break; if (sp > XB_SPIN_CAP) { atomicAdd(&bar[XB_TMO], 1u); break; } }
    }
    nloc = mine > 0u ? mine : 1u; nx = cnt > 0u ? cnt : 1u;
}
__device__ __forceinline__ void xcd_barrier(const XcdBarrier& b) {
    asm volatile("s_waitcnt vmcnt(0)" ::: "memory");
    __syncthreads();
    if (threadIdx.x == 0) {
        unsigned* bar = b.bar;
        __builtin_amdgcn_s_waitcnt(0);
        unsigned nloc = b.st[0], nx = b.st[1];
        if (nloc == 0u) { xcd_barrier_complete(bar, b.x, nloc, nx); b.st[0] = nloc; b.st[1] = nx; }
        const unsigned old = xb_add(&bar[XB_XSUB(b.x)], 1u);
        const unsigned gen = old / nloc;
        if (old + 1u == (gen + 1u) * nloc) {
            __builtin_amdgcn_fence(__ATOMIC_RELEASE, "agent");
            asm volatile("s_waitcnt vmcnt(0)" ::: "memory");
            const unsigned og = xb_add(&bar[XB_TOP], 1u);
            const unsigned tg = og / nx;
            if (og + 1u == (tg + 1u) * nx) xb_add(&bar[XB_TOPGEN], 1u);
            else XB_SPIN(xb_ld(&bar[XB_TOPGEN]) == tg, bar);
            __builtin_amdgcn_fence(__ATOMIC_ACQUIRE, "agent");
            xb_add(&bar[XB_XGEN(b.x)], 1u);
            asm volatile("s_waitcnt vmcnt(0)" ::: "memory");
        } else {
            XB_SPIN(xb_ld(&bar[XB_XGEN(b.x)]) == gen, bar);
            __builtin_amdgcn_fence(__ATOMIC_ACQUIRE, "agent");
            asm volatile("s_waitcnt vmcnt(0)" ::: "memory");
        }
    }
    __syncthreads();
}

struct Args { const float* in[27]; float* out; unsigned char* ws; int lo, hi; };
typedef const __attribute__((address_space(4))) Args* ArgsP;
__device__ __forceinline__ int fresh_tid() { int t = threadIdx.x; asm volatile("" : "+v"(t)); return t; }
__device__ __forceinline__ ArgsP get_args() { ArgsP p = (ArgsP)__builtin_amdgcn_kernarg_segment_ptr(); asm volatile("" : "+s"(p)); return p; }
enum { I_X = 0, I_C, I_CTX, I_CCTX, I_WMOD, I_BMOD, I_GMIXPRE, I_GMIXPOST, I_GFFNPRE, I_GFFNPOST, I_WIN, I_WOUT, I_RPB, I_QNORM, I_KNORM,
       I_LQ1, I_LK1, I_LQ2, I_LK2, I_SUBLN, I_FW1, I_FW3, I_FW2, I_ROUTER, I_MW1, I_MW3, I_MW2 };

__device__ __forceinline__ void transpose_item(const float* W, int K, int N, bf16_t* WT, int item, int mode, LAS float* scr, int lane) {
    const int nblk = N / 32, kb = item / nblk, nb = item % nblk, k0 = 64 * kb, n0 = 32 * nb;
#pragma unroll 8
    for (int i = 0; i < 32; ++i) { const int kk = 2 * i + (lane >> 5); scr[kk * 33 + (lane & 31)] = W[(size_t)(k0 + kk) * N + n0 + (lane & 31)]; }
    LDS_WAIT(); asm volatile("" ::: "memory");
    const int c = lane & 7;
    const int drow0 = mode == 0 ? n0 : (256 * (n0 >> 7) + (n0 & 127) + (mode == 2 ? 128 : 0));
#pragma unroll
    for (int j = 0; j < 4; ++j) { const int n = (lane >> 3) + 8 * j; const LAS float* s = scr + (8 * c) * 33 + n;
        u32x4 o; o.x = cvt_pk_bf16(s[0 * 33], s[1 * 33]); o.y = cvt_pk_bf16(s[2 * 33], s[3 * 33]); o.z = cvt_pk_bf16(s[4 * 33], s[5 * 33]); o.w = cvt_pk_bf16(s[6 * 33], s[7 * 33]);
        *(u32x4*)(WT + (size_t)(drow0 + n) * K + k0 + 8 * c) = o; }
    LDS_WAIT(); asm volatile("" ::: "memory");
}
__device__ __forceinline__ void transpose_item_f8(const float* W, int K, int N, unsigned char* WT, int item, int mode, LAS float* scr, int lane) {
    const int nblk = N / 32, kb = item / nblk, nb = item % nblk, k0 = 64 * kb, n0 = 32 * nb;
#pragma unroll 8
    for (int i = 0; i < 32; ++i) { const int kk = 2 * i + (lane >> 5); scr[kk * 33 + (lane & 31)] = W[(size_t)(k0 + kk) * N + n0 + (lane & 31)]; }
    LDS_WAIT(); asm volatile("" ::: "memory");
    const int c = lane & 7;
    const int drow0 = mode == 0 ? n0 : (256 * (n0 >> 7) + (n0 & 127) + (mode == 2 ? 128 : 0));
#pragma unroll
    for (int j = 0; j < 4; ++j) { const int n = (lane >> 3) + 8 * j; const LAS float* s = scr + (8 * c) * 33 + n;
        u32x2 o; o.x = pk4_fp8(s[0 * 33] * F8_SW, s[1 * 33] * F8_SW, s[2 * 33] * F8_SW, s[3 * 33] * F8_SW); o.y = pk4_fp8(s[4 * 33] * F8_SW, s[5 * 33] * F8_SW, s[6 * 33] * F8_SW, s[7 * 33] * F8_SW);
        *(u32x2*)(WT + (size_t)(drow0 + n) * K + k0 + 8 * c) = o; }
    LDS_WAIT(); asm volatile("" ::: "memory");
}
struct CvtItem { const float* src; unsigned char* dst; int N, K, f8; };
__device__ __forceinline__ CvtItem cvt_decode(ArgsP a, int it, int lane) {
    unsigned char* ws = a->ws;
    constexpr int I_IN = 32 * 144, I_OUT = 32 * 64, I_F = 5632;
    const float* W; unsigned char* WT; int K, N, mode, f8 = 0, q;
    int r = it;
    if (r < 2 * I_IN) { const int l = r / I_IN; W = a->in[I_WIN] + (size_t)l * D * INW; K = D; N = INW; WT = ws + WS_WIN + (size_t)l * INW * D * 2; mode = 0; q = r % I_IN; }
    else if (r < 2 * I_IN + 2 * I_OUT) { r -= 2 * I_IN; const int l = r / I_OUT; W = a->in[I_WOUT] + (size_t)l * D * D; K = D; N = D; WT = ws + WS_WOUT + (size_t)l * D * D * 2; mode = 0; q = r % I_OUT; }
    else { r -= 2 * I_IN + 2 * I_OUT; const int m = r / I_F; q = r % I_F;
        if (m == 0) { W = a->in[I_FW1]; K = D; N = DFF; WT = ws + WS_W13; mode = 1; f8 = FP8_UP0; }
        else if (m == 1) { W = a->in[I_FW3]; K = D; N = DFF; WT = ws + WS_W13; mode = 2; f8 = FP8_UP0; }
        else if (m == 2) { W = a->in[I_FW2]; K = DFF; N = D; WT = ws + WS_W2; mode = 0; }
        else if (m < 11) { const int e = m - 3; W = a->in[I_MW1] + (size_t)e * D * DFF; K = D; N = DFF; WT = ws + WS_MW13 + (size_t)e * 2 * DFF * D; mode = 1; f8 = 1; }
        else if (m < 19) { const int e = m - 11; W = a->in[I_MW3] + (size_t)e * D * DFF; K = D; N = DFF; WT = ws + WS_MW13 + (size_t)e * 2 * DFF * D; mode = 2; f8 = 1; }
        else { const int e = m - 19; W = a->in[I_MW2] + (size_t)e * DFF * D; K = DFF; N = D; WT = ws + WS_MW2 + (size_t)e * D * DFF; mode = 0; f8 = 1; } }
    const int nblk = N / 32, kb = q / nblk, nb = q % nblk, k0 = 64 * kb, n0 = 32 * nb;
    const int drow0 = mode == 0 ? n0 : (256 * (n0 >> 7) + (n0 & 127) + (mode == 2 ? 128 : 0));
    CvtItem c; c.src = W + (size_t)k0 * N + n0; c.N = N; c.K = K; c.f8 = f8; c.dst = WT + ((size_t)drow0 * K + k0) * (f8 ? 1 : 2); return c;
}
__device__ __forceinline__ void cvt_load(const CvtItem& c, int lane, float (&v)[32]) {
    const float* p = c.src + (size_t)(lane >> 5) * c.N + (lane & 31);
#pragma unroll
    for (int i = 0; i < 32; ++i) v[i] = p[(size_t)(2 * i) * c.N];
}
__device__ __forceinline__ void cvt_store(const CvtItem& c, int lane, const float (&v)[32], LAS float* scr) {
#pragma unroll
    for (int i = 0; i < 32; ++i) scr[(2 * i + (lane >> 5)) * 33 + (lane & 31)] = v[i];
    LDS_WAIT(); asm volatile("" ::: "memory");
    const int cc = lane & 7;
#pragma unroll
    for (int j = 0; j < 4; ++j) { const int n = (lane >> 3) + 8 * j; const LAS float* s = scr + (8 * cc) * 33 + n;
        if (c.f8) { u32x2 o; o.x = pk4_fp8(s[0 * 33] * F8_SW, s[1 * 33] * F8_SW, s[2 * 33] * F8_SW, s[3 * 33] * F8_SW); o.y = pk4_fp8(s[4 * 33] * F8_SW, s[5 * 33] * F8_SW, s[6 * 33] * F8_SW, s[7 * 33] * F8_SW);
            *(u32x2*)(c.dst + (size_t)n * c.K + 8 * cc) = o; }
        else { u32x4 o; o.x = cvt_pk_bf16(s[0 * 33], s[1 * 33]); o.y = cvt_pk_bf16(s[2 * 33], s[3 * 33]); o.z = cvt_pk_bf16(s[4 * 33], s[5 * 33]); o.w = cvt_pk_bf16(s[6 * 33], s[7 * 33]);
            *(u32x4*)(c.dst + ((size_t)n * c.K + 8 * cc) * 2) = o; } }
    LDS_WAIT(); asm volatile("" ::: "memory");
}
__device__ __forceinline__ void phase_convert(ArgsP a, LAS unsigned char* lds, int gw, int ngw, int wave, int lane) {
    LAS float* scr = (LAS float*)(lds + wave * 16384);
    constexpr int NITEMS = 2 * 32 * 144 + 2 * 32 * 64 + 27 * 5632;
    int it = gw; if (it >= NITEMS) return;
    CvtItem cur = cvt_decode(a, it, lane); float va[32], vb[32];
    cvt_load(cur, lane, va);
    for (;;) {
        const int n1 = it + ngw; const bool h1 = n1 < NITEMS; CvtItem nx = cur;
        if (h1) { nx = cvt_decode(a, n1, lane); cvt_load(nx, lane, vb); }
        cvt_store(cur, lane, va, scr);
        if (!h1) break;
        const int n2 = n1 + ngw; const bool h2 = n2 < NITEMS;
        if (h2) { cur = cvt_decode(a, n2, lane); cvt_load(cur, lane, va); }
        cvt_store(nx, lane, vb, scr);
        if (!h2) break;
        it = n2;
    }
}
__device__ __forceinline__ void phase_adaln(ArgsP a, LAS unsigned char* lds, int tid, int wave, int lane) {
    LAS float* sc = (LAS float*)lds;
    LAS float* red = (LAS float*)(lds + 5 * 2048 * 4);
    float* MOD = (float*)(a->ws + WS_MOD);
    for (int task = blockIdx.x; task < 192; task += gridDim.x) {
        const int l = task / 96, j0 = (task % 96) * 128;
        for (int i = tid; i < 5 * 2048; i += NTHREADS) { const int v = i >> 11, k = i & 2047; const float c = v < 4 ? a->in[I_C][v * D + k] : a->in[I_CCTX][k]; sc[i] = c / (1.f + __expf(-c)); }
        __syncthreads();
        float acc[5][2];
#pragma unroll
        for (int v = 0; v < 5; ++v) { acc[v][0] = 0.f; acc[v][1] = 0.f; }
        const float* wp = a->in[I_WMOD] + ((size_t)l * D + wave * 256) * MODW + j0 + 2 * lane;
        for (int k = 0; k < 256; ++k) { const f32x2 w = *(const f32x2*)(wp + (size_t)k * MODW);
#pragma unroll
            for (int v = 0; v < 5; ++v) { const float s = sc[v * 2048 + wave * 256 + k]; acc[v][0] += s * w.x; acc[v][1] += s * w.y; } }
#pragma unroll
        for (int v = 0; v < 5; ++v) { red[(wave * 5 + v) * 128 + 2 * lane] = acc[v][0]; red[(wave * 5 + v) * 128 + 2 * lane + 1] = acc[v][1]; }
        __syncthreads();
        for (int i = tid; i < 640; i += NTHREADS) { const int v = i >> 7, j = i & 127; float s = a->in[I_BMOD][l * MODW + j0 + j];
#pragma unroll
            for (int w = 0; w < 8; ++w) s += red[(w * 5 + v) * 128 + j];
            MOD[(size_t)(l * 5 + v) * MODW + j0 + j] = s; }
        __syncthreads();
    }
}

__device__ __forceinline__ void ld_row_f32(const float* p, int lane, f32x4 (&v)[8]) {
#pragma unroll
    for (int j = 0; j < 8; ++j) v[j] = *(const f32x4*)(p + 4 * lane + 256 * j);
}
__device__ __forceinline__ void ld_row_bf16(const bf16_t* p, int lane, f32x4 (&v)[8]) {
#pragma unroll
    for (int j = 0; j < 8; ++j) { const u32x2 w = *(const u32x2*)(p + 4 * lane + 256 * j); v[j] = (f32x4){bf_lo(w.x), bf_hi(w.x), bf_lo(w.y), bf_hi(w.y)}; }
}
__device__ __forceinline__ void st_row_f32(float* p, int lane, const f32x4 (&v)[8]) {
#pragma unroll
    for (int j = 0; j < 8; ++j) *(f32x4*)(p + 4 * lane + 256 * j) = v[j];
}
__device__ __forceinline__ void st_row_bf16(bf16_t* p, int lane, const f32x4 (&v)[8]) {
#pragma unroll
    for (int j = 0; j < 8; ++j) { u32x2 w; w.x = cvt_pk_bf16(v[j].x, v[j].y); w.y = cvt_pk_bf16(v[j].z, v[j].w); *(u32x2*)(p + 4 * lane + 256 * j) = w; }
}
__device__ __forceinline__ float row_rstd(const f32x4 (&v)[8]) {
    float s = 0.f;
#pragma unroll
    for (int j = 0; j < 8; ++j) s += (v[j].x * v[j].x + v[j].y * v[j].y) + (v[j].z * v[j].z + v[j].w * v[j].w);
    return rsqrtf(wave_sum(s) * (1.f / D) + EPS);
}
template <bool STORE = true> __device__ __forceinline__ void norm_mod_store(const f32x4 (&x)[8], const float* g, const float* sh, const float* sc, bf16_t* hrow, int lane, f32x4 (&h)[8]) {
    const float r = row_rstd(x);
#pragma unroll
    for (int j = 0; j < 8; ++j) { const int c = 4 * lane + 256 * j; const f32x4 gv = *(const f32x4*)(g + c), sv = *(const f32x4*)(sc + c), hv = *(const f32x4*)(sh + c);
        h[j] = (x[j] * r * gv) * (sv + 1.f) + hv; }
    if (STORE) st_row_bf16(hrow, lane, h);
}
__device__ __forceinline__ void phase_row_entry(ArgsP a, int gw, int ngw, int lane) {
    bf16_t* X = (bf16_t*)(a->ws + WS_X); bf16_t* H = (bf16_t*)(a->ws + WS_H); const float* MOD = (const float*)(a->ws + WS_MOD);
    for (int row = gw; row < NR; row += ngw) {
        const int b = row / TPB, t = row % TPB; const bool lat = t < SEQ; const int v = lat ? b : 4;
        const float* src = lat ? a->in[I_X] + ((size_t)b * SEQ + t) * D : a->in[I_CTX] + ((size_t)b * CTX + (t - SEQ)) * D;
        f32x4 x[8], h[8]; ld_row_f32(src, lane, x); st_row_bf16(X + (size_t)row * D, lane, x);
        const float* mv = MOD + (size_t)(0 * 5 + v) * MODW;
        norm_mod_store(x, a->in[I_GMIXPRE], mv + 0 * D, mv + 1 * D, H + (size_t)row * D, lane, h);
    }
}
template <int L> __device__ __forceinline__ void phase_row_mid(ArgsP a, LAS unsigned char* lds, int gw, int ngw, int tid, int lane) {
    bf16_t* X = (bf16_t*)(a->ws + WS_X); bf16_t* H = (bf16_t*)(a->ws + WS_H); const float* MOD = (const float*)(a->ws + WS_MOD); const bf16_t* O = (const bf16_t*)(a->ws + WS_O);
    LAS unsigned* lcnt = (LAS unsigned*)(lds + 131072 + 64); LAS float* rt = (LAS float*)lds;
    if (L == 1) { if (tid < 8) lcnt[tid] = 0u;
        for (int i = tid; i < D * NE; i += NTHREADS) rt[(i & 7) * D + (i >> 3)] = a->in[I_ROUTER][i];
        __syncthreads(); }
    for (int row = gw; row < NR; row += ngw) {
        const int b = row / TPB, t = row % TPB; const bool lat = t < SEQ; const int v = lat ? b : 4;
        if (L == 1 && !lat) continue;
        const float* mv = MOD + (size_t)(L * 5 + v) * MODW;
        f32x4 o[8], x[8], h[8];
        if (L == 0 && !lat) { const bf16_t* P = (const bf16_t*)(a->ws + WS_PART_A) + (size_t)(b * CTX + (t - SEQ)) * D; ld_row_bf16(P, lane, o);
#pragma unroll
            for (int s = 1; s < 8; ++s) { f32x4 p[8]; ld_row_bf16(P + (size_t)s * (NB * CTX) * D, lane, p);
#pragma unroll
                for (int j = 0; j < 8; ++j) o[j] = o[j] + p[j]; } }
        else ld_row_bf16(O + (size_t)row * D, lane, o);
        ld_row_bf16(X + (size_t)row * D, lane, x);
        const float r1 = row_rstd(o);
#pragma unroll
        for (int j = 0; j < 8; ++j) { const int c = 4 * lane + 256 * j; const f32x4 gv = *(const f32x4*)(a->in[I_GMIXPOST] + L * D + c), gt = *(const f32x4*)(mv + 2 * D + c);
            x[j] = x[j] + gt * (o[j] * r1 * gv); }
        st_row_bf16(X + (size_t)row * D, lane, x);
        norm_mod_store<(L == 0 && !FP8_UP0)>(x, a->in[I_GFFNPRE] + L * D, mv + 3 * D, mv + 4 * D, H + (size_t)row * D, lane, h);
        { unsigned char* h8 = a->ws + WS_H8 + (size_t)row * D;
#pragma unroll
            for (int j = 0; j < 8; ++j) *(unsigned*)(h8 + 4 * lane + 256 * j) = pk4_fp8(h[j].x * F8_SH, h[j].y * F8_SH, h[j].z * F8_SH, h[j].w * F8_SH); }
        if (L == 1) {
            float lg[8];
#pragma unroll
            for (int e = 0; e < 8; ++e) lg[e] = 0.f;
#pragma unroll
            for (int j = 0; j < 8; ++j)
#pragma unroll
                for (int e = 0; e < 8; ++e) { const f32x4 r = *(const LAS f32x4*)(rt + e * D + 4 * lane + 256 * j); lg[e] += (h[j].x * r.x + h[j].y * r.y) + (h[j].z * r.z + h[j].w * r.w); }
#pragma unroll
            for (int e = 0; e < 8; ++e) lg[e] = wave_sum(lg[e]);
            int i1 = 0; float v1 = lg[0];
#pragma unroll
            for (int e = 1; e < 8; ++e) if (lg[e] > v1) { v1 = lg[e]; i1 = e; }
            int i2 = -1; float v2 = -3.0e38f;
#pragma unroll
            for (int e = 0; e < 8; ++e) if (e != i1 && lg[e] > v2) { v2 = lg[e]; i2 = e; }
            const float e2 = __expf(v2 - v1), g1 = 1.f / (1.f + e2), g2 = e2 / (1.f + e2);
            if (lane == 0) { const int tok = b * SEQ + t; int* tk = (int*)(a->ws + WS_TOPK) + (size_t)tok * 4; tk[0] = i1; tk[1] = i2; ((float*)tk)[2] = g1; ((float*)tk)[3] = g2;
                atomicAdd((unsigned*)&lcnt[i1], 1u); atomicAdd((unsigned*)&lcnt[i2], 1u); }
        }
    }
    if (L == 1) { __syncthreads(); if (tid < 8) { const unsigned c = lcnt[tid]; if (c) __hip_atomic_fetch_add((unsigned*)(a->ws + WS_CTL) + CW_CNT + tid, c, __ATOMIC_RELAXED, __HIP_MEMORY_SCOPE_AGENT); } __syncthreads(); }
}
constexpr int LDS_CTL_OFF = 131072;
__device__ __forceinline__ LAS int* moe_offsets(ArgsP a, LAS unsigned char* lds, int tid) {
    LAS int* toff = (LAS int*)(lds + LDS_CTL_OFF);
    __syncthreads();
    if (tid == 0) { int acc = 0;
        for (int e = 0; e < 8; ++e) { toff[e] = acc; const unsigned c = __hip_atomic_load((unsigned*)(a->ws + WS_CTL) + CW_CNT + e, __ATOMIC_RELAXED, __HIP_MEMORY_SCOPE_AGENT); toff[16 + e] = (int)c; acc += (int)((c + 255u) >> 8); }
        toff[8] = acc; }
    __syncthreads();
    return toff;
}
__device__ __forceinline__ void phase_moe_slots(ArgsP a, LAS unsigned char* lds, int gw, int ngw, int tid, int lane) {
    LAS int* toff = moe_offsets(a, lds, fresh_tid());
    unsigned* ctl = (unsigned*)(a->ws + WS_CTL); int* SLOT = (int*)(a->ws + WS_SLOT); int* IDX = (int*)(a->ws + WS_IDX); const int* TOPK = (const int*)(a->ws + WS_TOPK);
    const int wave = tid >> 6;
    for (int e = blockIdx.x; e < 8; e += gridDim.x) { const int c = toff[16 + e], s0 = toff[e] * 256 + c, n = ((c + 255) & ~255) - c;
        for (int i = tid; i < n; i += NTHREADS) IDX[s0 + i] = 0; }
    for (int grp = blockIdx.x; grp < NTOK / 64; grp += gridDim.x) {
        if (wave == 0) {
            const int tok = grp * 64 + lane, b = tok / SEQ, t = tok % SEQ, row = b * TPB + t;
            const int e1 = TOPK[tok * 4], e2 = TOPK[tok * 4 + 1]; int s0 = 0, s1 = 0;
            unsigned long long msk[8]; int nmine = 0;
#pragma unroll
            for (int e = 0; e < 8; ++e) { msk[e] = __ballot((e1 == e) || (e2 == e)); nmine = (lane == e) ? __popcll(msk[e]) : nmine; }
            unsigned base = 0; if (lane < 8 && nmine) base = __hip_atomic_fetch_add(ctl + CW_CUR + lane, (unsigned)nmine, __ATOMIC_RELAXED, __HIP_MEMORY_SCOPE_AGENT);
#pragma unroll
            for (int e = 0; e < 8; ++e) { const unsigned be = __shfl(base, e);
                const int slot = toff[e] * 256 + (int)be + __popcll(msk[e] & ((1ull << lane) - 1ull));
                if (e1 == e) s0 = slot; if (e2 == e) s1 = slot; }
            SLOT[tok * 2] = s0; SLOT[tok * 2 + 1] = s1; IDX[s0] = row; IDX[s1] = row;
        }
    }
    __syncthreads();
}
template <int L> __device__ __forceinline__ void phase_row_end(ArgsP a, int gw, int ngw, int lane) {
    bf16_t* X = (bf16_t*)(a->ws + WS_X); bf16_t* H = (bf16_t*)(a->ws + WS_H); const float* MOD = (const float*)(a->ws + WS_MOD); const bf16_t* Y = (const bf16_t*)(a->ws + WS_Y);
    for (int row = gw; row < NR; row += ngw) {
        const int b = row / TPB, t = row % TPB; const bool lat = t < SEQ; const int v = lat ? b : 4;
        if (L == 1 && !lat) continue;
        const float* mv = MOD + (size_t)(L * 5 + v) * MODW;
        f32x4 y[8], x[8], h[8];
        if (L == 0 && !lat) { const bf16_t* P = (const bf16_t*)(a->ws + WS_PART_B) + (size_t)(b * CTX + (t - SEQ)) * D; ld_row_bf16(P, lane, y);
#pragma unroll
            for (int s = 1; s < 8; ++s) { f32x4 p[8]; ld_row_bf16(P + (size_t)s * (NB * CTX) * D, lane, p);
#pragma unroll
                for (int j = 0; j < 8; ++j) y[j] = y[j] + p[j]; } }
        else if (L == 0) ld_row_bf16(Y + (size_t)row * D, lane, y);
        else { const int tok = b * SEQ + t; const int* sl = (const int*)(a->ws + WS_SLOT) + tok * 2; const float* tk = (const float*)(a->ws + WS_TOPK) + (size_t)tok * 4; const float g1 = tk[2], g2 = tk[3];
            f32x4 y2[8]; const bf16_t* PM = (const bf16_t*)(a->ws + WS_PART_M); const int sa = sl[0], sb = sl[1], TS = 256 * ((2 * NTOK) / 256);
            if (sa < TS) ld_row_bf16(Y + (size_t)sa * D, lane, y);
            else { ld_row_bf16(PM + (size_t)(sa - TS) * D, lane, y);
                for (int q = 1; q < 4; ++q) { f32x4 p[8]; ld_row_bf16(PM + ((size_t)q * 2048 + (sa - TS)) * D, lane, p);
#pragma unroll
                    for (int j = 0; j < 8; ++j) y[j] = y[j] + p[j]; } }
            if (sb < TS) ld_row_bf16(Y + (size_t)sb * D, lane, y2);
            else { ld_row_bf16(PM + (size_t)(sb - TS) * D, lane, y2);
                for (int q = 1; q < 4; ++q) { f32x4 p[8]; ld_row_bf16(PM + ((size_t)q * 2048 + (sb - TS)) * D, lane, p);
#pragma unroll
                    for (int j = 0; j < 8; ++j) y2[j] = y2[j] + p[j]; } }
#pragma unroll
            for (int j = 0; j < 8; ++j) y[j] = y[j] * g1 + y2[j] * g2; }
        ld_row_bf16(X + (size_t)row * D, lane, x);
        const float r1 = row_rstd(y);
#pragma unroll
        for (int j = 0; j < 8; ++j) { const int c = 4 * lane + 256 * j; const f32x4 gv = *(const f32x4*)(a->in[I_GFFNPOST] + L * D + c), gt = *(const f32x4*)(mv + 5 * D + c);
            x[j] = x[j] + gt * (y[j] * r1 * gv); }
        if (L == 0) { st_row_bf16(X + (size_t)row * D, lane, x); const float* mn = MOD + (size_t)(1 * 5 + v) * MODW;
            norm_mod_store(x, a->in[I_GMIXPRE] + D, mn + 0 * D, mn + 1 * D, H + (size_t)row * D, lane, h); }
        else st_row_f32(a->out + ((size_t)b * SEQ + t) * D, lane, x);
    }
}

template <int L> __device__ __forceinline__ void phase_qkpost(ArgsP a, LAS unsigned char* lds, int gw, int ngw, int tid, int lane) {
    bf16_t* QKV = (bf16_t*)(a->ws + WS_QKV);
    const float L2T = 13.287712379549449f;
    LAS f32x2* tg = (LAS f32x2*)lds; LAS f32x2* td = tg + 64 * 32;
    for (int i = tid; i < 64 * 32 + 64 * 16; i += NTHREADS) { float s_, c_;
        if (i < 64 * 32) { sincosf((float)(i >> 5) * exp2f(-(float)(i & 31) * (1.f / 32.f) * L2T), &s_, &c_); tg[i] = (f32x2){c_, s_}; }
        else { const int q_ = i - 64 * 32; sincosf((float)(q_ >> 4) * exp2f(-(float)(q_ & 15) * (1.f / 16.f) * L2T), &s_, &c_); td[q_] = (f32x2){c_, s_}; } }
    __syncthreads();
    const float qn0 = a->in[I_QNORM][L * 128 + lane], qn1 = a->in[I_QNORM][L * 128 + 64 + lane], kn0 = a->in[I_KNORM][L * 128 + lane], kn1 = a->in[I_KNORM][L * 128 + 64 + lane];
    for (int row = gw; row < NR; row += ngw) {
        const int t = row % TPB; const bool lat = t < SEQ; const int gr = t >> 6, gc = t & 63;
        bf16_t* q = QKV + (size_t)row * INW;
        const f32x2 t_r = tg[gr * 32 + (lane & 31)], t_c = tg[gc * 32 + (lane & 31)], t_d = td[(lane < 32 ? gr : gc) * 16 + (lane & 15)];
        const float cr = t_r.x, sr = t_r.y, cc = t_c.x, sc2 = t_c.y, cd = t_d.x, sd = t_d.y;
        float e0[10], e1[10], f0[8], f1[8];
#pragma unroll
        for (int hd = 8; hd < 10; ++hd) { const int base = hd < 8 ? 1536 + hd * 128 : 2560 + (hd - 8) * 128; e0[hd] = bf2f(q[base + lane]); e1[hd] = bf2f(q[base + 64 + lane]); }
        if (lat) {
#pragma unroll
            for (int bl = 4; bl < 8; ++bl) { const int base = 3072 + bl * 128; f0[bl] = bf2f(q[base + lane]); f1[bl] = bf2f(q[base + 64 + lane]); } }
#pragma unroll
        for (int hd = 8; hd < 10; ++hd) {
            const int base = hd < 8 ? 1536 + hd * 128 : 2560 + (hd - 8) * 128;
            float x0 = e0[hd], x1 = e1[hd];
            const float r = rsqrtf(wave_sum(x0 * x0 + x1 * x1) * (1.f / 128.f) + EPS);
            x0 = x0 * r * (hd < 8 ? qn0 : kn0); x1 = x1 * r * (hd < 8 ? qn1 : kn1);
            if (lat) { const float p0 = __shfl_xor(x0, 32), p1 = __shfl_xor(x1, 32);
                if (lane < 32) { x0 = x0 * cr - p0 * sr; x1 = x1 * cc - p1 * sc2; } else { x0 = x0 * cr + p0 * sr; x1 = x1 * cc + p1 * sc2; } }
            q[base + lane] = f2bf(x0); q[base + 64 + lane] = f2bf(x1);
        }
        if (lat) {
#pragma unroll
            for (int bl = 4; bl < 8; ++bl) {
                const int base = 3072 + bl * 128;
                float x0 = f0[bl], x1 = f1[bl];
                const float p0 = __shfl_xor(x0, 16), p1 = __shfl_xor(x1, 16);
                if ((lane & 16) == 0) { x0 = x0 * cd - p0 * sd; x1 = x1 * cd - p1 * sd; } else { x0 = x0 * cd + p0 * sd; x1 = x1 * cd + p1 * sd; }
                q[base + lane] = f2bf(x0); q[base + 64 + lane] = f2bf(x1);
            }
        }
    }
}

namespace att {
typedef short s16x4 __attribute__((ext_vector_type(4)));
typedef float f32x16 __attribute__((ext_vector_type(16)));
constexpr int KVBLK = 64;
constexpr int SHM_V = KVBLK * 128 * 2, SHM_K = KVBLK * 128 * 2;
constexpr float THR = 8.f;
#define KSWZ(row, colB) ((row) * 256 + ((colB) ^ (((row) & 7) << 4)))
#define SBAR() __builtin_amdgcn_sched_barrier(0)
__device__ __forceinline__ int crow(int r, int hi) { return (r & 3) + 8 * (r >> 2) + 4 * hi; }
__device__ __forceinline__ unsigned cvtpk(float lo, float hi) { unsigned r; asm volatile("v_cvt_pk_bf16_f32 %0, %1, %2" : "=v"(r) : "v"(lo), "v"(hi)); return r; }
constexpr float THRL = 64.f;
template <int MODE> __device__ __forceinline__ void partialSM(f32x16& p0, f32x16& p1, float& m_reg, float& mn, float& alpha, bool chk = true) {
  mn = m_reg; alpha = 1.f;
  if (chk) {
    float pmax = p0[0];
#pragma unroll
    for (int r = 1; r < 16; ++r) pmax = fmaxf(pmax, p0[r]);
#pragma unroll
    for (int r = 0; r < 16; ++r) pmax = fmaxf(pmax, p1[r]);
    { auto rr = __builtin_amdgcn_permlane32_swap(__float_as_uint(pmax), __float_as_uint(pmax), false, false);
      pmax = fmaxf(__uint_as_float(rr[0]), __uint_as_float(rr[1])); }
    if (!__builtin_expect(__all(pmax - m_reg <= THRL), 1)) { mn = fmaxf(m_reg, pmax); alpha = __builtin_amdgcn_exp2f(m_reg - mn); m_reg = mn; }
  }
  if (__builtin_expect(__any(mn != 0.f), 0)) {
#pragma unroll
    for (int r = 0; r < 16; ++r) { p0[r] -= mn; p1[r] -= mn; }
  }
#pragma unroll
  for (int r = 0; r < 16; ++r) p0[r] = __builtin_amdgcn_exp2f(p0[r]);
}
template <bool LSUM = false> __device__ __forceinline__ void finishSM(f32x16& p0, f32x16& p1, float alpha, float& l_reg, bf16x8& pa0, bf16x8& pa1, bf16x8& pa2, bf16x8& pa3) {
#pragma unroll
  for (int r = 0; r < 16; ++r) p1[r] = __builtin_amdgcn_exp2f(p1[r]);
  if (!LSUM) { float ps = 0;
#pragma unroll
  for (int r = 0; r < 16; ++r) ps += p0[r];
#pragma unroll
  for (int r = 0; r < 16; ++r) ps += p1[r];
  { auto rr = __builtin_amdgcn_permlane32_swap(__float_as_uint(ps), __float_as_uint(ps), false, false);
    ps = __uint_as_float(rr[0]) + __uint_as_float(rr[1]); }
  l_reg = l_reg * alpha + ps; }
#define PK4(P, BASE, OUT) do { unsigned a0 = cvtpk(P[BASE + 0], P[BASE + 1]), a1 = cvtpk(P[BASE + 2], P[BASE + 3]);   \
    unsigned b0 = cvtpk(P[BASE + 4], P[BASE + 5]), b1 = cvtpk(P[BASE + 6], P[BASE + 7]);                              \
    auto r0 = __builtin_amdgcn_permlane32_swap(a0, b0, false, false); auto r1 = __builtin_amdgcn_permlane32_swap(a1, b1, false, false); \
    u32x4 w = {r0[0], r1[0], r0[1], r1[1]}; OUT = *reinterpret_cast<bf16x8*>(&w); } while (0)
  PK4(p0, 0, pa0); PK4(p0, 8, pa1); PK4(p1, 0, pa2); PK4(p1, 8, pa3);
#undef PK4
}
template <int NQ> __device__ __forceinline__ void qkt(f32x16& p0, f32x16& p1, const LAS unsigned char* Ks, const bf16x8* qr, int r32, int hi, int mapoff) {
  p0 = f32x16{}; p1 = f32x16{};
#pragma unroll
  for (int d0 = 0; d0 < NQ; ++d0) { int cb = (mapoff + d0 * 16 + hi * 8) * 2;
    bf16x8 b0 = *reinterpret_cast<const LAS bf16x8*>(Ks + KSWZ(r32, cb));
    bf16x8 b1 = *reinterpret_cast<const LAS bf16x8*>(Ks + KSWZ(32 + r32, cb));
    p0 = __builtin_amdgcn_mfma_f32_32x32x16_bf16(b0, qr[d0], p0, 0, 0, 0);
    p1 = __builtin_amdgcn_mfma_f32_32x32x16_bf16(b1, qr[d0], p1, 0, 0, 0); }
}
__device__ __forceinline__ int v_st(int k, int c) { const int kk = (k & ~0xC) | ((k & 4) << 1) | ((k & 8) >> 1); return ((kk >> 3) * 4 + (c >> 5)) * 512 + ((kk & 7) * 32 + (c & 31)) * 2; }
__device__ __forceinline__ int v_rd_base(int lane) { return ((lane & 3) << 3) | (((lane >> 2) & 3) << 6) | (((lane >> 4) & 1) << 5) | (((lane >> 5) & 1) << 8); }
constexpr int v_rd_off(int d0, int ks, int half) { return d0 * 512 + ks * 4096 + half * 2048; }
template <int OFF> __device__ __forceinline__ s16x4 tr_read(int vb) {
  s16x4 r; asm volatile("ds_read_b64_tr_b16 %0, %1 offset:%2" : "=&v"(r) : "v"(vb), "i"(OFF) : "memory"); return r;
}
template <int D0> __device__ __forceinline__ void pv_one(f32x16& od, int vb, bf16x8 pa0, bf16x8 pa1, bf16x8 pa2, bf16x8 pa3) {
  const s16x4 l0 = tr_read<v_rd_off(D0, 0, 0)>(vb), h0 = tr_read<v_rd_off(D0, 0, 1)>(vb), l1 = tr_read<v_rd_off(D0, 1, 0)>(vb), h1 = tr_read<v_rd_off(D0, 1, 1)>(vb);
  const s16x4 l2 = tr_read<v_rd_off(D0, 2, 0)>(vb), h2 = tr_read<v_rd_off(D0, 2, 1)>(vb), l3 = tr_read<v_rd_off(D0, 3, 0)>(vb), h3 = tr_read<v_rd_off(D0, 3, 1)>(vb);
  asm volatile("s_waitcnt lgkmcnt(0)" ::: "memory"); SBAR();
#define PK(L, H) (bf16x8){L[0], L[1], L[2], L[3], H[0], H[1], H[2], H[3]}
  od = __builtin_amdgcn_mfma_f32_32x32x16_bf16(pa0, PK(l0, h0), od, 0, 0, 0);
  od = __builtin_amdgcn_mfma_f32_32x32x16_bf16(pa1, PK(l1, h1), od, 0, 0, 0);
  od = __builtin_amdgcn_mfma_f32_32x32x16_bf16(pa2, PK(l2, h2), od, 0, 0, 0);
  od = __builtin_amdgcn_mfma_f32_32x32x16_bf16(pa3, PK(l3, h3), od, 0, 0, 0);
#undef PK
}
__device__ __forceinline__ void lsum_mm(f32x16& lacc, bf16x8 onesB, bf16x8 pa0, bf16x8 pa1, bf16x8 pa2, bf16x8 pa3) {
  lacc = __builtin_amdgcn_mfma_f32_32x32x16_bf16(pa0, onesB, lacc, 0, 0, 0); lacc = __builtin_amdgcn_mfma_f32_32x32x16_bf16(pa1, onesB, lacc, 0, 0, 0);
  lacc = __builtin_amdgcn_mfma_f32_32x32x16_bf16(pa2, onesB, lacc, 0, 0, 0); lacc = __builtin_amdgcn_mfma_f32_32x32x16_bf16(pa3, onesB, lacc, 0, 0, 0);
}
__device__ __forceinline__ void pv_d0(f32x16* o, int vb, bf16x8 pa0, bf16x8 pa1, bf16x8 pa2, bf16x8 pa3) {
  pv_one<0>(o[0], vb, pa0, pa1, pa2, pa3); pv_one<1>(o[1], vb, pa0, pa1, pa2, pa3); pv_one<2>(o[2], vb, pa0, pa1, pa2, pa3); pv_one<3>(o[3], vb, pa0, pa1, pa2, pa3);
}
template <int MODE>
__device__ __forceinline__ void attn_body(const bf16_t* __restrict__ Qb, const bf16_t* __restrict__ Kh, const bf16_t* __restrict__ Vh, bf16_t* __restrict__ Ob, int seq, LAS unsigned char* lds,
                                          float lam, float osc, const float* __restrict__ subln, int na_r0 = 0, int na_R0 = 0, int qproc = 0, const float* __restrict__ qnw = nullptr, int trow0 = 0) {
  constexpr int NQ = MODE == 1 ? 4 : 8;
  const int tid = threadIdx.x, wid = __builtin_amdgcn_readfirstlane(tid >> 6), lane = tid & 63, r32 = lane & 31, hi = lane >> 5;
  const int wrow = MODE == 1 ? (wid & 3) : wid, mapoff = MODE == 1 ? (wid >> 2) * 64 : 0;
  LAS unsigned char* V_lds = lds; LAS unsigned char* K_lds = lds + 2 * SHM_V;
  LAS float* wsf = (LAS float*)(lds + 2 * SHM_V + 2 * SHM_K) + wid * 64; LAS float* li_l = wsf; LAS float* al_l = wsf + 32;
  constexpr bool LSUM = (MODE == 1);
  float m_reg = 0.f, l_reg = 0; f32x16 o[4] = {}; bf16x8 qr[NQ]; f32x16 lacc = {};
  bf16x8 onesB; { const short one_ = (r32 == 0) ? (short)0x3F80 : (short)0; onesB = (bf16x8){one_, one_, one_, one_, one_, one_, one_, one_}; }
  const bf16_t* Qw = Qb + (size_t)(wrow * 32 + r32) * INW + mapoff + hi * 8;
  { const LAS f32x2* tg = (const LAS f32x2*)(lds + 73728); const LAS f32x2* td = tg + 64 * 32;
    const int trow = trow0 + wrow * 32 + r32, gr = trow >> 6, gc = trow & 63;
    constexpr float CQ = (MODE == 1 ? 0.125f : 0.088388347648318440f) * 1.4426950408889634f;
#define QLD(X, D0) do { const u32x4 w_ = *reinterpret_cast<const u32x4*>(Qw + (D0) * 16); X[0] = bf_lo(w_.x); X[1] = bf_hi(w_.x); X[2] = bf_lo(w_.y); X[3] = bf_hi(w_.y); X[4] = bf_lo(w_.z); X[5] = bf_hi(w_.z); X[6] = bf_lo(w_.w); X[7] = bf_hi(w_.w); } while (0)
#define QPK(X, D0, SC) do { u32x4 s_; s_.x = cvtpk(X[0] * (SC), X[1] * (SC)); s_.y = cvtpk(X[2] * (SC), X[3] * (SC)); s_.z = cvtpk(X[4] * (SC), X[5] * (SC)); s_.w = cvtpk(X[6] * (SC), X[7] * (SC)); qr[D0] = *reinterpret_cast<bf16x8*>(&s_); } while (0)
    float rr = 1.f;
    if (MODE == 0 && qproc >= 1) { float ss = 0.f;
#pragma unroll
      for (int d0 = 0; d0 < NQ; ++d0) { float x[8]; QLD(x, d0);
#pragma unroll
        for (int e = 0; e < 8; ++e) ss += x[e] * x[e]; }
      ss += __shfl_xor(ss, 32); rr = rsqrtf(ss * (1.f / 128.f) + EPS); }
    constexpr int NPAIR = NQ / 2, PSTEP = MODE == 1 ? 1 : 2;
#pragma unroll
    for (int pr = 0; pr < NPAIR; ++pr) {
      const int da = MODE == 1 ? 2 * pr : 4 * (pr >> 1) + (pr & 1), db = da + PSTEP;
      float xa[8], xb[8]; QLD(xa, da); QLD(xb, db);
      if (MODE == 0 && qproc >= 1) { const f32x4 ga0 = *(const f32x4*)(qnw + 16 * da + 8 * hi), ga1 = *(const f32x4*)(qnw + 16 * da + 8 * hi + 4), gb0 = *(const f32x4*)(qnw + 16 * db + 8 * hi), gb1 = *(const f32x4*)(qnw + 16 * db + 8 * hi + 4);
#pragma unroll
        for (int e = 0; e < 4; ++e) { xa[e] *= rr * ga0[e]; xa[4 + e] *= rr * ga1[e]; xb[e] *= rr * gb0[e]; xb[4 + e] *= rr * gb1[e]; } }
      if (qproc == 2) {
        const LAS f32x2* tb = MODE == 1 ? td + (pr ? gc : gr) * 16 + 8 * hi : tg + ((pr >> 1) ? gc : gr) * 32 + 16 * (pr & 1) + 8 * hi;
#pragma unroll
        for (int e = 0; e < 8; ++e) { const f32x2 cs = tb[e]; const float x1 = xa[e], x2 = xb[e]; xa[e] = x1 * cs.x - x2 * cs.y; xb[e] = x2 * cs.x + x1 * cs.y; } }
      QPK(xa, da, CQ); QPK(xb, db, CQ);
    }
#undef QLD
#undef QPK
  }
  const int sr = tid >> 4, sc = (tid & 15) * 8, vst0 = v_st(sr, sc), vst1 = v_st(32 + sr, sc);
  const int vb0 = (int)(uintptr_t)V_lds + v_rd_base(lane);
  struct { bf16x8 vs0, vs1, ks0, ks1; } sr_[1];
#define TOK(T) (MODE == 2 ? ((T) < 4 ? SEQ + 64 * (T) : (na_R0 + (T) - 4) * 64) : (T) * KVBLK)
  const unsigned kvoff = (unsigned)(sr * INW + sc) * 2u;
#define SLOAD(i, T) do { const size_t tb_ = (size_t)TOK(T) * (INW * 2); const char* vb_ = (const char*)Vh + tb_; const char* kb_ = (const char*)Kh + tb_; \
    sr_[i].vs0 = *(const bf16x8*)(vb_ + kvoff); sr_[i].vs1 = *(const bf16x8*)(vb_ + (size_t)32 * INW * 2 + kvoff); \
    sr_[i].ks0 = *(const bf16x8*)(kb_ + kvoff); sr_[i].ks1 = *(const bf16x8*)(kb_ + (size_t)32 * INW * 2 + kvoff); } while (0)
  LAS float* rpbL = (LAS float*)(lds + 2 * SHM_V + 2 * SHM_K + 2048);
  const int na_rq = na_r0 + (wid >> 1), na_rs = min(max(na_rq - 4, 0), 56);
#define NABIAS(P0, P1, T) do { if (MODE == 2 && (T) >= 4) { const int na_c = ((wid & 1) << 5) + r32, na_t = 4 * hi - min(max(na_c - 8, 0), 48); \
    const int kr_ = na_R0 + (T) - 4; const bool rowok_ = kr_ >= na_rs && kr_ < na_rs + 8; const LAS float* bp_ = rpbL + (172 + (kr_ - na_rq + 7) * 31 + 15 - na_c + 4 * hi); \
    _Pragma("unroll") for (int r = 0; r < 16; ++r) { const int kq_ = (r & 3) + 8 * (r >> 2); \
      { const bool ok_ = rowok_ && (unsigned)(na_t + kq_) < 16u; P0[r] = ok_ ? fmaf(bp_[kq_], 1.4426950408889634f, P0[r]) : -1e30f; } \
      { const bool ok_ = rowok_ && (unsigned)(na_t + kq_ + 32) < 16u; P1[r] = ok_ ? fmaf(bp_[kq_ + 32], 1.4426950408889634f, P1[r]) : -1e30f; } } } } while (0)
#define SWRITE(b, i) do { *(LAS bf16x8*)(V_lds + (b) * SHM_V + vst0) = sr_[i].vs0;          \
    *(LAS bf16x8*)(V_lds + (b) * SHM_V + vst1) = sr_[i].vs1; int kc = sc * 2;               \
    *(LAS bf16x8*)(K_lds + (b) * SHM_K + KSWZ(sr, kc)) = sr_[i].ks0;                       \
    *(LAS bf16x8*)(K_lds + (b) * SHM_K + KSWZ(32 + sr, kc)) = sr_[i].ks1; } while (0)
#define SWAIT() asm volatile("s_waitcnt vmcnt(0)" ::: "memory")
#define RESC(a) do { if (__any((a) < 1.f)) { if (hi == 0) al_l[r32] = (a); asm volatile("s_waitcnt lgkmcnt(0)" ::: "memory"); \
    _Pragma("unroll") for (int d = 0; d < 4; ++d) _Pragma("unroll") for (int r = 0; r < 16; ++r) o[d][r] *= al_l[crow(r, hi)]; \
    if (LSUM) { _Pragma("unroll") for (int r = 0; r < 16; ++r) lacc[r] *= al_l[crow(r, hi)]; } } } while (0)
  f32x16 pA0, pA1, pB0, pB1; float mnA, mnB, alA, alB; bf16x8 pa0, pa1, pa2, pa3; const int NT = seq / KVBLK;
  if (MODE == 2) { for (int i = tid; i < 832; i += 512) { const int q = i - 172, dr = q >= 0 ? q / 31 : -1, dc = q - dr * 31; rpbL[i] = (q >= 0 && dr < 15) ? subln[dr * 31 + dc] : 0.f; } }
  SLOAD(0, 0); SWAIT(); SWRITE(0, 0); SLOAD(0, 1); __syncthreads();
  qkt<NQ>(pA0, pA1, K_lds, qr, r32, hi, mapoff); NABIAS(pA0, pA1, 0); partialSM<MODE>(pA0, pA1, m_reg, mnA, alA);
  SWAIT(); SWRITE(1, 0); if (2 < NT) SLOAD(0, 2); __syncthreads();
  for (int j = 1; j + 1 < NT; j += 2) {
    SBAR(); qkt<NQ>(pB0, pB1, K_lds + SHM_K, qr, r32, hi, mapoff);
    finishSM<LSUM>(pA0, pA1, alA, l_reg, pa0, pa1, pa2, pa3); SBAR();
    pv_d0(o, vb0, pa0, pa1, pa2, pa3); if (LSUM) lsum_mm(lacc, onesB, pa0, pa1, pa2, pa3); NABIAS(pB0, pB1, j); partialSM<MODE>(pB0, pB1, m_reg, mnB, alB, MODE == 2 || (j & 3) == 1);
    __syncthreads(); SWAIT(); SWRITE(0, 0); SLOAD(0, j + 2);
    RESC(alB); __syncthreads();
    SBAR(); qkt<NQ>(pA0, pA1, K_lds, qr, r32, hi, mapoff);
    finishSM<LSUM>(pB0, pB1, alB, l_reg, pa0, pa1, pa2, pa3); SBAR();
    pv_d0(o, vb0 + SHM_V, pa0, pa1, pa2, pa3); if (LSUM) lsum_mm(lacc, onesB, pa0, pa1, pa2, pa3); NABIAS(pA0, pA1, j + 1); partialSM<MODE>(pA0, pA1, m_reg, mnA, alA, MODE == 2);
    __syncthreads(); SWAIT(); SWRITE(1, 0); if (j + 3 < NT) SLOAD(0, j + 3);
    RESC(alA); __syncthreads();
  }
  SBAR(); qkt<NQ>(pB0, pB1, K_lds + SHM_K, qr, r32, hi, mapoff);
  finishSM<LSUM>(pA0, pA1, alA, l_reg, pa0, pa1, pa2, pa3); SBAR();
  pv_d0(o, vb0, pa0, pa1, pa2, pa3); if (LSUM) lsum_mm(lacc, onesB, pa0, pa1, pa2, pa3); NABIAS(pB0, pB1, NT - 1); partialSM<MODE>(pB0, pB1, m_reg, mnB, alB);
  __syncthreads(); RESC(alB);
  finishSM<LSUM>(pB0, pB1, alB, l_reg, pa0, pa1, pa2, pa3); SBAR();
  pv_d0(o, vb0 + SHM_V, pa0, pa1, pa2, pa3); if (LSUM) lsum_mm(lacc, onesB, pa0, pa1, pa2, pa3);
  if (hi == 0) li_l[r32] = l_reg; asm volatile("s_waitcnt lgkmcnt(0)" ::: "memory");
  float rli[16];
#pragma unroll
  for (int r = 0; r < 16; ++r) { if (LSUM) { const float la = __int_as_float(__builtin_amdgcn_readlane(__float_as_int(lacc[r]), 0)), lb = __int_as_float(__builtin_amdgcn_readlane(__float_as_int(lacc[r]), 32)); rli[r] = __builtin_amdgcn_rcpf(hi ? lb : la); }
    else rli[r] = __builtin_amdgcn_rcpf(li_l[crow(r, hi)]); }
  bf16_t* Ow = Ob + (size_t)(wrow * 32) * D;
  if (MODE != 1) {
#pragma unroll
    for (int r = 0; r < 16; ++r) { const int orow = crow(r, hi);
#pragma unroll
      for (int d0 = 0; d0 < 4; ++d0) Ow[(size_t)orow * D + d0 * 32 + r32] = f2bf(o[d0][r] * rli[r]); }
    __syncthreads();
  } else {
#pragma unroll
    for (int r = 0; r < 16; ++r)
#pragma unroll
      for (int d0 = 0; d0 < 4; ++d0) o[d0][r] *= rli[r];
    __syncthreads();
    LAS float* xb = (LAS float*)lds + (wid & 3) * 4096;
    if (wid >= 4) {
#pragma unroll
      for (int r = 0; r < 16; ++r)
#pragma unroll
        for (int d0 = 0; d0 < 4; ++d0) xb[crow(r, hi) * 128 + d0 * 32 + r32] = o[d0][r];
    }
    __syncthreads();
    if (wid < 4) {
      float sg[4];
#pragma unroll
      for (int d0 = 0; d0 < 4; ++d0) sg[d0] = subln[d0 * 32 + r32] * osc;
#pragma unroll
      for (int r = 0; r < 16; ++r) { float ss = 0.f;
#pragma unroll
        for (int d0 = 0; d0 < 4; ++d0) { o[d0][r] -= lam * xb[crow(r, hi) * 128 + d0 * 32 + r32]; ss += o[d0][r] * o[d0][r]; }
#pragma unroll
        for (int x = 1; x < 32; x <<= 1) ss += __shfl_xor(ss, x);
        const float rr = rsqrtf(ss * (1.f / 128.f) + EPS); const int orow = crow(r, hi);
#pragma unroll
        for (int d0 = 0; d0 < 4; ++d0) Ow[(size_t)orow * D + d0 * 32 + r32] = f2bf(o[d0][r] * rr * sg[d0]); }
    }
    __syncthreads();
  }
#undef SLOAD
#undef TOK
#undef NABIAS
#undef SWRITE
#undef SWAIT
#undef RESC
}
}

namespace pg8 {
constexpr int BM = 256, BK = 64, HALF = 128, HTB = HALF * BK * 2, STAGE_BYTES = 8 * HTB, NXCD = 8, WGM = 8;
__host__ __device__ __forceinline__ int lds_byte(int r, int c) { const int st = (r >> 4) * 2 + (c >> 5), rr = r & 15, cc = c & 31, ob = rr * 64 + cc * 2; return st * 1024 + (ob ^ (((ob >> 9) & 1) << 5)); }
__host__ __device__ __forceinline__ void stage_rc(int b, int& R, int& C) { const int st = b / 1024, sb = b % 1024, swz = sb ^ (((sb >> 9) & 1) << 5); R = (st >> 1) * 16 + swz / 64; C = (st & 1) * 32 + (swz % 64) / 2; }
__host__ __device__ __forceinline__ int perm32(int rho) { const int n = rho >> 4, i = rho & 15; return 8 * (i >> 2) + 4 * n + (i & 3); }
struct Unit { int pm, pn; size_t boff; int kt0, nt, split; };
struct Gemm { const void* A; const void* Bt; int KB; const int* idx = nullptr; };
typedef int v8i __attribute__((ext_vector_type(8))); typedef int v4i __attribute__((ext_vector_type(4)));
template <bool SKIPCTX> struct StaticOrder {
    int nM, nN, nwg, G, c, ntk;
    __device__ void init(int nM_, int nN_, int G_, int c_, int ntk_) { nM = nM_; nN = nN_; nwg = nM * nN; G = G_; c = c_; ntk = ntk_; }
    __device__ bool next(int i, Unit& u) const {
        const long L = (long)i * G + c; if (L >= nwg) return false;
        int wgid = (int)L; { const int q = nwg / NXCD, r = nwg % NXCD, xcd = wgid % NXCD, off = wgid / NXCD; wgid = (xcd < r ? xcd * (q + 1) : r * (q + 1) + (xcd - r) * q) + off; }
        const int nig = WGM * nN, gid = wgid / nig, fm = gid * WGM, gsz = (nM - fm) < WGM ? (nM - fm) : WGM;
        int pm = fm + ((wgid % nig) % gsz); u.pn = (wgid % nig) / gsz; if (SKIPCTX) pm += pm >> 4; u.pm = pm; u.boff = 0; u.kt0 = 0; u.nt = ntk; u.split = -1; return true;
    }
};
struct SplitCtxOrder {
    StaticOrder<true> lat; int ntk;
    __device__ void init(int G_, int c_, int ntk_) { lat.init(NTOK / 256, D / 256, G_, c_, ntk_); ntk = ntk_; }
    __device__ bool next(int i, Unit& u) const {
        const long L = (long)i * lat.G + lat.c;
        if (L < lat.nwg) return lat.next(i, u);
        const int q = (int)(L - lat.nwg); if (q >= 256) return false;
        const int s = q >> 5, pc = (q >> 3) & 3; u.pn = q & 7; u.pm = 17 * pc + 16; u.boff = 0; u.split = s;
        const int pairs = ntk >> 1, base = pairs >> 3, rem = pairs & 7;
        u.kt0 = 2 * (s * base + (s < rem ? s : rem)); u.nt = 2 * (base + (s < rem ? 1 : 0)); return true;
    }
};
constexpr int MOE_MAIN_TILES = (2 * NTOK) / 256;
template <bool TAIL> struct MoeOrderT {
    int nM, nMain, nN, nwg, ntail, G, c, ntk; int toff[8]; size_t bstride;
    __device__ void init(const LAS int* t, int nN_, int G_, int c_, size_t bstride_, int ntk_) { ntk = ntk_; for (int e = 0; e < 8; ++e) toff[e] = __builtin_amdgcn_readfirstlane(t[e]); nM = __builtin_amdgcn_readfirstlane(t[8]); nN = nN_;
        nMain = TAIL ? MOE_MAIN_TILES : nM; nwg = nMain * nN; ntail = TAIL ? (nM - MOE_MAIN_TILES) * nN * 4 : 0; G = G_; c = c_; bstride = bstride_; }
    __device__ bool next(int i, Unit& u) const {
        const long L = (long)i * G + c; int pm;
        if (L < nwg) {
            int wgid = (int)L; { const int q = nwg / NXCD, r = nwg % NXCD, xcd = wgid % NXCD, off = wgid / NXCD; wgid = (xcd < r ? xcd * (q + 1) : r * (q + 1) + (xcd - r) * q) + off; }
            const int nig = WGM * nN, gid = wgid / nig, fm = gid * WGM, gsz = (nMain - fm) < WGM ? (nMain - fm) : WGM;
            pm = fm + ((wgid % nig) % gsz); u.pn = (wgid % nig) / gsz; u.kt0 = 0; u.nt = ntk; u.split = -1;
        } else {
            const long sidx = L - nwg; if (sidx >= ntail) return false;
            const int q = (int)sidx & 3, unit = (int)sidx >> 2; pm = MOE_MAIN_TILES + unit / nN; u.pn = unit % nN; u.split = q;
            const int pairs = ntk >> 1, base = pairs >> 2, rem = pairs & 3;
            u.kt0 = 2 * (q * base + (q < rem ? q : rem)); u.nt = 2 * (base + (q < rem ? 1 : 0));
        }
        u.pm = pm; int e = 0;
#pragma unroll
        for (int q = 1; q < 8; ++q) e += (pm >= toff[q]) ? 1 : 0;
        u.boff = (size_t)e * bstride; return true;
    }
};
typedef MoeOrderT<false> MoeOrder;
template <bool SCALED> struct EpiBf16T {
    bf16_t* O; int ldc; float scale;
    __device__ __forceinline__ void operator()(const f32x4 (&acc)[2][2][4][2], const Unit& u, int wr, int wc, int fr, int fq) const {
        const int row0 = u.pm * BM + wr * 64 + fr, col0 = u.pn * BM + wc * 32 + 8 * fq;
#pragma unroll
        for (int ai = 0; ai < 2; ++ai)
#pragma unroll
            for (int m = 0; m < 4; ++m) { bf16_t* rowp = O + (size_t)(row0 + ai * HALF + m * 16) * ldc + col0;
#pragma unroll
                for (int bj = 0; bj < 2; ++bj) { f32x4 v0 = acc[ai][bj][m][0], v1 = acc[ai][bj][m][1]; if (SCALED) { v0 = v0 * scale; v1 = v1 * scale; }
                    u32x4 w; w.x = cvt_pk_bf16(v0[0], v0[1]); w.y = cvt_pk_bf16(v0[2], v0[3]); w.z = cvt_pk_bf16(v1[0], v1[1]); w.w = cvt_pk_bf16(v1[2], v1[3]);
                    *(u32x4*)(rowp + bj * HALF) = w; } }
    }
};
__device__ __forceinline__ float silu_mul(float g, float u) { return g * __builtin_amdgcn_rcpf(1.f + __expf(-g)) * u; }
typedef float f32x2 __attribute__((ext_vector_type(2)));
__device__ __forceinline__ f32x2 swiglu2(f32x2 g, f32x2 u, float c1, float c3) {
    const f32x2 t = g * c1; f32x2 e; e.x = __builtin_amdgcn_exp2f(t.x); e.y = __builtin_amdgcn_exp2f(t.y);
    const f32x2 d = __builtin_elementwise_fma(e, (f32x2){c3, c3}, (f32x2){c3, c3}); f32x2 r; r.x = __builtin_amdgcn_rcpf(d.x); r.y = __builtin_amdgcn_rcpf(d.y);
    return (g * u) * r; }
template <bool SCALED> struct EpiSwigluT {
    bf16_t* O; int ldc;
    __device__ __forceinline__ void operator()(const f32x4 (&acc)[2][2][4][2], const Unit& u, int wr, int wc, int fr, int fq) const {
        const int row0 = u.pm * BM + wr * 64 + fr, col0 = u.pn * HALF + wc * 32 + 8 * fq;
#pragma unroll
        for (int ai = 0; ai < 2; ++ai)
#pragma unroll
            for (int m = 0; m < 4; ++m) { bf16_t* rowp = O + (size_t)(row0 + ai * HALF + m * 16) * ldc + col0;
                constexpr float SI = SCALED ? 1.f / (F8_SH * F8_SW) : 1.f, C1 = -SI * 1.4426950408889634f, C3 = 1.f / (SI * SI);
                const f32x4 g0 = acc[ai][0][m][0], g1 = acc[ai][0][m][1], u0 = acc[ai][1][m][0], u1 = acc[ai][1][m][1];
                const f32x2 a = swiglu2(g0.xy, u0.xy, C1, C3), b = swiglu2(g0.zw, u0.zw, C1, C3), c = swiglu2(g1.xy, u1.xy, C1, C3), d = swiglu2(g1.zw, u1.zw, C1, C3);
                u32x4 w; w.x = cvt_pk_bf16(a.x, a.y); w.y = cvt_pk_bf16(b.x, b.y); w.z = cvt_pk_bf16(c.x, c.y); w.w = cvt_pk_bf16(d.x, d.y);
                *(u32x4*)rowp = w; }
    }
};
typedef EpiBf16T<false> EpiBf16;
typedef EpiSwigluT<false> EpiSwiglu;
struct EpiBf16OrPart {
    bf16_t* O; int ldc; bf16_t* PART;
    __device__ __forceinline__ void operator()(const f32x4 (&acc)[2][2][4][2], const Unit& u, int wr, int wc, int fr, int fq) const {
        if (u.split < 0) { EpiBf16 e{O, ldc, 1.f}; e(acc, u, wr, wc, fr, fq); return; }
        Unit v = u; v.pm = u.pm / 17;
        EpiBf16 e{PART + (size_t)u.split * (NB * CTX) * D, D, 1.f}; e(acc, v, wr, wc, fr, fq);
    }
};
struct EpiMoeDown {
    bf16_t* Y; bf16_t* PART; float scale;
    __device__ __forceinline__ void operator()(const f32x4 (&acc)[2][2][4][2], const Unit& u, int wr, int wc, int fr, int fq) const {
        if (u.split < 0) { EpiBf16T<true> e{Y, D, scale}; e(acc, u, wr, wc, fr, fq); return; }
        Unit v = u; v.pm = u.pm - MOE_MAIN_TILES;
        EpiBf16T<true> e{PART + (size_t)u.split * (8 * 256) * D, D, scale}; e(acc, v, wr, wc, fr, fq);
    }
};
struct EpiSwigluF8 {
    unsigned char* O; int ldc;
    __device__ __forceinline__ void operator()(const f32x4 (&acc)[2][2][4][2], const Unit& u, int wr, int wc, int fr, int fq) const {
        const int row0 = u.pm * BM + wr * 64 + fr, col0 = u.pn * HALF + wc * 32 + 8 * fq; constexpr float SI = 1.f / (F8_SH * F8_SW);
#pragma unroll
        for (int ai = 0; ai < 2; ++ai)
#pragma unroll
            for (int m = 0; m < 4; ++m) { unsigned char* rowp = O + (size_t)(row0 + ai * HALF + m * 16) * ldc + col0;
                constexpr float C1 = -SI * 1.4426950408889634f, C3 = 1.f / (SI * SI * F8_SA);
                const f32x4 g0 = acc[ai][0][m][0], g1 = acc[ai][0][m][1], u0 = acc[ai][1][m][0], u1 = acc[ai][1][m][1];
                const f32x2 a = swiglu2(g0.xy, u0.xy, C1, C3), b = swiglu2(g0.zw, u0.zw, C1, C3), c = swiglu2(g1.xy, u1.xy, C1, C3), d = swiglu2(g1.zw, u1.zw, C1, C3);
                u32x2 w; w.x = pk4_fp8(a.x, a.y, b.x, b.y); w.y = pk4_fp8(c.x, c.y, d.x, d.y);
                *(u32x2*)rowp = w; }
    }
};
#ifndef GEMM_SP2
#define GEMM_SP2 1
#endif
#ifndef GEMM_ALIGN
#define GEMM_ALIGN 1
#endif
template <bool FP8, bool GATHER = false, class Epi, class Sched>
__device__ __forceinline__ void gemm_phase(LAS unsigned char* lds, const Gemm g, const Sched& S, const Epi& E) {
    const int tid = threadIdx.x, wid = __builtin_amdgcn_readfirstlane(tid >> 6), lane = tid & 63, wr = wid >> 2, wc = wid & 3, fr = lane & 15, fq = lane >> 4;
    const int KB = g.KB;
    unsigned voffA[2], voffB[2];
#pragma unroll
    for (int i = 0; i < 2; ++i) { int R, C; stage_rc(tid * 16 + i * 8192, R, C); const int Rb = (R & ~31) + perm32(R & 31);
        voffA[i] = (unsigned)(R * KB + C * 2); voffB[i] = (unsigned)(Rb * KB + C * 2); }
    const size_t kstep = (size_t)(BK * 2);
    const size_t hstep = (size_t)HALF * KB;
    const size_t tstep = 2 * hstep;
    const unsigned ldsw = (unsigned)wid * 1024u;
    const int aoff = lds_byte(wr * 64 + fr, fq * 8), boff = lds_byte(wc * 32 + fr, fq * 8);
#define PG8_SA(b, h) (((b) * 2 + (h)) * HTB)
#define PG8_SB(b, h) ((4 + (b) * 2 + (h)) * HTB)
#define PG8_STAGE(bufoff, gbase, voff) do { _Pragma("unroll") for (int _i = 0; _i < 2; ++_i) \
        __builtin_amdgcn_global_load_lds((const unsigned*)((const char*)(gbase) + (voff)[_i]), (LAS unsigned*)(lds + (bufoff) + ldsw + _i * 8192), 16, 0, 0); } while (0)
#define PG8_STG(bufoff, kp, vv) do { _Pragma("unroll") for (int _i = 0; _i < 2; ++_i) \
        __builtin_amdgcn_global_load_lds((const unsigned*)((const char*)(kp) + (vv)[_i]), (LAS unsigned*)(lds + (bufoff) + ldsw + _i * 8192), 16, 0, 0); } while (0)
#define PG8_STA_CUR(bufoff, kp, h) do { if (GATHER) PG8_STG(bufoff, kp, gA[h]); else PG8_STAGE(bufoff, (kp) + (h) * hstep, voffA); } while (0)
#define PG8_STA_NX(bufoff, kp, h) do { if (GATHER) { unsigned _v[2] = {last ? nG[h][0] : gA[h][0], last ? nG[h][1] : gA[h][1]}; PG8_STG(bufoff, kp, _v); } else PG8_STAGE(bufoff, (kp) + (h) * hstep, voffA); } while (0)
#define PG8_LDA(dst, b, h) do { _Pragma("unroll") for (int m = 0; m < 4; ++m) { const v4i _l = *(const LAS v4i*)(lds + PG8_SA(b, h) + aoff + m * 2048), _h = *(const LAS v4i*)(lds + PG8_SA(b, h) + aoff + m * 2048 + 1024); \
        dst[m] = __builtin_shufflevector(_l, _h, 0, 1, 2, 3, 4, 5, 6, 7); } } while (0)
#define PG8_LDB(dst, b, h) do { _Pragma("unroll") for (int n = 0; n < 2; ++n) { const v4i _l = *(const LAS v4i*)(lds + PG8_SB(b, h) + boff + n * 2048), _h = *(const LAS v4i*)(lds + PG8_SB(b, h) + boff + n * 2048 + 1024); \
        dst[n] = __builtin_shufflevector(_l, _h, 0, 1, 2, 3, 4, 5, 6, 7); } } while (0)
#define PG8_H(v, k) __builtin_bit_cast(bf16x8, __builtin_shufflevector(v, v, 4 * (k), 4 * (k) + 1, 4 * (k) + 2, 4 * (k) + 3))
#define PG8_MMA(ai, bj, At, Bt) do { __builtin_amdgcn_s_setprio(1); _Pragma("unroll") for (int m = 0; m < 4; ++m) _Pragma("unroll") for (int n = 0; n < 2; ++n) { \
        if (FP8) asm volatile("v_mfma_f32_16x16x128_f8f6f4 %0, %1, %2, %0" : "+v"(acc[ai][bj][m][n]) : "v"(Bt[n]), "v"(At[m])); \
        else { acc[ai][bj][m][n] = __builtin_amdgcn_mfma_f32_16x16x32_bf16(PG8_H(Bt[n], 0), PG8_H(At[m], 0), acc[ai][bj][m][n], 0, 0, 0); \
               acc[ai][bj][m][n] = __builtin_amdgcn_mfma_f32_16x16x32_bf16(PG8_H(Bt[n], 1), PG8_H(At[m], 1), acc[ai][bj][m][n], 0, 0, 0); } } \
        __builtin_amdgcn_s_setprio(0); } while (0)
#define PG8_WAIT_V(n) asm volatile("s_waitcnt vmcnt(" #n ")" ::: "memory")
#define PG8_WAIT_L(n) asm volatile("s_waitcnt lgkmcnt(" #n ")" ::: "memory")
#define PG8_BAR __builtin_amdgcn_s_barrier()
#define PG8_SCHED __builtin_amdgcn_sched_barrier(0)
    Unit cur, nxt; int ui = 0;
    if (!S.next(0, cur)) return;
    f32x4 acc[2][2][4][2];
#pragma unroll
    for (int a = 0; a < 2; ++a)
#pragma unroll
        for (int b = 0; b < 2; ++b)
#pragma unroll
            for (int m = 0; m < 4; ++m)
#pragma unroll
                for (int n = 0; n < 2; ++n) acc[a][b][m][n] = (f32x4){0.f, 0.f, 0.f, 0.f};
    v8i At[4], B0[2], B1[2];
    unsigned gA[2][2], nG[2][2]; int gR[2], gC[2];
#pragma unroll
    for (int i = 0; i < 2; ++i) { stage_rc(tid * 16 + i * 8192, gR[i], gC[i]); gC[i] *= 2; }
    LAS int* gidx = (LAS int*)(lds + 131072 + 2048);
#pragma unroll
    for (int h = 0; h < 2; ++h)
#pragma unroll
        for (int i = 0; i < 2; ++i) { gA[h][i] = GATHER ? (unsigned)(g.idx[cur.pm * 256 + h * 128 + gR[i]] * KB + gC[i]) : 0u; nG[h][i] = 0u; }
    const char* cA = (const char*)g.A + (GATHER ? (size_t)0 : (size_t)cur.pm * tstep) + (size_t)cur.kt0 * kstep; const char* cB = (const char*)g.Bt + cur.boff + (size_t)cur.pn * tstep + (size_t)cur.kt0 * kstep;
    if (GEMM_SP2) {
        PG8_STAGE(PG8_SB(0, 0), cB, voffB); PG8_STAGE(PG8_SB(0, 1), cB + hstep, voffB); PG8_STA_CUR(PG8_SA(0, 0), cA, 0); PG8_STA_CUR(PG8_SA(0, 1), cA, 1);
        if (wr == 1) PG8_BAR;
        PG8_WAIT_V(2); PG8_BAR;
        PG8_STAGE(PG8_SB(1, 0), cB + kstep, voffB); PG8_STA_CUR(PG8_SA(1, 0), cA + kstep, 0); PG8_STAGE(PG8_SB(1, 1), cB + hstep + kstep, voffB);
        PG8_WAIT_V(6); PG8_BAR;
    } else {
    PG8_STAGE(PG8_SB(0, 0), cB, voffB); PG8_STAGE(PG8_SA(0, 0), cA, voffA); PG8_STAGE(PG8_SB(0, 1), cB + hstep, voffB); PG8_STAGE(PG8_SA(0, 1), cA + hstep, voffA);
    if (wr == 1) PG8_BAR;
    PG8_WAIT_V(4); PG8_BAR;
    PG8_STAGE(PG8_SB(1, 0), cB + kstep, voffB); PG8_STAGE(PG8_SA(1, 0), cA + kstep, voffA); PG8_STAGE(PG8_SB(1, 1), cB + hstep + kstep, voffB);
    PG8_WAIT_V(6); PG8_BAR;
    }
    for (;;) {
        const bool has_next = S.next(ui + 1, nxt);
        const char* nA = has_next ? (const char*)g.A + (GATHER ? (size_t)0 : (size_t)nxt.pm * tstep) + (size_t)nxt.kt0 * kstep : cA;
        if (GATHER && has_next) __builtin_amdgcn_global_load_lds((const unsigned*)(g.idx + nxt.pm * 256 + (wid & 3) * 64 + lane), (LAS unsigned*)(gidx + (wid & 3) * 64), 4, 0, 0); const char* nB = has_next ? (const char*)g.Bt + nxt.boff + (size_t)nxt.pn * tstep + (size_t)nxt.kt0 * kstep : cB;
        const int nt = cur.nt;
        for (int t = 0; t < nt; t += 2) {
            const bool last = (t == nt - 2);
            if (GATHER && last && has_next) {
#pragma unroll
                for (int h = 0; h < 2; ++h)
#pragma unroll
                    for (int i = 0; i < 2; ++i) nG[h][i] = (unsigned)(gidx[h * 128 + gR[i]] * KB + gC[i]); }
            const char* a1 = cA + (size_t)(t + 1) * kstep;
            const char* a2 = last ? nA : cA + (size_t)(t + 2) * kstep; const char* b2 = last ? nB : cB + (size_t)(t + 2) * kstep;
            const char* a3 = a2 + kstep; const char* b3 = b2 + kstep;
            if (GEMM_SP2) {
            PG8_LDB(B0, 0, 0); PG8_LDB(B1, 0, 1); PG8_SCHED; PG8_LDA(At, 0, 0); PG8_STA_CUR(PG8_SA(1, 1), a1, 1);
            PG8_WAIT_V(8); PG8_WAIT_L(0); PG8_BAR; PG8_MMA(0, 0, At, B0); PG8_MMA(0, 1, At, B1); PG8_BAR; PG8_SCHED;
            PG8_LDA(At, 0, 1); PG8_STAGE(PG8_SB(0, 0), b2, voffB); PG8_STAGE(PG8_SB(0, 1), b2 + hstep, voffB); PG8_STA_NX(PG8_SA(0, 0), a2, 0);
            PG8_WAIT_V(8); PG8_WAIT_L(0); PG8_BAR; PG8_MMA(1, 0, At, B0); PG8_MMA(1, 1, At, B1); PG8_BAR; PG8_SCHED;
            PG8_LDB(B0, 1, 0); PG8_LDB(B1, 1, 1); PG8_SCHED; PG8_LDA(At, 1, 0); PG8_STA_NX(PG8_SA(0, 1), a2, 1);
            PG8_WAIT_V(8); PG8_WAIT_L(0); PG8_BAR; PG8_MMA(0, 0, At, B0); PG8_MMA(0, 1, At, B1); PG8_BAR; PG8_SCHED;
            PG8_LDA(At, 1, 1); PG8_STAGE(PG8_SB(1, 0), b3, voffB); PG8_STAGE(PG8_SB(1, 1), b3 + hstep, voffB); PG8_STA_NX(PG8_SA(1, 0), a3, 0);
            PG8_WAIT_V(8); PG8_WAIT_L(0); PG8_BAR; PG8_MMA(1, 0, At, B0); PG8_MMA(1, 1, At, B1); PG8_BAR; PG8_SCHED;
            } else {
            PG8_LDB(B0, 0, 0); PG8_SCHED; PG8_LDA(At, 0, 0); PG8_STAGE(PG8_SA(1, 1), a1 + hstep, voffA);
            PG8_WAIT_L(8); PG8_BAR; PG8_WAIT_L(0); PG8_MMA(0, 0, At, B0); PG8_BAR; PG8_SCHED;
            PG8_LDB(B1, 0, 1); PG8_STAGE(PG8_SB(0, 0), b2, voffB);
            PG8_BAR; PG8_WAIT_L(0); PG8_MMA(0, 1, At, B1); PG8_BAR;
            PG8_LDA(At, 0, 1); PG8_STAGE(PG8_SA(0, 0), a2, voffA);
            PG8_BAR; PG8_WAIT_L(0); PG8_MMA(1, 0, At, B0); PG8_BAR; PG8_SCHED;
            PG8_STAGE(PG8_SB(0, 1), b2 + hstep, voffB);
            PG8_WAIT_V(6); PG8_BAR; PG8_MMA(1, 1, At, B1); PG8_BAR;
            PG8_LDB(B0, 1, 0); PG8_SCHED; PG8_LDA(At, 1, 0); PG8_STAGE(PG8_SA(0, 1), a2 + hstep, voffA);
            PG8_WAIT_L(8); PG8_BAR; PG8_WAIT_L(0); PG8_MMA(0, 0, At, B0); PG8_BAR; PG8_SCHED;
            PG8_LDB(B1, 1, 1); PG8_STAGE(PG8_SB(1, 0), b3, voffB);
            PG8_BAR; PG8_WAIT_L(0); PG8_MMA(0, 1, At, B1); PG8_BAR;
            PG8_LDA(At, 1, 1); PG8_STAGE(PG8_SA(1, 0), a3, voffA);
            PG8_BAR; PG8_WAIT_L(0); PG8_MMA(1, 0, At, B0); PG8_BAR; PG8_SCHED;
            PG8_STAGE(PG8_SB(1, 1), b3 + hstep, voffB);
            PG8_WAIT_V(6); PG8_BAR; PG8_MMA(1, 1, At, B1); PG8_BAR;
            }
        }
        if (GEMM_ALIGN) { if (wr == 0) PG8_BAR; }
        if (FP8) asm volatile("s_nop 15\n\ts_nop 15" ::: "memory");
        E(acc, cur, wr, wc, fr, fq);
        if (!has_next) break;
#pragma unroll
        for (int a = 0; a < 2; ++a)
#pragma unroll
            for (int b = 0; b < 2; ++b)
#pragma unroll
                for (int m = 0; m < 4; ++m)
#pragma unroll
                    for (int n = 0; n < 2; ++n) acc[a][b][m][n] = (f32x4){0.f, 0.f, 0.f, 0.f};
        cur = nxt; cA = nA; cB = nB; ++ui;
        if (GATHER) {
#pragma unroll
            for (int h = 0; h < 2; ++h)
#pragma unroll
                for (int i = 0; i < 2; ++i) gA[h][i] = nG[h][i]; }
        if (GEMM_ALIGN) { if (wr == 1) PG8_BAR; }
    }
    PG8_WAIT_V(0);
    if (!GEMM_ALIGN) { if (wr == 0) PG8_BAR; }
    PG8_BAR;
#undef PG8_SA
#undef PG8_SB
#undef PG8_STAGE
#undef PG8_STG
#undef PG8_STA_CUR
#undef PG8_STA_NX
#undef PG8_LDA
#undef PG8_LDB
#undef PG8_MMA
#undef PG8_H
#undef PG8_WAIT_V
#undef PG8_WAIT_L
#undef PG8_BAR
#undef PG8_SCHED
}
}

template <int L> __device__ __forceinline__ void phase_attn(ArgsP a, LAS unsigned char* lds, int gw, int ngw, int wave, int lane) {
    const bf16_t* QKV = (const bf16_t*)(a->ws + WS_QKV); bf16_t* ATT = (bf16_t*)(a->ws + WS_ATT);
    const float lambda_init = L == 0 ? 0.2f : 0.8f - 0.6f * 0.74081822068171786607f;
    {
      const float L2T = 13.287712379549449f; LAS f32x2* tg = (LAS f32x2*)(lds + 73728); LAS f32x2* td = tg + 64 * 32;
      for (int i = threadIdx.x; i < 64 * 32 + 64 * 16; i += NTHREADS) { float s_, c_;
        if (i < 64 * 32) { sincosf((float)(i >> 5) * exp2f(-(float)(i & 31) * (1.f / 32.f) * L2T), &s_, &c_); tg[i] = (f32x2){c_, s_}; }
        else { const int q_ = i - 64 * 32; sincosf((float)(q_ >> 4) * exp2f(-(float)(q_ & 15) * (1.f / 16.f) * L2T), &s_, &c_); td[q_] = (f32x2){c_, s_}; } }
      __syncthreads(); }
    {
    constexpr int REP2 = ((PROBE_DUP >> 2) & 1) + 1, NUQ = 512 + (L == 0 ? 48 : 0);
    for (int uu = blockIdx.x; uu < NUQ * REP2; uu += gridDim.x) { const int u = REP2 == 1 ? uu : uu % NUQ;
        int seq; size_t qrow, krow; int qcol, kcol, vcol, ocol, qproc = 0, trow0 = 0;
        if (u < 512) { const int grp = u & 7, idx = u >> 3, b = grp >> 1, hq = (grp & 1) * 4 + (idx & 3), kvh = hq >> 2; seq = TPB; qrow = (size_t)b * TPB + (idx >> 2) * 256; krow = (size_t)b * TPB; qproc = 2; trow0 = (idx >> 2) * 256;
            qcol = 1536 + hq * 128; kcol = 2560 + kvh * 128; vcol = 2816 + kvh * 128; ocol = 512 + hq * 128; }
        else if (u < 544) { const int v = u - 512, b = v >> 3, hq = v & 7, kvh = hq >> 2; seq = CTX; qrow = (size_t)b * TPB + SEQ; krow = qrow; qproc = 1;
            qcol = 1536 + hq * 128; kcol = 2560 + kvh * 128; vcol = 2816 + kvh * 128; ocol = 512 + hq * 128; }
        else { const int v = u - 544, b = v >> 2, h = v & 3; seq = CTX; qrow = (size_t)b * TPB + SEQ; krow = qrow; qcol = h * 128; kcol = 512 + h * 128; vcol = 1024 + h * 128; ocol = h * 128; }
        att::attn_body<0>(QKV + qrow * INW + qcol, QKV + krow * INW + kcol, QKV + krow * INW + vcol, ATT + qrow * D + ocol, seq, lds, 0.f, 0.f, nullptr, 0, 0, qproc, a->in[I_QNORM] + L * 128, trow0);
    }
    float lam;
    { const int ln = threadIdx.x & 63; const float d1 = wave_sum(a->in[I_LQ1][L * 64 + ln] * a->in[I_LK1][L * 64 + ln]), d2 = wave_sum(a->in[I_LQ2][L * 64 + ln] * a->in[I_LK2][L * 64 + ln]); lam = __expf(d1) - __expf(d2) + lambda_init; lam = __int_as_float(__builtin_amdgcn_readfirstlane(__float_as_int(lam))); }
    constexpr int NUD = 512 + (L == 0 ? 64 : 0);
    for (int uu = blockIdx.x; uu < NUD * REP2; uu += gridDim.x) { const int u = REP2 == 1 ? uu : uu % NUD;
        int seq; size_t qrow, krow; int h, qproc = 0, trow0 = 0;
        if (u < 512) { const int idx = u >> 3, grp = (u & 7) + 8 * (idx >> 5), b = grp >> 2; h = grp & 3; seq = TPB; qrow = (size_t)b * TPB + (idx & 31) * 128; krow = (size_t)b * TPB; qproc = 2; trow0 = (idx & 31) * 128; }
        else { const int v = u - 544; if (v < 0) continue; const int b = v >> 3; h = (v >> 1) & 3; seq = CTX; krow = (size_t)b * TPB + SEQ; qrow = krow + (v & 1) * 128; }
        att::attn_body<1>(QKV + qrow * INW + 3072 + h * 128, QKV + krow * INW + 3584 + h * 128, QKV + krow * INW + 4096 + h * 128, ATT + qrow * D + 1536 + h * 128, seq, lds, lam, 1.f - lambda_init, a->in[I_SUBLN] + L * 128, 0, 0, qproc, nullptr, trow0);
    }
    constexpr int REP3 = ((PROBE_DUP >> 3) & 1) + 1;
    for (int uu = blockIdx.x; uu < 256 * REP3; uu += gridDim.x) { const int u = uu & 255;
        const int grp = u & 15, b = grp >> 2, h = grp & 3, r0 = (u >> 4) * 4, R0 = min(max(r0 - 4, 0), 52);
        const size_t qrow = (size_t)b * TPB + r0 * 64, krow = (size_t)b * TPB;
        att::attn_body<2>(QKV + qrow * INW + h * 128, QKV + krow * INW + 512 + h * 128, QKV + krow * INW + 1024 + h * 128, ATT + qrow * D + h * 128, 1024, lds, 0.f, 0.f, a->in[I_RPB] + (size_t)(L * 4 + h) * 465, r0, R0);
    }
    }
    __syncthreads();
}

template <int L> __device__ __forceinline__ void layer_program(LAS unsigned char* lds, const XcdBarrier& bar, int lo, int hi) {
    constexpr int P = 2 + 9 * L; const int G = gridDim.x, cid = blockIdx.x;
#define PHASE_IDS const int tid = fresh_tid(), lane = tid & 63, wave = __builtin_amdgcn_readfirstlane(tid >> 6), gw = blockIdx.x * NWAVES + wave, ngw = gridDim.x * NWAVES; (void)lane; (void)gw; (void)ngw
#define IN(k) (lo <= (k) && (k) < hi)
#define SEAM(k) do { if (IN(k) && IN((k) + 1)) xcd_barrier(bar); STAMP((k) + 1); } while (0)
    if (IN(P + 0)) DUP(1) { ArgsP a = get_args(); unsigned char* ws = a->ws;
        pg8::Gemm g{ws + WS_H, (const bf16_t*)(ws + WS_WIN) + (size_t)L * INW * D, 2 * D}; pg8::StaticOrder<false> S; S.init(NR / 256, INW / 256, G, cid, D / 64);
        pg8::EpiBf16 E{(bf16_t*)(ws + WS_QKV), INW, 1.f}; pg8::gemm_phase<false>(lds, g, S, E); }
    SEAM(P + 0);
    if (IN(P + 1)) { ArgsP a = get_args(); PHASE_IDS; phase_qkpost<L>(a, lds, gw, ngw, tid, lane); }
    SEAM(P + 1);
    if (IN(P + 2)) { ArgsP a = get_args(); PHASE_IDS; phase_attn<L>(a, lds, gw, ngw, wave, lane); }
    SEAM(P + 2);
    if (IN(P + 3)) DUP(4) { ArgsP a = get_args(); unsigned char* ws = a->ws;
        pg8::Gemm g{ws + WS_ATT, (const bf16_t*)(ws + WS_WOUT) + (size_t)L * D * D, 2 * D};
        if (L == 0) { pg8::EpiBf16OrPart E{(bf16_t*)(ws + WS_O), D, (bf16_t*)(ws + WS_PART_A)}; pg8::SplitCtxOrder S; S.init(G, cid, D / 64); pg8::gemm_phase<false>(lds, g, S, E); }
        else { pg8::EpiBf16 E{(bf16_t*)(ws + WS_O), D, 1.f}; pg8::StaticOrder<true> S; S.init(NTOK / 256, D / 256, G, cid, D / 64); pg8::gemm_phase<false>(lds, g, S, E); } }
    SEAM(P + 3);
    if (IN(P + 4)) { ArgsP a = get_args(); PHASE_IDS; phase_row_mid<L>(a, lds, gw, ngw, tid, lane); }
    SEAM(P + 4);
    if (IN(P + 5)) { if (L == 1) { ArgsP a = get_args(); PHASE_IDS; phase_moe_slots(a, lds, gw, ngw, tid, lane); } }
    if (L == 1) SEAM(P + 5); else STAMP(P + 6);
    if (IN(P + 6)) DUP(5) { ArgsP a = get_args(); unsigned char* ws = a->ws;
        if (L == 0 && FP8_UP0) { pg8::EpiSwigluT<true> E{(bf16_t*)(ws + WS_ACT), DFF}; pg8::Gemm g{ws + WS_H8, ws + WS_W13, D}; pg8::StaticOrder<false> S; S.init(NR / 256, 2 * DFF / 256, G, cid, D / 128); pg8::gemm_phase<true>(lds, g, S, E); }
        else if (L == 0) { pg8::EpiSwiglu E{(bf16_t*)(ws + WS_ACT), DFF}; pg8::Gemm g{ws + WS_H, ws + WS_W13, 2 * D}; pg8::StaticOrder<false> S; S.init(NR / 256, 2 * DFF / 256, G, cid, D / 64); pg8::gemm_phase<false>(lds, g, S, E); }
        else { LAS int* toff = moe_offsets(a, lds, fresh_tid()); pg8::EpiSwigluF8 E{ws + WS_ACT, DFF}; pg8::Gemm g{ws + WS_H8, ws + WS_MW13, D, (const int*)(ws + WS_IDX)}; pg8::MoeOrder S; S.init(toff, 2 * DFF / 256, G, cid, (size_t)2 * DFF * D, D / 128); pg8::gemm_phase<true, true>(lds, g, S, E); }
    }
    SEAM(P + 6);
    if (IN(P + 7)) DUP(6) { ArgsP a = get_args(); unsigned char* ws = a->ws;
        if (L == 0) { pg8::EpiBf16OrPart E{(bf16_t*)(ws + WS_Y), D, (bf16_t*)(ws + WS_PART_B)}; pg8::Gemm g{ws + WS_ACT, ws + WS_W2, 2 * DFF}; pg8::SplitCtxOrder S; S.init(G, cid, DFF / 64); pg8::gemm_phase<false>(lds, g, S, E); }
        else { LAS int* toff = moe_offsets(a, lds, fresh_tid()); pg8::EpiMoeDown E{(bf16_t*)(ws + WS_Y), (bf16_t*)(ws + WS_PART_M), 1.f / (F8_SA * F8_SW)}; pg8::Gemm g{ws + WS_ACT, ws + WS_MW2, DFF}; pg8::MoeOrderT<true> S; S.init(toff, D / 256, G, cid, (size_t)D * DFF, DFF / 128); pg8::gemm_phase<true>(lds, g, S, E); }
    }
    SEAM(P + 7);
    if (IN(P + 8)) { ArgsP a = get_args(); PHASE_IDS; phase_row_end<L>(a, gw, ngw, lane); }
    if (L == 0) SEAM(P + 8);
#undef IN
#undef SEAM
}
constexpr int NPHASE = 20;


__global__ void __launch_bounds__(NTHREADS, 2) fwd_kernel(Args kargs_unused) {
    extern __shared__ __attribute__((aligned(16))) unsigned char lds_raw[];
    LAS unsigned char* lds = (LAS unsigned char*)lds_raw;
    volatile LAS unsigned* xbw = (volatile LAS unsigned*)(lds + LDS_BYTES - 16);
    { const int t0 = fresh_tid(); if (t0 < 4) xbw[t0] = 0u; }
    __syncthreads();
    STAMP(0); const unsigned long long probe_c0 = PROBE_STAMP == 100 ? (unsigned long long)clock64() : 0ull;
    int lo, hi; XcdBarrier bar;
    { ArgsP a = get_args(); lo = a->lo; hi = a->hi; bar.bar = (unsigned*)(a->ws + WS_CTL) + CW_BAR; bar.x = 0; bar.st = xbw;
      if (hi - lo > 1) bar = xcd_barrier_post((unsigned*)(a->ws + WS_CTL) + CW_BAR, xbw); }
#define IN(k) (lo <= (k) && (k) < hi)
    { const int tid = fresh_tid(), lane = tid & 63, wave = __builtin_amdgcn_readfirstlane(tid >> 6), gw = blockIdx.x * NWAVES + wave, ngw = gridDim.x * NWAVES;
      if (IN(0)) DUP(0) { ArgsP a = get_args(); phase_adaln(a, lds, tid, wave, lane); phase_convert(a, lds, gw, ngw, wave, lane); __syncthreads(); }
      if (IN(0) && IN(1)) xcd_barrier(bar);
      STAMP(1);
      if (IN(1)) { ArgsP a = get_args(); phase_row_entry(a, gw, ngw, lane); }
      if (IN(1) && IN(2)) xcd_barrier(bar);
      STAMP(2); }
#undef IN
    layer_program<0>(lds, bar, lo, hi);
    layer_program<1>(lds, bar, lo, hi);
    if (PROBE_STAMP >= 0 && blockIdx.x == 0 && threadIdx.x == 0) {
        STAMP(NPHASE);
        volatile LAS unsigned long long* st = (volatile LAS unsigned long long*)(lds + 131072 + 1024);
        const unsigned long long d = PROBE_STAMP == 100 ? ((unsigned long long)clock64() - probe_c0) / 20ull : (PROBE_STAMP >= 200 ? (st[32 + PROBE_STAMP - 200 + 1] - st[32 + PROBE_STAMP - 200]) / 20ull : st[PROBE_STAMP + 1] - st[PROBE_STAMP]);
        const unsigned long long t0 = (unsigned long long)wall_clock64();
        while ((unsigned long long)wall_clock64() - t0 < d) __builtin_amdgcn_s_sleep(10);
    }
}

#ifndef MK_PER_PHASE
#define MK_PER_PHASE 0
#endif
extern "C" void kernel_launch(void* const* d_in, const int* in_sizes, int n_in, void* d_out, int out_size, void* d_ws, size_t ws_size, hipStream_t stream) {
    static int grid = 0;
    if (grid == 0) {
        if (n_in != 27 || out_size != NB * SEQ * D || ws_size < WS_H8 + (size_t)NR * D) { fprintf(stderr, "kernel_launch: unexpected shapes: n_in %d out %d ws %zu (need %zu)\n", n_in, out_size, ws_size, (size_t)WS_END); grid = -1; return; }
        int dev = 0, cus = 0, per_cu = 0;
        if (hipGetDevice(&dev) != hipSuccess || hipDeviceGetAttribute(&cus, hipDeviceAttributeMultiprocessorCount, dev) != hipSuccess) { grid = -1; return; }
        if (hipFuncSetAttribute((const void*)fwd_kernel, hipFuncAttributeMaxDynamicSharedMemorySize, LDS_BYTES) != hipSuccess) { fprintf(stderr, "kernel_launch: hipFuncSetAttribute failed\n"); grid = -1; return; }
        if (hipOccupancyMaxActiveBlocksPerMultiprocessor(&per_cu, (const void*)fwd_kernel, NTHREADS, LDS_BYTES) != hipSuccess || per_cu < 1) fprintf(stderr, "kernel_launch: occupancy query says %d\n", per_cu);
        (void)hipGetLastError();
        grid = cus;
    }
    if (grid < 0) return;
    (void)hipMemsetAsync((char*)d_ws + WS_CTL, 0, CTL_ZERO_BYTES, stream);
    Args a{};
    for (int i = 0; i < 27; ++i) a.in[i] = (const float*)d_in[i];
    a.out = (float*)d_out; a.ws = (unsigned char*)d_ws;
#if MK_PER_PHASE
    for (int p = 0; p < NPHASE; ++p) { if (p == 7) continue; a.lo = p; a.hi = p + 1; hipLaunchKernelGGL(fwd_kernel, dim3(grid), dim3(NTHREADS), LDS_BYTES, stream, a); }
#else
    a.lo = 0; a.hi = NPHASE; hipLaunchKernelGGL(fwd_kernel, dim3(grid), dim3(NTHREADS), LDS_BYTES, stream, a);
#endif
}
```

```cpp
#include <hip/hip_runtime.h>
#include <stdint.h>
#include <stdio.h>

#define GAS __attribute__((address_space(1)))
#define LAS __attribute__((address_space(3)))
typedef unsigned short bf16_t;
typedef short bf16x8 __attribute__((ext_vector_type(8)));
typedef float f32x4 __attribute__((ext_vector_type(4)));
typedef float f32x2 __attribute__((ext_vector_type(2)));
typedef unsigned u32x4 __attribute__((ext_vector_type(4)));
typedef unsigned u32x2 __attribute__((ext_vector_type(2)));

#ifndef PROBE_DUP
#define PROBE_DUP 0
#endif
#define DUP(bit) for (int _rep = 0; _rep < (((PROBE_DUP) >> (bit)) & 1) + 1; ++_rep)
#ifndef PROBE_STAMP
#define PROBE_STAMP -1
#endif
#define STAMP(i) do { if (PROBE_STAMP >= 0 && blockIdx.x == 0 && threadIdx.x == 0) { ((volatile LAS unsigned long long*)(lds + 131072 + 1024))[i] = (unsigned long long)wall_clock64(); ((volatile LAS unsigned long long*)(lds + 131072 + 1024))[32 + (i)] = (unsigned long long)clock64(); } } while (0)
constexpr int D = 2048, NB = 4, SEQ = 4096, CTX = 256, TPB = SEQ + CTX, NR = NB * TPB;
constexpr int INW = 4608, DFF = 5632, NE = 8, MODW = 6 * D, NTOK = NB * SEQ;
constexpr int MAXSLOT = 34816;
constexpr float EPS = 1e-6f;
constexpr int NWAVES = 8, NTHREADS = 512;
constexpr int LDS_BYTES = 147456;

constexpr size_t MiB = 1u << 20;
constexpr size_t WS_CTL = 0, CTL_ZERO_BYTES = 128 * 1024;
constexpr size_t WS_MOD = 1 * MiB;
constexpr size_t WS_TOPK = 2 * MiB;
constexpr size_t WS_SLOT = WS_TOPK + 512 * 1024;
constexpr size_t WS_RS = 3 * MiB + 512 * 1024;
constexpr size_t WS_IDX = 3 * MiB;
constexpr size_t WS_WIN = 4 * MiB;
constexpr size_t WS_WOUT = 40 * MiB;
constexpr size_t WS_W13 = 56 * MiB;
constexpr size_t WS_W2 = 100 * MiB;
constexpr size_t WS_MW13 = 122 * MiB;
constexpr size_t WS_MW2 = 474 * MiB;
constexpr size_t WS_X = 650 * MiB;
constexpr size_t WS_H = 786 * MiB;
constexpr size_t WS_Y = 854 * MiB;
constexpr size_t WS_HG = WS_Y;
constexpr size_t WS_R1 = 990 * MiB;
constexpr size_t WS_QKV = WS_R1, WS_VT = WS_R1 + 153 * MiB, WS_ATT = WS_R1 + 170 * MiB, WS_O = WS_R1 + 238 * MiB, WS_ACT = WS_R1;
constexpr size_t WS_END = WS_R1 + (size_t)MAXSLOT * DFF * 2;
constexpr size_t WS_H8 = WS_END;
constexpr size_t WS_ATT8 = WS_QKV + 64 * MiB;
constexpr size_t WS_PART_A = WS_QKV;
constexpr size_t WS_PART_M = WS_R1 + 256 * MiB;
constexpr size_t WS_PART_B = WS_Y + 68 * MiB;
static_assert((size_t)NR * INW * 2 <= 153 * MiB && (size_t)16 * 128 * TPB * 2 <= 17 * MiB && (size_t)NR * D * 2 <= 68 * MiB, "R1 map");
constexpr int CW_BAR = 4096;
constexpr int CW_CNT = 16384;
constexpr int CW_CUR = 16384 + 64;

__device__ __forceinline__ unsigned cvt_pk_bf16(float lo, float hi) { unsigned r; asm("v_cvt_pk_bf16_f32 %0, %1, %2" : "=v"(r) : "v"(lo), "v"(hi)); return r; }
__device__ __forceinline__ float bf_lo(unsigned w) { return __uint_as_float(w << 16); }
__device__ __forceinline__ float bf_hi(unsigned w) { return __uint_as_float(w & 0xffff0000u); }
__device__ __forceinline__ float bf2f(bf16_t b) { return __uint_as_float(((unsigned)b) << 16); }
__device__ __forceinline__ bf16_t f2bf(float f) { return (bf16_t)(cvt_pk_bf16(f, 0.f) & 0xffffu); }
__device__ __forceinline__ float wave_sum(float v) {
#pragma unroll
    for (int o = 1; o < 64; o <<= 1) v += __shfl_xor(v, o);
    return v;
}
__device__ __forceinline__ float wave_max(float v) {
#pragma unroll
    for (int o = 1; o < 64; o <<= 1) v = fmaxf(v, __shfl_xor(v, o));
    return v;
}
#define LDS_WAIT() asm volatile("s_waitcnt lgkmcnt(0)" ::: "memory")
__device__ __forceinline__ unsigned pk4_fp8(float a, float b, float c, float d) {
    a = fminf(fmaxf(a, -448.f), 448.f); b = fminf(fmaxf(b, -448.f), 448.f); c = fminf(fmaxf(c, -448.f), 448.f); d = fminf(fmaxf(d, -448.f), 448.f);
    int w = 0; w = __builtin_amdgcn_cvt_pk_fp8_f32(a, b, w, false); w = __builtin_amdgcn_cvt_pk_fp8_f32(c, d, w, true); return (unsigned)w; }
#ifndef FP8_UP0
#define FP8_UP0 1
#endif
#ifndef INT8_UP
#define INT8_UP 1
#endif
__device__ __forceinline__ unsigned pk4_i8s(float a, float b, float c, float d, float S) {
    constexpr float M = 12582912.f;
    const float fa = __builtin_amdgcn_fmed3f(fmaf(a, S, M), M - 127.f, M + 127.f), fb = __builtin_amdgcn_fmed3f(fmaf(b, S, M), M - 127.f, M + 127.f);
    const float fc = __builtin_amdgcn_fmed3f(fmaf(c, S, M), M - 127.f, M + 127.f), fd = __builtin_amdgcn_fmed3f(fmaf(d, S, M), M - 127.f, M + 127.f);
    const unsigned p01 = __builtin_amdgcn_perm(__float_as_uint(fb), __float_as_uint(fa), 0x0c0c0400u), p23 = __builtin_amdgcn_perm(__float_as_uint(fd), __float_as_uint(fc), 0x0c0c0400u);
    return __builtin_amdgcn_perm(p23, p01, 0x05040100u); }
constexpr float I8_SH = 16.f, I8_SW = 1024.f;
#ifndef INT8_OUT
#define INT8_OUT 1
#endif
#ifndef INT8_QKV
#define INT8_QKV 1
#endif
#ifndef FP8_DOWN0
#define FP8_DOWN0 1
#endif
constexpr float F8_SW = 64.f, F8_SH = 16.f, F8_SA = 8.f;

#define XB_TMO      128
#define XB_XCNT(j)  (256  + 64 * (j))
#define XB_XSUB(j)  (1280 + 64 * (j))
#define XB_XGEN(j)  (2304 + 64 * (j))
#define XB_TOP      3328
#define XB_TOPGEN   3392
#define XCD_BAR_WORDS 3456
#define XB_SPIN_CAP (1u << 18)
__device__ __forceinline__ unsigned xb_ld(unsigned* p)              { return __hip_atomic_load(p, __ATOMIC_RELAXED, __HIP_MEMORY_SCOPE_AGENT); }
__device__ __forceinline__ unsigned xb_add(unsigned* p, unsigned v) { return __hip_atomic_fetch_add(p, v, __ATOMIC_RELAXED, __HIP_MEMORY_SCOPE_AGENT); }
__device__ __forceinline__ unsigned xb_xcc_id() { return (unsigned)__builtin_amdgcn_s_getreg((3 << 11) | 20) & 0xFu; }
#define XB_SPIN(cond, bar) do { unsigned _sp = 0; while (cond) { __builtin_amdgcn_s_sleep(1); \
    if ((++_sp & 255u) == 0u) { if (xb_ld(&(bar)[XB_TMO])) break; if (_sp > XB_SPIN_CAP) { atomicAdd(&(bar)[XB_TMO], 1u); break; } } } } while (0)
struct XcdBarrier { unsigned* bar; unsigned x; volatile LAS unsigned* st; };
__device__ __forceinline__ XcdBarrier xcd_barrier_post(unsigned* bar, volatile LAS unsigned* st) {
    XcdBarrier b; b.bar = bar; b.x = xb_xcc_id(); b.st = st;
    if (threadIdx.x == 0) (void)xb_add(&bar[XB_XCNT(b.x)], 1u);
    return b;
}
__device__ __forceinline__ void xcd_barrier_complete(unsigned* bar, unsigned x, unsigned& nloc, unsigned& nx) {
    const unsigned G = gridDim.x * gridDim.y * gridDim.z;
    unsigned sum, cnt, mine, sp = 0u;
    for (;;) {
        sum = 0u; cnt = 0u; mine = 0u;
#pragma unroll
        for (unsigned j = 0; j < 16; ++j) { const unsigned c = xb_ld(&bar[XB_XCNT(j)]); sum += c; cnt += (c > 0u) ? 1u : 0u; mine = (j == x) ? c : mine; }
        if (sum == G) break;
        __builtin_amdgcn_s_sleep(1);
        if ((++sp & 255u) == 0u) { if (xb_ld(&bar[XB_TMO])) break; if (sp > XB_SPIN_CAP) { atomicAdd(&bar[XB_TMO], 1u); break; } }
    }
    nloc = mine > 0u ? mine : 1u; nx = cnt > 0u ? cnt : 1u;
}
__device__ __forceinline__ void xcd_barrier(const XcdBarrier& b) {
    asm volatile("s_waitcnt vmcnt(0)" ::: "memory");
    __syncthreads();
    if (threadIdx.x == 0) {
        unsigned* bar = b.bar;
        __builtin_amdgcn_s_waitcnt(0);
        unsigned nloc = b.st[0], nx = b.st[1];
        if (nloc == 0u) { xcd_barrier_complete(bar, b.x, nloc, nx); b.st[0] = nloc; b.st[1] = nx; }
        const unsigned old = xb_add(&bar[XB_XSUB(b.x)], 1u);
        const unsigned gen = old / nloc;
        if (old + 1u == (gen + 1u) * nloc) {
            __builtin_amdgcn_fence(__ATOMIC_RELEASE, "agent");
            asm volatile("s_waitcnt vmcnt(0)" ::: "memory");
            const unsigned og = xb_add(&bar[XB_TOP], 1u);
            const unsigned tg = og / nx;
            if (og + 1u == (tg + 1u) * nx) xb_add(&bar[XB_TOPGEN], 1u);
            else XB_SPIN(xb_ld(&bar[XB_TOPGEN]) == tg, bar);
            __builtin_amdgcn_fence(__ATOMIC_ACQUIRE, "agent");
            xb_add(&bar[XB_XGEN(b.x)], 1u);
            asm volatile("s_waitcnt vmcnt(0)" ::: "memory");
        } else {
            XB_SPIN(xb_ld(&bar[XB_XGEN(b.x)]) == gen, bar);
            __builtin_amdgcn_fence(__ATOMIC_ACQUIRE, "agent");
            asm volatile("s_waitcnt vmcnt(0)" ::: "memory");
        }
    }
    __syncthreads();
}

struct Args { const float* in[27]; float* out; unsigned char* ws; int lo, hi; };
typedef const __attribute__((address_space(4))) Args* ArgsP;
__device__ __forceinline__ int fresh_tid() { int t = threadIdx.x; asm volatile("" : "+v"(t)); return t; }
__device__ __forceinline__ ArgsP get_args() { ArgsP p = (ArgsP)__builtin_amdgcn_kernarg_segment_ptr(); asm volatile("" : "+s"(p)); return p; }
enum { I_X = 0, I_C, I_CTX, I_CCTX, I_WMOD, I_BMOD, I_GMIXPRE, I_GMIXPOST, I_GFFNPRE, I_GFFNPOST, I_WIN, I_WOUT, I_RPB, I_QNORM, I_KNORM,
       I_LQ1, I_LK1, I_LQ2, I_LK2, I_SUBLN, I_FW1, I_FW3, I_FW2, I_ROUTER, I_MW1, I_MW3, I_MW2 };

__device__ __forceinline__ void transpose_item(const float* W, int K, int N, bf16_t* WT, int item, int mode, LAS float* scr, int lane) {
    const int nblk = N / 32, kb = item / nblk, nb = item % nblk, k0 = 64 * kb, n0 = 32 * nb;
#pragma unroll 8
    for (int i = 0; i < 32; ++i) { const int kk = 2 * i + (lane >> 5); scr[kk * 33 + (lane & 31)] = W[(size_t)(k0 + kk) * N + n0 + (lane & 31)]; }
    LDS_WAIT(); asm volatile("" ::: "memory");
    const int c = lane & 7;
    const int drow0 = mode == 0 ? n0 : (256 * (n0 >> 7) + (n0 & 127) + (mode == 2 ? 128 : 0));
#pragma unroll
    for (int j = 0; j < 4; ++j) { const int n = (lane >> 3) + 8 * j; const LAS float* s = scr + (8 * c) * 33 + n;
        u32x4 o; o.x = cvt_pk_bf16(s[0 * 33], s[1 * 33]); o.y = cvt_pk_bf16(s[2 * 33], s[3 * 33]); o.z = cvt_pk_bf16(s[4 * 33], s[5 * 33]); o.w = cvt_pk_bf16(s[6 * 33], s[7 * 33]);
        *(u32x4*)(WT + (size_t)(drow0 + n) * K + k0 + 8 * c) = o; }
    LDS_WAIT(); asm volatile("" ::: "memory");
}
__device__ __forceinline__ void transpose_item_f8(const float* W, int K, int N, unsigned char* WT, int item, int mode, LAS float* scr, int lane) {
    const int nblk = N / 32, kb = item / nblk, nb = item % nblk, k0 = 64 * kb, n0 = 32 * nb;
#pragma unroll 8
    for (int i = 0; i < 32; ++i) { const int kk = 2 * i + (lane >> 5); scr[kk * 33 + (lane & 31)] = W[(size_t)(k0 + kk) * N + n0 + (lane & 31)]; }
    LDS_WAIT(); asm volatile("" ::: "memory");
    const int c = lane & 7;
    const int drow0 = mode == 0 ? n0 : (256 * (n0 >> 7) + (n0 & 127) + (mode == 2 ? 128 : 0));
#pragma unroll
    for (int j = 0; j < 4; ++j) { const int n = (lane >> 3) + 8 * j; const LAS float* s = scr + (8 * c) * 33 + n;
        u32x2 o; o.x = pk4_fp8(s[0 * 33] * F8_SW, s[1 * 33] * F8_SW, s[2 * 33] * F8_SW, s[3 * 33] * F8_SW); o.y = pk4_fp8(s[4 * 33] * F8_SW, s[5 * 33] * F8_SW, s[6 * 33] * F8_SW, s[7 * 33] * F8_SW);
        *(u32x2*)(WT + (size_t)(drow0 + n) * K + k0 + 8 * c) = o; }
    LDS_WAIT(); asm volatile("" ::: "memory");
}
struct CvtItem { const float* src; unsigned char* dst; int N, K, f8; };
__device__ __forceinline__ CvtItem cvt_decode(ArgsP a, int it, int half, int lane) {
    unsigned char* ws = a->ws;
    constexpr int I_IN = 8 * 144, I_OUT = 8 * 64, I_F = 1408;
    const float* W; unsigned char* WT; int K, N, mode, f8 = 0, q;
    int r = it;
    if (r < 2 * (I_IN + I_OUT)) { const int l = r / (I_IN + I_OUT), rr = r % (I_IN + I_OUT);
        if (rr < I_IN) { W = a->in[I_WIN] + (size_t)l * D * INW; K = D; N = INW; WT = ws + WS_WIN + (size_t)l * INW * D * 2; mode = 0; q = rr; f8 = INT8_QKV ? 2 : 0; }
        else { W = a->in[I_WOUT] + (size_t)l * D * D; K = D; N = D; WT = ws + WS_WOUT + (size_t)l * D * D * 2; mode = 0; q = rr - I_IN; f8 = INT8_OUT ? 2 : 0; } }
    else { r -= 2 * I_IN + 2 * I_OUT; const int m = r / I_F; q = r % I_F;
        if (m == 0) { W = a->in[I_FW1]; K = D; N = DFF; WT = ws + WS_W13; mode = 1; f8 = FP8_UP0 ? (INT8_UP ? 2 : 1) : 0; }
        else if (m == 1) { W = a->in[I_FW3]; K = D; N = DFF; WT = ws + WS_W13; mode = 2; f8 = FP8_UP0 ? (INT8_UP ? 2 : 1) : 0; }
        else if (m == 2) { W = a->in[I_FW2]; K = DFF; N = D; WT = ws + WS_W2; mode = 0; f8 = (FP8_UP0 && FP8_DOWN0); }
        else if (m < 11) { const int e = m - 3; W = a->in[I_MW1] + (size_t)e * D * DFF; K = D; N = DFF; WT = ws + WS_MW13 + (size_t)e * 2 * DFF * D; mode = 1; f8 = INT8_UP ? 2 : 1; }
        else if (m < 19) { const int e = m - 11; W = a->in[I_MW3] + (size_t)e * D * DFF; K = D; N = DFF; WT = ws + WS_MW13 + (size_t)e * 2 * DFF * D; mode = 2; f8 = INT8_UP ? 2 : 1; }
        else { const int e = m - 19; W = a->in[I_MW2] + (size_t)e * DFF * D; K = DFF; N = D; WT = ws + WS_MW2 + (size_t)e * D * DFF; mode = 0; f8 = 1; } }
    const int nblk = N / 32, kb = 4 * (q / nblk) + half, nb = q % nblk, k0 = 64 * kb, n0 = 32 * nb;
    const int drow0 = mode == 0 ? n0 : (256 * (n0 >> 7) + (n0 & 127) + (mode == 2 ? 128 : 0));
    CvtItem c; c.src = W + (size_t)k0 * N + n0; c.N = N; c.K = K; c.f8 = f8; c.dst = WT + ((size_t)drow0 * K + k0) * (f8 ? 1 : 2); return c;
}
__device__ __forceinline__ void cvt_load(const CvtItem& c, int lane, f32x4 (&v)[8]) {
    const float* p = c.src + (size_t)(lane >> 3) * c.N + (lane & 7) * 4;
#pragma unroll
    for (int i = 0; i < 8; ++i) v[i] = *(const f32x4*)(p + (size_t)(8 * i) * c.N);
}
static_assert(INT8_OUT && INT8_QKV && FP8_UP0 && FP8_DOWN0, "the conversion store handles byte formats only: every weight matrix is int8 or fp8 in this build");
__device__ __forceinline__ void cvt_store(const CvtItem& c, int lane, const f32x4 (&v)[8], LAS float* scr) {
    LAS unsigned* su = (LAS unsigned*)scr + (lane & 7) * 72 + (lane >> 3);
#pragma unroll
    for (int i = 0; i < 8; ++i) su[8 * i] = c.f8 == 2 ? pk4_i8s(v[i].x, v[i].y, v[i].z, v[i].w, I8_SW) : pk4_fp8(v[i].x * F8_SW, v[i].y * F8_SW, v[i].z * F8_SW, v[i].w * F8_SW);
    LDS_WAIT(); asm volatile("" ::: "memory");
    const LAS u32x4* sr = (const LAS u32x4*)((LAS unsigned*)scr + (lane >> 3) * 72 + 8 * (lane & 7));
    unsigned char* d = c.dst + (size_t)(4 * (lane >> 3)) * c.K + 8 * (lane & 7);
    const u32x4 wa = sr[0], wb = sr[1];
#define CVT_T4(W, O0, O1, O2, O3) do { const unsigned a_ = __builtin_amdgcn_perm(W.y, W.x, 0x05010400u), b_ = __builtin_amdgcn_perm(W.w, W.z, 0x05010400u), c_ = __builtin_amdgcn_perm(W.y, W.x, 0x07030602u), d_ = __builtin_amdgcn_perm(W.w, W.z, 0x07030602u); \
        O0 = __builtin_amdgcn_perm(b_, a_, 0x05040100u); O1 = __builtin_amdgcn_perm(b_, a_, 0x07060302u); O2 = __builtin_amdgcn_perm(d_, c_, 0x05040100u); O3 = __builtin_amdgcn_perm(d_, c_, 0x07060302u); } while (0)
    u32x2 o0, o1, o2, o3;
    CVT_T4(wa, o0.x, o1.x, o2.x, o3.x); CVT_T4(wb, o0.y, o1.y, o2.y, o3.y);
#undef CVT_T4
    *(u32x2*)d = o0; *(u32x2*)(d + c.K) = o1; *(u32x2*)(d + 2 * (size_t)c.K) = o2; *(u32x2*)(d + 3 * (size_t)c.K) = o3;
    LDS_WAIT(); asm volatile("" ::: "memory");
}
constexpr int CVT_Q_ALL = 2 * 8 * 144 + 2 * 8 * 64 + 27 * 1408;
constexpr int CVT_Q_DENSE = 8 * 144 + 8 * 64;
constexpr int CVT_Q_MOE = CVT_Q_ALL - CVT_Q_DENSE;
__device__ __forceinline__ void convert_quads(ArgsP a, LAS float* scr, int gw, int ngw, int lane, int q0, int nq) {
    const int FULL = nq - nq % ngw;
    f32x4 va[8], vb[8], vc[8];
    for (int ti = gw; ti < (nq - FULL) * 4; ti += ngw) { const CvtItem t = cvt_decode(a, q0 + FULL + (ti >> 2), ti & 3, lane); cvt_load(t, lane, va); cvt_store(t, lane, va, scr); }
    const int nI = 4 * (FULL / ngw); if (nI == 0) return;
#define CVT_LD(T, V) do { const CvtItem c_ = cvt_decode(a, q0 + gw + ((T) >> 2) * ngw, (T) & 3, lane); cvt_load(c_, lane, V); } while (0)
#define CVT_ST(T, V) do { const CvtItem c_ = cvt_decode(a, q0 + gw + ((T) >> 2) * ngw, (T) & 3, lane); cvt_store(c_, lane, V, scr); } while (0)
    CVT_LD(0, va); CVT_LD(1, vb); CVT_LD(2, vc);
    for (int t = 0; t < nI; t += 3) {
        CVT_ST(t, va); if (t + 3 < nI) CVT_LD(t + 3, va);
        if (t + 1 < nI) { CVT_ST(t + 1, vb); if (t + 4 < nI) CVT_LD(t + 4, vb); }
        if (t + 2 < nI) { CVT_ST(t + 2, vc); if (t + 5 < nI) CVT_LD(t + 5, vc); }
    }
#undef CVT_LD
#undef CVT_ST
}
__device__ __forceinline__ void phase_convert(ArgsP a, LAS unsigned char* lds, int gw, int ngw, int wave, int lane) {
    convert_quads(a, (LAS float*)(lds + wave * 16384), gw, ngw, lane, 0, CVT_Q_DENSE);
}
__device__ __forceinline__ void phase_adaln(ArgsP a, LAS unsigned char* lds, int tid, int wave, int lane) {
    LAS float* sc = (LAS float*)lds;
    LAS float* red = (LAS float*)(lds + 5 * 2048 * 4);
    float* MOD = (float*)(a->ws + WS_MOD);
    for (int task = blockIdx.x; task < 192; task += gridDim.x) {
        const int l = task / 96, j0 = (task % 96) * 128;
        for (int i = tid; i < 5 * 2048; i += NTHREADS) { const int v = i >> 11, k = i & 2047; const float c = v < 4 ? a->in[I_C][v * D + k] : a->in[I_CCTX][k]; sc[i] = c / (1.f + __expf(-c)); }
        __syncthreads();
        float acc[5][2];
#pragma unroll
        for (int v = 0; v < 5; ++v) { acc[v][0] = 0.f; acc[v][1] = 0.f; }
        const float* wp = a->in[I_WMOD] + ((size_t)l * D + wave * 256) * MODW + j0 + 2 * lane;
        f32x2 wa[16], wb[16];
#pragma unroll
        for (int i = 0; i < 16; ++i) wa[i] = *(const f32x2*)(wp + (size_t)i * MODW);
        for (int kb = 0; kb < 256; kb += 32) {
#pragma unroll
            for (int i = 0; i < 16; ++i) wb[i] = *(const f32x2*)(wp + (size_t)(kb + 16 + i) * MODW);
            __builtin_amdgcn_sched_barrier(0);
#pragma unroll
            for (int i = 0; i < 16; ++i)
#pragma unroll
                for (int v = 0; v < 5; ++v) { const float s = sc[v * 2048 + wave * 256 + kb + i]; acc[v][0] += s * wa[i].x; acc[v][1] += s * wa[i].y; }
            __builtin_amdgcn_sched_barrier(0);
            if (kb + 32 < 256) {
#pragma unroll
                for (int i = 0; i < 16; ++i) wa[i] = *(const f32x2*)(wp + (size_t)(kb + 32 + i) * MODW); }
            __builtin_amdgcn_sched_barrier(0);
#pragma unroll
            for (int i = 0; i < 16; ++i)
#pragma unroll
                for (int v = 0; v < 5; ++v) { const float s = sc[v * 2048 + wave * 256 + kb + 16 + i]; acc[v][0] += s * wb[i].x; acc[v][1] += s * wb[i].y; }
            __builtin_amdgcn_sched_barrier(0);
        }
#pragma unroll
        for (int v = 0; v < 5; ++v) { red[(wave * 5 + v) * 128 + 2 * lane] = acc[v][0]; red[(wave * 5 + v) * 128 + 2 * lane + 1] = acc[v][1]; }
        __syncthreads();
        for (int i = tid; i < 640; i += NTHREADS) { const int v = i >> 7, j = i & 127; float s = a->in[I_BMOD][l * MODW + j0 + j];
#pragma unroll
            for (int w = 0; w < 8; ++w) s += red[(w * 5 + v) * 128 + j];
            MOD[(size_t)(l * 5 + v) * MODW + j0 + j] = s; }
        __syncthreads();
    }
}

__device__ __forceinline__ void ld_row_f32(const float* p, int lane, f32x4 (&v)[8]) {
#pragma unroll
    for (int j = 0; j < 8; ++j) v[j] = *(const f32x4*)(p + 4 * lane + 256 * j);
}
__device__ __forceinline__ void ld_row_bf16(const bf16_t* p, int lane, f32x4 (&v)[8]) {
#pragma unroll
    for (int j = 0; j < 8; ++j) { const u32x2 w = *(const u32x2*)(p + 4 * lane + 256 * j); v[j] = (f32x4){bf_lo(w.x), bf_hi(w.x), bf_lo(w.y), bf_hi(w.y)}; }
}
__device__ __forceinline__ void st_row_f32(float* p, int lane, const f32x4 (&v)[8]) {
#pragma unroll
    for (int j = 0; j < 8; ++j) *(f32x4*)(p + 4 * lane + 256 * j) = v[j];
}
__device__ __forceinline__ void st_row_bf16(bf16_t* p, int lane, const f32x4 (&v)[8]) {
#pragma unroll
    for (int j = 0; j < 8; ++j) { u32x2 w; w.x = cvt_pk_bf16(v[j].x, v[j].y); w.y = cvt_pk_bf16(v[j].z, v[j].w); *(u32x2*)(p + 4 * lane + 256 * j) = w; }
}
__device__ __forceinline__ float row_rstd(const f32x4 (&v)[8]) {
    float s = 0.f;
#pragma unroll
    for (int j = 0; j < 8; ++j) s += (v[j].x * v[j].x + v[j].y * v[j].y) + (v[j].z * v[j].z + v[j].w * v[j].w);
    return rsqrtf(wave_sum(s) * (1.f / D) + EPS);
}
template <bool STORE = true> __device__ __forceinline__ void norm_mod_store(const f32x4 (&x)[8], const float* g, const float* sh, const float* sc, bf16_t* hrow, int lane, f32x4 (&h)[8]) {
    const float r = row_rstd(x);
#pragma unroll
    for (int j = 0; j < 8; ++j) { const int c = 4 * lane + 256 * j; const f32x4 gv = *(const f32x4*)(g + c), sv = *(const f32x4*)(sc + c), hv = *(const f32x4*)(sh + c);
        h[j] = (x[j] * r * gv) * (sv + 1.f) + hv; }
    if (STORE) st_row_bf16(hrow, lane, h);
}
__device__ __forceinline__ void phase_row_entry(ArgsP a, int gw, int ngw, int lane) {
    bf16_t* X = (bf16_t*)(a->ws + WS_X); bf16_t* H = (bf16_t*)(a->ws + WS_H); const float* MOD = (const float*)(a->ws + WS_MOD);
    for (int row = gw; row < NR; row += ngw) {
        const int b = row / TPB, t = row % TPB; const bool lat = t < SEQ; const int v = lat ? b : 4;
        const float* src = lat ? a->in[I_X] + ((size_t)b * SEQ + t) * D : a->in[I_CTX] + ((size_t)b * CTX + (t - SEQ)) * D;
        f32x4 x[8], h[8]; ld_row_f32(src, lane, x); st_row_bf16(X + (size_t)row * D, lane, x);
        const float* mv = MOD + (size_t)(0 * 5 + v) * MODW;
        norm_mod_store<!INT8_QKV>(x, a->in[I_GMIXPRE], mv + 0 * D, mv + 1 * D, H + (size_t)row * D, lane, h);
        if (INT8_QKV) { unsigned char* hq = (unsigned char*)H + (size_t)row * D;
#pragma unroll
            for (int j = 0; j < 8; ++j) *(unsigned*)(hq + 4 * lane + 256 * j) = pk4_i8s(h[j].x, h[j].y, h[j].z, h[j].w, I8_SH); }
    }
}
template <int L> __device__ __forceinline__ void phase_row_mid(ArgsP a, LAS unsigned char* lds, int gw, int ngw, int tid, int lane) {
    bf16_t* X = (bf16_t*)(a->ws + WS_X); bf16_t* H = (bf16_t*)(a->ws + WS_H); const float* MOD = (const float*)(a->ws + WS_MOD); const bf16_t* O = (const bf16_t*)(a->ws + WS_O);
    LAS unsigned* lcnt = (LAS unsigned*)(lds + 131072 + 64); LAS float* rt = (LAS float*)lds;
    if (L == 1) { if (tid < 8) lcnt[tid] = 0u;
        for (int i = tid; i < D * NE; i += NTHREADS) rt[(i & 7) * D + (i >> 3)] = a->in[I_ROUTER][i];
        __syncthreads(); }
    for (int row = gw; row < NR; row += ngw) {
        const int b = row / TPB, t = row % TPB; const bool lat = t < SEQ; const int v = lat ? b : 4;
        if (L == 1 && !lat) continue;
        const float* mv = MOD + (size_t)(L * 5 + v) * MODW;
        f32x4 o[8], x[8], h[8];
        if (L == 0 && !lat) { const bf16_t* P = (const bf16_t*)(a->ws + WS_PART_A) + (size_t)(b * CTX + (t - SEQ)) * D; ld_row_bf16(P, lane, o);
#pragma unroll
            for (int s = 1; s < 8; ++s) { f32x4 p[8]; ld_row_bf16(P + (size_t)s * (NB * CTX) * D, lane, p);
#pragma unroll
                for (int j = 0; j < 8; ++j) o[j] = o[j] + p[j]; } }
        else ld_row_bf16(O + (size_t)row * D, lane, o);
        ld_row_bf16(X + (size_t)row * D, lane, x);
        const float r1 = row_rstd(o);
#pragma unroll
        for (int j = 0; j < 8; ++j) { const int c = 4 * lane + 256 * j; const f32x4 gv = *(const f32x4*)(a->in[I_GMIXPOST] + L * D + c), gt = *(const f32x4*)(mv + 2 * D + c);
            x[j] = x[j] + gt * (o[j] * r1 * gv); }
        st_row_bf16(X + (size_t)row * D, lane, x);
        norm_mod_store<(L == 0 && !FP8_UP0)>(x, a->in[I_GFFNPRE] + L * D, mv + 3 * D, mv + 4 * D, H + (size_t)row * D, lane, h);
        { unsigned char* h8 = a->ws + WS_H8 + (size_t)row * D;
#pragma unroll
            for (int j = 0; j < 8; ++j) *(unsigned*)(h8 + 4 * lane + 256 * j) = INT8_UP ? pk4_i8s(h[j].x, h[j].y, h[j].z, h[j].w, I8_SH) : pk4_fp8(h[j].x * F8_SH, h[j].y * F8_SH, h[j].z * F8_SH, h[j].w * F8_SH); }
        if (L == 1) {
            float lg[8];
#pragma unroll
            for (int e = 0; e < 8; ++e) lg[e] = 0.f;
#pragma unroll
            for (int j = 0; j < 8; ++j)
#pragma unroll
                for (int e = 0; e < 8; ++e) { const f32x4 r = *(const LAS f32x4*)(rt + e * D + 4 * lane + 256 * j); lg[e] += (h[j].x * r.x + h[j].y * r.y) + (h[j].z * r.z + h[j].w * r.w); }
#pragma unroll
            for (int e = 0; e < 8; ++e) lg[e] = wave_sum(lg[e]);
            int i1 = 0; float v1 = lg[0];
#pragma unroll
            for (int e = 1; e < 8; ++e) if (lg[e] > v1) { v1 = lg[e]; i1 = e; }
            int i2 = -1; float v2 = -3.0e38f;
#pragma unroll
            for (int e = 0; e < 8; ++e) if (e != i1 && lg[e] > v2) { v2 = lg[e]; i2 = e; }
            const float e2 = __expf(v2 - v1), g1 = 1.f / (1.f + e2), g2 = e2 / (1.f + e2);
            if (lane == 0) { const int tok = b * SEQ + t; int* tk = (int*)(a->ws + WS_TOPK) + (size_t)tok * 4; tk[0] = i1; tk[1] = i2; ((float*)tk)[2] = g1; ((float*)tk)[3] = g2;
                atomicAdd((unsigned*)&lcnt[i1], 1u); atomicAdd((unsigned*)&lcnt[i2], 1u); }
        }
    }
    if (L == 1) { __syncthreads(); if (tid < 8) { const unsigned c = lcnt[tid]; if (c) __hip_atomic_fetch_add((unsigned*)(a->ws + WS_CTL) + CW_CNT + tid, c, __ATOMIC_RELAXED, __HIP_MEMORY_SCOPE_AGENT); } __syncthreads(); }
}
constexpr int LDS_CTL_OFF = 131072;
__device__ __forceinline__ LAS int* moe_offsets(ArgsP a, LAS unsigned char* lds, int tid) {
    LAS int* toff = (LAS int*)(lds + LDS_CTL_OFF);
    __syncthreads();
    if (tid == 0) { int acc = 0;
        for (int e = 0; e < 8; ++e) { toff[e] = acc; const unsigned c = __hip_atomic_load((unsigned*)(a->ws + WS_CTL) + CW_CNT + e, __ATOMIC_RELAXED, __HIP_MEMORY_SCOPE_AGENT); toff[16 + e] = (int)c; acc += (int)((c + 255u) >> 8); }
        toff[8] = acc; }
    __syncthreads();
    return toff;
}
__device__ __forceinline__ void phase_moe_slots(ArgsP a, LAS unsigned char* lds, int gw, int ngw, int tid, int lane) {
    LAS int* toff = moe_offsets(a, lds, fresh_tid());
    unsigned* ctl = (unsigned*)(a->ws + WS_CTL); int* SLOT = (int*)(a->ws + WS_SLOT); int* IDX = (int*)(a->ws + WS_IDX); const int* TOPK = (const int*)(a->ws + WS_TOPK);
    const int wave = tid >> 6;
    for (int e = blockIdx.x; e < 8; e += gridDim.x) { const int c = toff[16 + e], s0 = toff[e] * 256 + c, n = ((c + 255) & ~255) - c;
        for (int i = tid; i < n; i += NTHREADS) IDX[s0 + i] = 0; }
    for (int grp = blockIdx.x; grp < NTOK / 64; grp += gridDim.x) {
        if (wave == 0) {
            const int tok = grp * 64 + lane, b = tok / SEQ, t = tok % SEQ, row = b * TPB + t;
            const int e1 = TOPK[tok * 4], e2 = TOPK[tok * 4 + 1]; int s0 = 0, s1 = 0;
            unsigned long long msk[8]; int nmine = 0;
#pragma unroll
            for (int e = 0; e < 8; ++e) { msk[e] = __ballot((e1 == e) || (e2 == e)); nmine = (lane == e) ? __popcll(msk[e]) : nmine; }
            unsigned base = 0; if (lane < 8 && nmine) base = __hip_atomic_fetch_add(ctl + CW_CUR + lane, (unsigned)nmine, __ATOMIC_RELAXED, __HIP_MEMORY_SCOPE_AGENT);
#pragma unroll
            for (int e = 0; e < 8; ++e) { const unsigned be = __shfl(base, e);
                const int slot = toff[e] * 256 + (int)be + __popcll(msk[e] & ((1ull << lane) - 1ull));
                if (e1 == e) s0 = slot; if (e2 == e) s1 = slot; }
            SLOT[tok * 2] = s0; SLOT[tok * 2 + 1] = s1; IDX[s0] = row; IDX[s1] = row;
        }
    }
    __syncthreads();
}
template <int L> __device__ __forceinline__ void phase_row_end(ArgsP a, int gw, int ngw, int lane) {
    bf16_t* X = (bf16_t*)(a->ws + WS_X); bf16_t* H = (bf16_t*)(a->ws + WS_H); const float* MOD = (const float*)(a->ws + WS_MOD); const bf16_t* Y = (const bf16_t*)(a->ws + WS_Y);
    for (int row = gw; row < NR; row += ngw) {
        const int b = row / TPB, t = row % TPB; const bool lat = t < SEQ; const int v = lat ? b : 4;
        if (L == 1 && !lat) continue;
        const float* mv = MOD + (size_t)(L * 5 + v) * MODW;
        f32x4 y[8], x[8], h[8];
        if (L == 0 && !lat) { const bf16_t* P = (const bf16_t*)(a->ws + WS_PART_B) + (size_t)(b * CTX + (t - SEQ)) * D; ld_row_bf16(P, lane, y);
#pragma unroll
            for (int s = 1; s < 8; ++s) { f32x4 p[8]; ld_row_bf16(P + (size_t)s * (NB * CTX) * D, lane, p);
#pragma unroll
                for (int j = 0; j < 8; ++j) y[j] = y[j] + p[j]; } }
        else if (L == 0) ld_row_bf16(Y + (size_t)row * D, lane, y);
        else { const int tok = b * SEQ + t; const int* sl = (const int*)(a->ws + WS_SLOT) + tok * 2; const float* tk = (const float*)(a->ws + WS_TOPK) + (size_t)tok * 4; const float g1 = tk[2], g2 = tk[3];
            f32x4 y2[8]; const bf16_t* PM = (const bf16_t*)(a->ws + WS_PART_M); const int sa = sl[0], sb = sl[1], TS = 256 * ((2 * NTOK) / 256);
            if (sa < TS) ld_row_bf16(Y + (size_t)sa * D, lane, y);
            else { ld_row_bf16(PM + (size_t)(sa - TS) * D, lane, y);
                for (int q = 1; q < 4; ++q) { f32x4 p[8]; ld_row_bf16(PM + ((size_t)q * 2048 + (sa - TS)) * D, lane, p);
#pragma unroll
                    for (int j = 0; j < 8; ++j) y[j] = y[j] + p[j]; } }
            if (sb < TS) ld_row_bf16(Y + (size_t)sb * D, lane, y2);
            else { ld_row_bf16(PM + (size_t)(sb - TS) * D, lane, y2);
                for (int q = 1; q < 4; ++q) { f32x4 p[8]; ld_row_bf16(PM + ((size_t)q * 2048 + (sb - TS)) * D, lane, p);
#pragma unroll
                    for (int j = 0; j < 8; ++j) y2[j] = y2[j] + p[j]; } }
#pragma unroll
            for (int j = 0; j < 8; ++j) y[j] = y[j] * g1 + y2[j] * g2; }
        ld_row_bf16(X + (size_t)row * D, lane, x);
        const float r1 = row_rstd(y);
#pragma unroll
        for (int j = 0; j < 8; ++j) { const int c = 4 * lane + 256 * j; const f32x4 gv = *(const f32x4*)(a->in[I_GFFNPOST] + L * D + c), gt = *(const f32x4*)(mv + 5 * D + c);
            x[j] = x[j] + gt * (y[j] * r1 * gv); }
        if (L == 0) { st_row_bf16(X + (size_t)row * D, lane, x); const float* mn = MOD + (size_t)(1 * 5 + v) * MODW;
            norm_mod_store<!INT8_QKV>(x, a->in[I_GMIXPRE] + D, mn + 0 * D, mn + 1 * D, H + (size_t)row * D, lane, h);
            if (INT8_QKV) { unsigned char* hq = (unsigned char*)H + (size_t)row * D;
#pragma unroll
                for (int j = 0; j < 8; ++j) *(unsigned*)(hq + 4 * lane + 256 * j) = pk4_i8s(h[j].x, h[j].y, h[j].z, h[j].w, I8_SH); } }
        else st_row_f32(a->out + ((size_t)b * SEQ + t) * D, lane, x);
    }
}

template <int L> __device__ __forceinline__ void phase_attq(ArgsP a, int gw, int ngw, int lane) {
    const bf16_t* ATT = (const bf16_t*)(a->ws + WS_ATT); unsigned char* Q8 = a->ws + WS_ATT8; float* RS = (float*)(a->ws + WS_RS);
    for (int row = gw; row < NR; row += 2 * ngw) {
        const int r1 = row + ngw; const bool v0 = !(L == 1 && (row % TPB) >= SEQ), v1 = r1 < NR && !(L == 1 && (r1 % TPB) >= SEQ);
        f32x4 h0[8], h1[8];
        if (v0) ld_row_bf16(ATT + (size_t)row * D, lane, h0);
        if (v1) ld_row_bf16(ATT + (size_t)r1 * D, lane, h1);
#define ATTQ_ROW(R, H) do { float m = 0.f; \
        _Pragma("unroll") for (int j = 0; j < 8; ++j) m = fmaxf(fmaxf(m, fmaxf(fabsf(H[j].x), fabsf(H[j].y))), fmaxf(fabsf(H[j].z), fabsf(H[j].w))); \
        _Pragma("unroll") for (int o = 1; o < 64; o <<= 1) m = fmaxf(m, __shfl_xor(m, o)); \
        const float sc = m > 0.f ? 127.f / m : 0.f; unsigned char* q = Q8 + (size_t)(R) * D; \
        _Pragma("unroll") for (int j = 0; j < 8; ++j) *(unsigned*)(q + 4 * lane + 256 * j) = pk4_i8s(H[j].x, H[j].y, H[j].z, H[j].w, sc); \
        if (lane == 0) RS[R] = m * (1.f / (127.f * I8_SW)); } while (0)
        if (v0) ATTQ_ROW(row, h0);
        if (v1) ATTQ_ROW(r1, h1);
#undef ATTQ_ROW
    }
}
template <int L> __device__ __forceinline__ void phase_qkpost(ArgsP a, LAS unsigned char* lds, int gw, int ngw, int tid, int lane) {
    bf16_t* QKV = (bf16_t*)(a->ws + WS_QKV);
    const float L2T = 13.287712379549449f;
    LAS f32x2* tg = (LAS f32x2*)lds; LAS f32x2* td = tg + 64 * 32;
    for (int i = tid; i < 64 * 32 + 64 * 16; i += NTHREADS) { float s_, c_;
        if (i < 64 * 32) { sincosf((float)(i >> 5) * exp2f(-(float)(i & 31) * (1.f / 32.f) * L2T), &s_, &c_); tg[i] = (f32x2){c_, s_}; }
        else { const int q_ = i - 64 * 32; sincosf((float)(q_ >> 4) * exp2f(-(float)(q_ & 15) * (1.f / 16.f) * L2T), &s_, &c_); td[q_] = (f32x2){c_, s_}; } }
    __syncthreads();
    const float qn0 = a->in[I_QNORM][L * 128 + lane], qn1 = a->in[I_QNORM][L * 128 + 64 + lane], kn0 = a->in[I_KNORM][L * 128 + lane], kn1 = a->in[I_KNORM][L * 128 + 64 + lane];
    for (int row = gw; row < NR; row += ngw) {
        const int t = row % TPB; const bool lat = t < SEQ; const int gr = t >> 6, gc = t & 63;
        bf16_t* q = QKV + (size_t)row * INW;
        const f32x2 t_r = tg[gr * 32 + (lane & 31)], t_c = tg[gc * 32 + (lane & 31)], t_d = td[(lane < 32 ? gr : gc) * 16 + (lane & 15)];
        const float cr = t_r.x, sr = t_r.y, cc = t_c.x, sc2 = t_c.y, cd = t_d.x, sd = t_d.y;
        float e0[10], e1[10], f0[8], f1[8];
#pragma unroll
        for (int hd = 8; hd < 10; ++hd) { const int base = hd < 8 ? 1536 + hd * 128 : 2560 + (hd - 8) * 128; e0[hd] = bf2f(q[base + lane]); e1[hd] = bf2f(q[base + 64 + lane]); }
        if (lat) {
#pragma unroll
            for (int bl = 4; bl < 8; ++bl) { const int base = 3072 + bl * 128; f0[bl] = bf2f(q[base + lane]); f1[bl] = bf2f(q[base + 64 + lane]); } }
#pragma unroll
        for (int hd = 8; hd < 10; ++hd) {
            const int base = hd < 8 ? 1536 + hd * 128 : 2560 + (hd - 8) * 128;
            float x0 = e0[hd], x1 = e1[hd];
            const float r = rsqrtf(wave_sum(x0 * x0 + x1 * x1) * (1.f / 128.f) + EPS);
            x0 = x0 * r * (hd < 8 ? qn0 : kn0); x1 = x1 * r * (hd < 8 ? qn1 : kn1);
            if (lat) { const float p0 = __shfl_xor(x0, 32), p1 = __shfl_xor(x1, 32);
                if (lane < 32) { x0 = x0 * cr - p0 * sr; x1 = x1 * cc - p1 * sc2; } else { x0 = x0 * cr + p0 * sr; x1 = x1 * cc + p1 * sc2; } }
            q[base + lane] = f2bf(x0); q[base + 64 + lane] = f2bf(x1);
        }
        if (lat) {
#pragma unroll
            for (int bl = 4; bl < 8; ++bl) {
                const int base = 3072 + bl * 128;
                float x0 = f0[bl], x1 = f1[bl];
                const float p0 = __shfl_xor(x0, 16), p1 = __shfl_xor(x1, 16);
                if ((lane & 16) == 0) { x0 = x0 * cd - p0 * sd; x1 = x1 * cd - p1 * sd; } else { x0 = x0 * cd + p0 * sd; x1 = x1 * cd + p1 * sd; }
                q[base + lane] = f2bf(x0); q[base + 64 + lane] = f2bf(x1);
            }
        }
    }
}

namespace att {
typedef short s16x4 __attribute__((ext_vector_type(4)));
typedef float f32x16 __attribute__((ext_vector_type(16)));
constexpr int KVBLK = 64;
constexpr int SHM_V = KVBLK * 128 * 2, SHM_K = KVBLK * 128 * 2;
constexpr float THR = 8.f;
#define KSWZ(row, colB) ((row) * 256 + ((colB) ^ (((row) & 7) << 4)))
#define SBAR() __builtin_amdgcn_sched_barrier(0)
__device__ __forceinline__ int crow(int r, int hi) { return (r & 3) + 8 * (r >> 2) + 4 * hi; }
__device__ __forceinline__ unsigned cvtpk(float lo, float hi) { unsigned r; asm volatile("v_cvt_pk_bf16_f32 %0, %1, %2" : "=v"(r) : "v"(lo), "v"(hi)); return r; }
constexpr float THRL = 64.f;
template <int MODE> __device__ __forceinline__ void partialSM(f32x16& p0, f32x16& p1, float& m_reg, float& mn, float& alpha, bool chk = true) {
  mn = m_reg; alpha = 1.f;
  if (chk) {
    float pmax = p0[0];
#pragma unroll
    for (int r = 1; r < 16; ++r) pmax = fmaxf(pmax, p0[r]);
#pragma unroll
    for (int r = 0; r < 16; ++r) pmax = fmaxf(pmax, p1[r]);
    { auto rr = __builtin_amdgcn_permlane32_swap(__float_as_uint(pmax), __float_as_uint(pmax), false, false);
      pmax = fmaxf(__uint_as_float(rr[0]), __uint_as_float(rr[1])); }
    if (!__builtin_expect(__all(pmax - m_reg <= THRL), 1)) { mn = fmaxf(m_reg, pmax); alpha = __builtin_amdgcn_exp2f(m_reg - mn); m_reg = mn; }
  }
  if (__builtin_expect(__any(mn != 0.f), 0)) {
#pragma unroll
    for (int r = 0; r < 16; ++r) { p0[r] -= mn; p1[r] -= mn; }
  }
#pragma unroll
  for (int r = 0; r < 16; ++r) p0[r] = __builtin_amdgcn_exp2f(p0[r]);
}
template <bool LSUM = false> __device__ __forceinline__ void finishSM(f32x16& p0, f32x16& p1, float alpha, float& l_reg, bf16x8& pa0, bf16x8& pa1, bf16x8& pa2, bf16x8& pa3) {
#pragma unroll
  for (int r = 0; r < 16; ++r) p1[r] = __builtin_amdgcn_exp2f(p1[r]);
  if (!LSUM) { float ps = 0;
#pragma unroll
  for (int r = 0; r < 16; ++r) ps += p0[r];
#pragma unroll
  for (int r = 0; r < 16; ++r) ps += p1[r];
  { auto rr = __builtin_amdgcn_permlane32_swap(__float_as_uint(ps), __float_as_uint(ps), false, false);
    ps = __uint_as_float(rr[0]) + __uint_as_float(rr[1]); }
  l_reg = l_reg * alpha + ps; }
#define PK4(P, BASE, OUT) do { unsigned a0 = cvtpk(P[BASE + 0], P[BASE + 1]), a1 = cvtpk(P[BASE + 2], P[BASE + 3]);   \
    unsigned b0 = cvtpk(P[BASE + 4], P[BASE + 5]), b1 = cvtpk(P[BASE + 6], P[BASE + 7]);                              \
    auto r0 = __builtin_amdgcn_permlane32_swap(a0, b0, false, false); auto r1 = __builtin_amdgcn_permlane32_swap(a1, b1, false, false); \
    u32x4 w = {r0[0], r1[0], r0[1], r1[1]}; OUT = *reinterpret_cast<bf16x8*>(&w); } while (0)
  PK4(p0, 0, pa0); PK4(p0, 8, pa1); PK4(p1, 0, pa2); PK4(p1, 8, pa3);
#undef PK4
}
template <int NQ> __device__ __forceinline__ void qkt(f32x16& p0, f32x16& p1, const LAS unsigned char* Ks, const bf16x8* qr, int r32, int hi, int mapoff) {
  p0 = f32x16{}; p1 = f32x16{};
#pragma unroll
  for (int d0 = 0; d0 < NQ; ++d0) { int cb = (mapoff + d0 * 16 + hi * 8) * 2;
    bf16x8 b0 = *reinterpret_cast<const LAS bf16x8*>(Ks + KSWZ(r32, cb));
    bf16x8 b1 = *reinterpret_cast<const LAS bf16x8*>(Ks + KSWZ(32 + r32, cb));
    p0 = __builtin_amdgcn_mfma_f32_32x32x16_bf16(b0, qr[d0], p0, 0, 0, 0);
    p1 = __builtin_amdgcn_mfma_f32_32x32x16_bf16(b1, qr[d0], p1, 0, 0, 0); }
}
__device__ __forceinline__ int v_st(int k, int c) { const int kk = (k & ~0xC) | ((k & 4) << 1) | ((k & 8) >> 1); return ((kk >> 3) * 4 + (c >> 5)) * 512 + ((kk & 7) * 32 + (c & 31)) * 2; }
__device__ __forceinline__ int v_rd_base(int lane) { return ((lane & 3) << 3) | (((lane >> 2) & 3) << 6) | (((lane >> 4) & 1) << 5) | (((lane >> 5) & 1) << 8); }
constexpr int v_rd_off(int d0, int ks, int half) { return d0 * 512 + ks * 4096 + half * 2048; }
template <int OFF> __device__ __forceinline__ s16x4 tr_read(int vb) {
  s16x4 r; asm volatile("ds_read_b64_tr_b16 %0, %1 offset:%2" : "=&v"(r) : "v"(vb), "i"(OFF) : "memory"); return r;
}
template <int D0> __device__ __forceinline__ void pv_one(f32x16& od, int vb, bf16x8 pa0, bf16x8 pa1, bf16x8 pa2, bf16x8 pa3) {
  const s16x4 l0 = tr_read<v_rd_off(D0, 0, 0)>(vb), h0 = tr_read<v_rd_off(D0, 0, 1)>(vb), l1 = tr_read<v_rd_off(D0, 1, 0)>(vb), h1 = tr_read<v_rd_off(D0, 1, 1)>(vb);
  const s16x4 l2 = tr_read<v_rd_off(D0, 2, 0)>(vb), h2 = tr_read<v_rd_off(D0, 2, 1)>(vb), l3 = tr_read<v_rd_off(D0, 3, 0)>(vb), h3 = tr_read<v_rd_off(D0, 3, 1)>(vb);
  asm volatile("s_waitcnt lgkmcnt(0)" ::: "memory"); SBAR();
#define PK(L, H) (bf16x8){L[0], L[1], L[2], L[3], H[0], H[1], H[2], H[3]}
  od = __builtin_amdgcn_mfma_f32_32x32x16_bf16(pa0, PK(l0, h0), od, 0, 0, 0);
  od = __builtin_amdgcn_mfma_f32_32x32x16_bf16(pa1, PK(l1, h1), od, 0, 0, 0);
  od = __builtin_amdgcn_mfma_f32_32x32x16_bf16(pa2, PK(l2, h2), od, 0, 0, 0);
  od = __builtin_amdgcn_mfma_f32_32x32x16_bf16(pa3, PK(l3, h3), od, 0, 0, 0);
#undef PK
}
__device__ __forceinline__ void lsum_mm(f32x16& lacc, bf16x8 onesB, bf16x8 pa0, bf16x8 pa1, bf16x8 pa2, bf16x8 pa3) {
  lacc = __builtin_amdgcn_mfma_f32_32x32x16_bf16(pa0, onesB, lacc, 0, 0, 0); lacc = __builtin_amdgcn_mfma_f32_32x32x16_bf16(pa1, onesB, lacc, 0, 0, 0);
  lacc = __builtin_amdgcn_mfma_f32_32x32x16_bf16(pa2, onesB, lacc, 0, 0, 0); lacc = __builtin_amdgcn_mfma_f32_32x32x16_bf16(pa3, onesB, lacc, 0, 0, 0);
}
__device__ __forceinline__ void pv_d0(f32x16* o, int vb, bf16x8 pa0, bf16x8 pa1, bf16x8 pa2, bf16x8 pa3) {
  pv_one<0>(o[0], vb, pa0, pa1, pa2, pa3); pv_one<1>(o[1], vb, pa0, pa1, pa2, pa3); pv_one<2>(o[2], vb, pa0, pa1, pa2, pa3); pv_one<3>(o[3], vb, pa0, pa1, pa2, pa3);
}
template <int MODE>
__device__ __forceinline__ void attn_body(const bf16_t* __restrict__ Qb, const bf16_t* __restrict__ Kh, const bf16_t* __restrict__ Vh, bf16_t* __restrict__ Ob, int seq, LAS unsigned char* lds,
                                          float lam, float osc, const float* __restrict__ subln, int na_r0 = 0, int na_R0 = 0, int qproc = 0, const float* __restrict__ qnw = nullptr, int trow0 = 0) {
  constexpr int NQ = MODE == 1 ? 4 : 8;
  const int tid = threadIdx.x, wid = __builtin_amdgcn_readfirstlane(tid >> 6), lane = tid & 63, r32 = lane & 31, hi = lane >> 5;
  const int wrow = MODE == 1 ? (wid & 3) : wid, mapoff = MODE == 1 ? (wid >> 2) * 64 : 0;
  LAS unsigned char* V_lds = lds; LAS unsigned char* K_lds = lds + 2 * SHM_V;
  LAS float* wsf = (LAS float*)(lds + 2 * SHM_V + 2 * SHM_K) + wid * 64; LAS float* li_l = wsf; LAS float* al_l = wsf + 32;
  constexpr bool LSUM = (MODE == 1);
  float m_reg = 0.f, l_reg = 0; f32x16 o[4] = {}; bf16x8 qr[NQ]; f32x16 lacc = {};
  bf16x8 onesB; { const short one_ = (r32 == 0) ? (short)0x3F80 : (short)0; onesB = (bf16x8){one_, one_, one_, one_, one_, one_, one_, one_}; }
  const bf16_t* Qw = Qb + (size_t)(wrow * 32 + r32) * INW + mapoff + hi * 8;
  { const LAS f32x2* tg = (const LAS f32x2*)(lds + 73728); const LAS f32x2* td = tg + 64 * 32;
    const int trow = trow0 + wrow * 32 + r32, gr = trow >> 6, gc = trow & 63;
    constexpr float CQ = (MODE == 1 ? 0.125f : 0.088388347648318440f) * 1.4426950408889634f;
#define QLD(X, D0) do { const u32x4 w_ = *reinterpret_cast<const u32x4*>(Qw + (D0) * 16); X[0] = bf_lo(w_.x); X[1] = bf_hi(w_.x); X[2] = bf_lo(w_.y); X[3] = bf_hi(w_.y); X[4] = bf_lo(w_.z); X[5] = bf_hi(w_.z); X[6] = bf_lo(w_.w); X[7] = bf_hi(w_.w); } while (0)
#define QPK(X, D0, SC) do { u32x4 s_; s_.x = cvtpk(X[0] * (SC), X[1] * (SC)); s_.y = cvtpk(X[2] * (SC), X[3] * (SC)); s_.z = cvtpk(X[4] * (SC), X[5] * (SC)); s_.w = cvtpk(X[6] * (SC), X[7] * (SC)); qr[D0] = *reinterpret_cast<bf16x8*>(&s_); } while (0)
    float rr = 1.f;
    if (MODE == 0 && qproc >= 1) { float ss = 0.f;
#pragma unroll
      for (int d0 = 0; d0 < NQ; ++d0) { float x[8]; QLD(x, d0);
#pragma unroll
        for (int e = 0; e < 8; ++e) ss += x[e] * x[e]; }
      ss += __shfl_xor(ss, 32); rr = rsqrtf(ss * (1.f / 128.f) + EPS); }
    constexpr int NPAIR = NQ / 2, PSTEP = MODE == 1 ? 1 : 2;
#pragma unroll
    for (int pr = 0; pr < NPAIR; ++pr) {
      const int da = MODE == 1 ? 2 * pr : 4 * (pr >> 1) + (pr & 1), db = da + PSTEP;
      float xa[8], xb[8]; QLD(xa, da); QLD(xb, db);
      if (MODE == 0 && qproc >= 1) { const f32x4 ga0 = *(const f32x4*)(qnw + 16 * da + 8 * hi), ga1 = *(const f32x4*)(qnw + 16 * da + 8 * hi + 4), gb0 = *(const f32x4*)(qnw + 16 * db + 8 * hi), gb1 = *(const f32x4*)(qnw + 16 * db + 8 * hi + 4);
#pragma unroll
        for (int e = 0; e < 4; ++e) { xa[e] *= rr * ga0[e]; xa[4 + e] *= rr * ga1[e]; xb[e] *= rr * gb0[e]; xb[4 + e] *= rr * gb1[e]; } }
      if (qproc == 2) {
        const LAS f32x2* tb = MODE == 1 ? td + (pr ? gc : gr) * 16 + 8 * hi : tg + ((pr >> 1) ? gc : gr) * 32 + 16 * (pr & 1) + 8 * hi;
#pragma unroll
        for (int e = 0; e < 8; ++e) { const f32x2 cs = tb[e]; const float x1 = xa[e], x2 = xb[e]; xa[e] = x1 * cs.x - x2 * cs.y; xb[e] = x2 * cs.x + x1 * cs.y; } }
      QPK(xa, da, CQ); QPK(xb, db, CQ);
    }
#undef QLD
#undef QPK
  }
  const int sr = tid >> 4, sc = (tid & 15) * 8, vst0 = v_st(sr, sc), vst1 = v_st(32 + sr, sc);
  const int vb0 = (int)(uintptr_t)V_lds + v_rd_base(lane);
  struct { bf16x8 vs0, vs1, ks0, ks1; } sr_[1];
#define TOK(T) (MODE == 2 ? ((T) < 4 ? SEQ + 64 * (T) : (na_R0 + (T) - 4) * 64) : (T) * KVBLK)
  const unsigned kvoff = (unsigned)(sr * INW + sc) * 2u;
#define SLOAD(i, T) do { const size_t tb_ = (size_t)TOK(T) * (INW * 2); const char* vb_ = (const char*)Vh + tb_; const char* kb_ = (const char*)Kh + tb_; \
    sr_[i].vs0 = *(const bf16x8*)(vb_ + kvoff); sr_[i].vs1 = *(const bf16x8*)(vb_ + (size_t)32 * INW * 2 + kvoff); \
    sr_[i].ks0 = *(const bf16x8*)(kb_ + kvoff); sr_[i].ks1 = *(const bf16x8*)(kb_ + (size_t)32 * INW * 2 + kvoff); } while (0)
  LAS float* rpbL = (LAS float*)(lds + 2 * SHM_V + 2 * SHM_K + 2048);
  const int na_rq = na_r0 + (wid >> 1), na_rs = min(max(na_rq - 4, 0), 56);
#define NABIAS(P0, P1, T) do { if (MODE == 2 && (T) >= 4) { const int na_c = ((wid & 1) << 5) + r32, na_t = 4 * hi - min(max(na_c - 8, 0), 48); \
    const int kr_ = na_R0 + (T) - 4; const bool rowok_ = kr_ >= na_rs && kr_ < na_rs + 8; const LAS float* bp_ = rpbL + (172 + (kr_ - na_rq + 7) * 31 + 15 - na_c + 4 * hi); \
    _Pragma("unroll") for (int r = 0; r < 16; ++r) { const int kq_ = (r & 3) + 8 * (r >> 2); \
      { const bool ok_ = rowok_ && (unsigned)(na_t + kq_) < 16u; P0[r] = ok_ ? fmaf(bp_[kq_], 1.4426950408889634f, P0[r]) : -1e30f; } \
      { const bool ok_ = rowok_ && (unsigned)(na_t + kq_ + 32) < 16u; P1[r] = ok_ ? fmaf(bp_[kq_ + 32], 1.4426950408889634f, P1[r]) : -1e30f; } } } } while (0)
#define SWRITE(b, i) do { *(LAS bf16x8*)(V_lds + (b) * SHM_V + vst0) = sr_[i].vs0;          \
    *(LAS bf16x8*)(V_lds + (b) * SHM_V + vst1) = sr_[i].vs1; int kc = sc * 2;               \
    *(LAS bf16x8*)(K_lds + (b) * SHM_K + KSWZ(sr, kc)) = sr_[i].ks0;                       \
    *(LAS bf16x8*)(K_lds + (b) * SHM_K + KSWZ(32 + sr, kc)) = sr_[i].ks1; } while (0)
#define SWAIT() asm volatile("s_waitcnt vmcnt(0)" ::: "memory")
#define RESC(a) do { if (__any((a) < 1.f)) { if (hi == 0) al_l[r32] = (a); asm volatile("s_waitcnt lgkmcnt(0)" ::: "memory"); \
    _Pragma("unroll") for (int d = 0; d < 4; ++d) _Pragma("unroll") for (int r = 0; r < 16; ++r) o[d][r] *= al_l[crow(r, hi)]; \
    if (LSUM) { _Pragma("unroll") for (int r = 0; r < 16; ++r) lacc[r] *= al_l[crow(r, hi)]; } } } while (0)
  f32x16 pA0, pA1, pB0, pB1; float mnA, mnB, alA, alB; bf16x8 pa0, pa1, pa2, pa3; const int NT = seq / KVBLK;
  if (MODE == 2) { for (int i = tid; i < 832; i += 512) { const int q = i - 172, dr = q >= 0 ? q / 31 : -1, dc = q - dr * 31; rpbL[i] = (q >= 0 && dr < 15) ? subln[dr * 31 + dc] : 0.f; } }
  SLOAD(0, 0); SWAIT(); SWRITE(0, 0); SLOAD(0, 1); __syncthreads();
  qkt<NQ>(pA0, pA1, K_lds, qr, r32, hi, mapoff); NABIAS(pA0, pA1, 0); partialSM<MODE>(pA0, pA1, m_reg, mnA, alA);
  SWAIT(); SWRITE(1, 0); if (2 < NT) SLOAD(0, 2); __syncthreads();
  for (int j = 1; j + 1 < NT; j += 2) {
    SBAR(); qkt<NQ>(pB0, pB1, K_lds + SHM_K, qr, r32, hi, mapoff);
    finishSM<LSUM>(pA0, pA1, alA, l_reg, pa0, pa1, pa2, pa3); SBAR();
    pv_d0(o, vb0, pa0, pa1, pa2, pa3); if (LSUM) lsum_mm(lacc, onesB, pa0, pa1, pa2, pa3); NABIAS(pB0, pB1, j); partialSM<MODE>(pB0, pB1, m_reg, mnB, alB, MODE == 2 || (j & 3) == 1);
    __syncthreads(); SWAIT(); SWRITE(0, 0); SLOAD(0, j + 2);
    RESC(alB); __syncthreads();
    SBAR(); qkt<NQ>(pA0, pA1, K_lds, qr, r32, hi, mapoff);
    finishSM<LSUM>(pB0, pB1, alB, l_reg, pa0, pa1, pa2, pa3); SBAR();
    pv_d0(o, vb0 + SHM_V, pa0, pa1, pa2, pa3); if (LSUM) lsum_mm(lacc, onesB, pa0, pa1, pa2, pa3); NABIAS(pA0, pA1, j + 1); partialSM<MODE>(pA0, pA1, m_reg, mnA, alA, MODE == 2);
    __syncthreads(); SWAIT(); SWRITE(1, 0); if (j + 3 < NT) SLOAD(0, j + 3);
    RESC(alA); __syncthreads();
  }
  SBAR(); qkt<NQ>(pB0, pB1, K_lds + SHM_K, qr, r32, hi, mapoff);
  finishSM<LSUM>(pA0, pA1, alA, l_reg, pa0, pa1, pa2, pa3); SBAR();
  pv_d0(o, vb0, pa0, pa1, pa2, pa3); if (LSUM) lsum_mm(lacc, onesB, pa0, pa1, pa2, pa3); NABIAS(pB0, pB1, NT - 1); partialSM<MODE>(pB0, pB1, m_reg, mnB, alB);
  __syncthreads(); RESC(alB);
  finishSM<LSUM>(pB0, pB1, alB, l_reg, pa0, pa1, pa2, pa3); SBAR();
  pv_d0(o, vb0 + SHM_V, pa0, pa1, pa2, pa3); if (LSUM) lsum_mm(lacc, onesB, pa0, pa1, pa2, pa3);
  if (hi == 0) li_l[r32] = l_reg; asm volatile("s_waitcnt lgkmcnt(0)" ::: "memory");
  float rli[16];
#pragma unroll
  for (int r = 0; r < 16; ++r) { if (LSUM) { const float la = __int_as_float(__builtin_amdgcn_readlane(__float_as_int(lacc[r]), 0)), lb = __int_as_float(__builtin_amdgcn_readlane(__float_as_int(lacc[r]), 32)); rli[r] = __builtin_amdgcn_rcpf(hi ? lb : la); }
    else rli[r] = __builtin_amdgcn_rcpf(li_l[crow(r, hi)]); }
  bf16_t* Ow = Ob + (size_t)(wrow * 32) * D;
  if (MODE != 1) {
#pragma unroll
    for (int r = 0; r < 16; ++r) { const int orow = crow(r, hi);
#pragma unroll
      for (int d0 = 0; d0 < 4; ++d0) Ow[(size_t)orow * D + d0 * 32 + r32] = f2bf(o[d0][r] * rli[r]); }
    __syncthreads();
  } else {
#pragma unroll
    for (int r = 0; r < 16; ++r)
#pragma unroll
      for (int d0 = 0; d0 < 4; ++d0) o[d0][r] *= rli[r];
    __syncthreads();
    LAS float* xb = (LAS float*)lds + (wid & 3) * 4096;
    if (wid >= 4) {
#pragma unroll
      for (int r = 0; r < 16; ++r)
#pragma unroll
        for (int d0 = 0; d0 < 4; ++d0) xb[crow(r, hi) * 128 + d0 * 32 + r32] = o[d0][r];
    }
    __syncthreads();
    if (wid < 4) {
      float sg[4];
#pragma unroll
      for (int d0 = 0; d0 < 4; ++d0) sg[d0] = subln[d0 * 32 + r32] * osc;
#pragma unroll
      for (int r = 0; r < 16; ++r) { float ss = 0.f;
#pragma unroll
        for (int d0 = 0; d0 < 4; ++d0) { o[d0][r] -= lam * xb[crow(r, hi) * 128 + d0 * 32 + r32]; ss += o[d0][r] * o[d0][r]; }
#pragma unroll
        for (int x = 1; x < 32; x <<= 1) ss += __shfl_xor(ss, x);
        const float rr = rsqrtf(ss * (1.f / 128.f) + EPS); const int orow = crow(r, hi);
#pragma unroll
        for (int d0 = 0; d0 < 4; ++d0) Ow[(size_t)orow * D + d0 * 32 + r32] = f2bf(o[d0][r] * rr * sg[d0]); }
    }
    __syncthreads();
  }
#undef SLOAD
#undef TOK
#undef NABIAS
#undef SWRITE
#undef SWAIT
#undef RESC
}
}

namespace pg8 {
constexpr int BM = 256, BK = 64, HALF = 128, HTB = HALF * BK * 2, STAGE_BYTES = 8 * HTB, NXCD = 8, WGM = 8;
__host__ __device__ __forceinline__ int lds_byte(int r, int c) { const int st = (r >> 4) * 2 + (c >> 5), rr = r & 15, cc = c & 31, ob = rr * 64 + cc * 2; return st * 1024 + (ob ^ (((ob >> 9) & 1) << 5)); }
__host__ __device__ __forceinline__ void stage_rc(int b, int& R, int& C) { const int st = b / 1024, sb = b % 1024, swz = sb ^ (((sb >> 9) & 1) << 5); R = (st >> 1) * 16 + swz / 64; C = (st & 1) * 32 + (swz % 64) / 2; }
__host__ __device__ __forceinline__ int perm32(int rho) { const int n = rho >> 4, i = rho & 15; return 8 * (i >> 2) + 4 * n + (i & 3); }
struct Unit { int pm, pn; size_t boff; int kt0, nt, split; };
struct Gemm { const void* A; const void* Bt; int KB; const int* idx = nullptr; };
typedef int v8i __attribute__((ext_vector_type(8))); typedef int v4i __attribute__((ext_vector_type(4)));
template <bool SKIPCTX> struct StaticOrder {
    int nM, nN, nwg, G, c, ntk;
    __device__ void init(int nM_, int nN_, int G_, int c_, int ntk_) { nM = nM_; nN = nN_; nwg = nM * nN; G = G_; c = c_; ntk = ntk_; }
    __device__ bool next(int i, Unit& u) const {
        const long L = (long)i * G + c; if (L >= nwg) return false;
        int wgid = (int)L; { const int q = nwg / NXCD, r = nwg % NXCD, xcd = wgid % NXCD, off = wgid / NXCD; wgid = (xcd < r ? xcd * (q + 1) : r * (q + 1) + (xcd - r) * q) + off; }
        const int nig = WGM * nN, gid = wgid / nig, fm = gid * WGM, gsz = (nM - fm) < WGM ? (nM - fm) : WGM;
        int pm = fm + ((wgid % nig) % gsz); u.pn = (wgid % nig) / gsz; if (SKIPCTX) pm += pm >> 4; u.pm = pm; u.boff = 0; u.kt0 = 0; u.nt = ntk; u.split = -1; return true;
    }
};
struct SplitCtxOrder {
    StaticOrder<true> lat; int ntk;
    __device__ void init(int G_, int c_, int ntk_) { lat.init(NTOK / 256, D / 256, G_, c_, ntk_); ntk = ntk_; }
    __device__ bool next(int i, Unit& u) const {
        const long L = (long)i * lat.G + lat.c;
        if (L < lat.nwg) return lat.next(i, u);
        const int q = (int)(L - lat.nwg); if (q >= 256) return false;
        const int s = q >> 5, pc = (q >> 3) & 3; u.pn = q & 7; u.pm = 17 * pc + 16; u.boff = 0; u.split = s;
        const int pairs = ntk >> 1, base = pairs >> 3, rem = pairs & 7;
        u.kt0 = 2 * (s * base + (s < rem ? s : rem)); u.nt = 2 * (base + (s < rem ? 1 : 0)); return true;
    }
};
constexpr int MOE_MAIN_TILES = (2 * NTOK) / 256;
template <bool TAIL> struct MoeOrderT {
    int nM, nMain, nN, nwg, ntail, G, c, ntk; int toff[8]; size_t bstride;
    __device__ void init(const LAS int* t, int nN_, int G_, int c_, size_t bstride_, int ntk_) { ntk = ntk_; for (int e = 0; e < 8; ++e) toff[e] = __builtin_amdgcn_readfirstlane(t[e]); nM = __builtin_amdgcn_readfirstlane(t[8]); nN = nN_;
        nMain = TAIL ? MOE_MAIN_TILES : nM; nwg = nMain * nN; ntail = TAIL ? (nM - MOE_MAIN_TILES) * nN * 4 : 0; G = G_; c = c_; bstride = bstride_; }
    __device__ bool next(int i, Unit& u) const {
        const long L = (long)i * G + c; int pm;
        if (L < nwg) {
            int wgid = (int)L; { const int q = nwg / NXCD, r = nwg % NXCD, xcd = wgid % NXCD, off = wgid / NXCD; wgid = (xcd < r ? xcd * (q + 1) : r * (q + 1) + (xcd - r) * q) + off; }
            const int nig = WGM * nN, gid = wgid / nig, fm = gid * WGM, gsz = (nMain - fm) < WGM ? (nMain - fm) : WGM;
            pm = fm + ((wgid % nig) % gsz); u.pn = (wgid % nig) / gsz; u.kt0 = 0; u.nt = ntk; u.split = -1;
        } else {
            const long sidx = L - nwg; if (sidx >= ntail) return false;
            const int q = (int)sidx & 3, unit = (int)sidx >> 2; pm = MOE_MAIN_TILES + unit / nN; u.pn = unit % nN; u.split = q;
            const int pairs = ntk >> 1, base = pairs >> 2, rem = pairs & 3;
            u.kt0 = 2 * (q * base + (q < rem ? q : rem)); u.nt = 2 * (base + (q < rem ? 1 : 0));
        }
        u.pm = pm; int e = 0;
#pragma unroll
        for (int q = 1; q < 8; ++q) e += (pm >= toff[q]) ? 1 : 0;
        u.boff = (size_t)e * bstride; return true;
    }
};
typedef MoeOrderT<false> MoeOrder;
constexpr float UP_SI = INT8_UP ? 1.f / (I8_SH * I8_SW) : 1.f / (F8_SH * F8_SW);
template <bool SCALED> struct EpiBf16T {
    bf16_t* O; int ldc; float scale;
    __device__ __forceinline__ void operator()(const f32x4 (&acc)[2][2][4][2], const Unit& u, int wr, int wc, int fr, int fq) const {
        const int row0 = u.pm * BM + wr * 64 + fr, col0 = u.pn * BM + wc * 32 + 8 * fq;
#pragma unroll
        for (int ai = 0; ai < 2; ++ai)
#pragma unroll
            for (int m = 0; m < 4; ++m) { bf16_t* rowp = O + (size_t)(row0 + ai * HALF + m * 16) * ldc + col0;
#pragma unroll
                for (int bj = 0; bj < 2; ++bj) { f32x4 v0 = acc[ai][bj][m][0], v1 = acc[ai][bj][m][1]; if (SCALED) { v0 = v0 * scale; v1 = v1 * scale; }
                    u32x4 w; w.x = cvt_pk_bf16(v0[0], v0[1]); w.y = cvt_pk_bf16(v0[2], v0[3]); w.z = cvt_pk_bf16(v1[0], v1[1]); w.w = cvt_pk_bf16(v1[2], v1[3]);
                    *(u32x4*)(rowp + bj * HALF) = w; } }
    }
};
__device__ __forceinline__ float silu_mul(float g, float u) { return g * __builtin_amdgcn_rcpf(1.f + __expf(-g)) * u; }
typedef float f32x2 __attribute__((ext_vector_type(2)));
__device__ __forceinline__ f32x2 swiglu2(f32x2 g, f32x2 u, float c1, float c3) {
    const f32x2 t = g * c1; f32x2 e; e.x = __builtin_amdgcn_exp2f(t.x); e.y = __builtin_amdgcn_exp2f(t.y);
    const f32x2 d = __builtin_elementwise_fma(e, (f32x2){c3, c3}, (f32x2){c3, c3}); f32x2 r; r.x = __builtin_amdgcn_rcpf(d.x); r.y = __builtin_amdgcn_rcpf(d.y);
    return (g * u) * r; }
template <bool SCALED> struct EpiSwigluT {
    bf16_t* O; int ldc;
    __device__ __forceinline__ void operator()(const f32x4 (&acc)[2][2][4][2], const Unit& u, int wr, int wc, int fr, int fq) const {
        const int row0 = u.pm * BM + wr * 64 + fr, col0 = u.pn * HALF + wc * 32 + 8 * fq;
#pragma unroll
        for (int ai = 0; ai < 2; ++ai)
#pragma unroll
            for (int m = 0; m < 4; ++m) { bf16_t* rowp = O + (size_t)(row0 + ai * HALF + m * 16) * ldc + col0;
                constexpr float SI = SCALED ? UP_SI : 1.f, C1 = -SI * 1.4426950408889634f, C3 = 1.f / (SI * SI);
                const f32x4 g0 = acc[ai][0][m][0], g1 = acc[ai][0][m][1], u0 = acc[ai][1][m][0], u1 = acc[ai][1][m][1];
                const f32x2 a = swiglu2(g0.xy, u0.xy, C1, C3), b = swiglu2(g0.zw, u0.zw, C1, C3), c = swiglu2(g1.xy, u1.xy, C1, C3), d = swiglu2(g1.zw, u1.zw, C1, C3);
                u32x4 w; w.x = cvt_pk_bf16(a.x, a.y); w.y = cvt_pk_bf16(b.x, b.y); w.z = cvt_pk_bf16(c.x, c.y); w.w = cvt_pk_bf16(d.x, d.y);
                *(u32x4*)rowp = w; }
    }
};
typedef EpiBf16T<false> EpiBf16;
typedef EpiSwigluT<false> EpiSwiglu;
struct EpiBf16OrPart {
    bf16_t* O; int ldc; bf16_t* PART;
    __device__ __forceinline__ void operator()(const f32x4 (&acc)[2][2][4][2], const Unit& u, int wr, int wc, int fr, int fq) const {
        if (u.split < 0) { EpiBf16 e{O, ldc, 1.f}; e(acc, u, wr, wc, fr, fq); return; }
        Unit v = u; v.pm = u.pm / 17;
        EpiBf16 e{PART + (size_t)u.split * (NB * CTX) * D, D, 1.f}; e(acc, v, wr, wc, fr, fq);
    }
};
struct EpiMoeDown {
    bf16_t* Y; bf16_t* PART; float scale;
    __device__ __forceinline__ void operator()(const f32x4 (&acc)[2][2][4][2], const Unit& u, int wr, int wc, int fr, int fq) const {
        if (u.split < 0) { EpiBf16T<true> e{Y, D, scale}; e(acc, u, wr, wc, fr, fq); return; }
        Unit v = u; v.pm = u.pm - MOE_MAIN_TILES;
        EpiBf16T<true> e{PART + (size_t)u.split * (8 * 256) * D, D, scale}; e(acc, v, wr, wc, fr, fq);
    }
};
struct EpiOutI8 {
    bf16_t* O; bf16_t* PART; const float* RS;
    __device__ __forceinline__ void operator()(const f32x4 (&acc)[2][2][4][2], const Unit& u, int wr, int wc, int fr, int fq) const {
        const int srow0 = u.pm * BM + wr * 64 + fr, col0 = u.pn * BM + wc * 32 + 8 * fq;
        bf16_t* base = u.split < 0 ? O : PART + (size_t)u.split * (NB * CTX) * D; const int orow0 = u.split < 0 ? srow0 : (u.pm / 17) * BM + wr * 64 + fr;
#pragma unroll
        for (int ai = 0; ai < 2; ++ai)
#pragma unroll
            for (int m = 0; m < 4; ++m) { const float sc = RS[srow0 + ai * HALF + m * 16]; bf16_t* rowp = base + (size_t)(orow0 + ai * HALF + m * 16) * D + col0;
#pragma unroll
                for (int bj = 0; bj < 2; ++bj) { const f32x4 v0 = acc[ai][bj][m][0] * sc, v1 = acc[ai][bj][m][1] * sc;
                    u32x4 w; w.x = cvt_pk_bf16(v0[0], v0[1]); w.y = cvt_pk_bf16(v0[2], v0[3]); w.z = cvt_pk_bf16(v1[0], v1[1]); w.w = cvt_pk_bf16(v1[2], v1[3]);
                    *(u32x4*)(rowp + bj * HALF) = w; } }
    }
};
struct EpiBf16OrPartS {
    bf16_t* O; int ldc; bf16_t* PART; float scale;
    __device__ __forceinline__ void operator()(const f32x4 (&acc)[2][2][4][2], const Unit& u, int wr, int wc, int fr, int fq) const {
        if (u.split < 0) { EpiBf16T<true> e{O, ldc, scale}; e(acc, u, wr, wc, fr, fq); return; }
        Unit v = u; v.pm = u.pm / 17;
        EpiBf16T<true> e{PART + (size_t)u.split * (NB * CTX) * D, D, scale}; e(acc, v, wr, wc, fr, fq);
    }
};
struct EpiSwigluF8 {
    unsigned char* O; int ldc;
    __device__ __forceinline__ void operator()(const f32x4 (&acc)[2][2][4][2], const Unit& u, int wr, int wc, int fr, int fq) const {
        const int row0 = u.pm * BM + wr * 64 + fr, col0 = u.pn * HALF + wc * 32 + 8 * fq; constexpr float SI = UP_SI;
#pragma unroll
        for (int ai = 0; ai < 2; ++ai)
#pragma unroll
            for (int m = 0; m < 4; ++m) { unsigned char* rowp = O + (size_t)(row0 + ai * HALF + m * 16) * ldc + col0;
                constexpr float C1 = -SI * 1.4426950408889634f, C3 = 1.f / (SI * SI * F8_SA);
                const f32x4 g0 = acc[ai][0][m][0], g1 = acc[ai][0][m][1], u0 = acc[ai][1][m][0], u1 = acc[ai][1][m][1];
                const f32x2 a = swiglu2(g0.xy, u0.xy, C1, C3), b = swiglu2(g0.zw, u0.zw, C1, C3), c = swiglu2(g1.xy, u1.xy, C1, C3), d = swiglu2(g1.zw, u1.zw, C1, C3);
                u32x2 w; w.x = pk4_fp8(a.x, a.y, b.x, b.y); w.y = pk4_fp8(c.x, c.y, d.x, d.y);
                *(u32x2*)rowp = w; }
    }
};
#ifndef GEMM_SP2
#define GEMM_SP2 1
#endif
#ifndef GEMM_ALIGN
#define GEMM_ALIGN 1
#endif
template <bool FP8, bool GATHER = false, bool I8 = false, class Epi, class Sched>
__device__ __forceinline__ void gemm_phase(LAS unsigned char* lds, const Gemm g, const Sched& S, const Epi& E) {
    const int tid = threadIdx.x, wid = __builtin_amdgcn_readfirstlane(tid >> 6), lane = tid & 63, wr = wid >> 2, wc = wid & 3, fr = lane & 15, fq = lane >> 4;
    const int KB = g.KB;
    unsigned voffA[2], voffB[2];
#pragma unroll
    for (int i = 0; i < 2; ++i) { int R, C; stage_rc(tid * 16 + i * 8192, R, C); const int Rb = (R & ~31) + perm32(R & 31);
        voffA[i] = (unsigned)(R * KB + C * 2); voffB[i] = (unsigned)(Rb * KB + C * 2); }
    const size_t kstep = (size_t)(BK * 2);
    const size_t hstep = (size_t)HALF * KB;
    const size_t tstep = 2 * hstep;
    const unsigned ldsw = (unsigned)wid * 1024u;
    const int aoff = lds_byte(wr * 64 + fr, fq * 8), boff = lds_byte(wc * 32 + fr, fq * 8);
#define PG8_SA(b, h) (((b) * 2 + (h)) * HTB)
#define PG8_SB(b, h) ((4 + (b) * 2 + (h)) * HTB)
#define PG8_STAGE(bufoff, gbase, voff) do { _Pragma("unroll") for (int _i = 0; _i < 2; ++_i) \
        __builtin_amdgcn_global_load_lds((const unsigned*)((const char*)(gbase) + (voff)[_i]), (LAS unsigned*)(lds + (bufoff) + ldsw + _i * 8192), 16, 0, 0); } while (0)
#define PG8_STG(bufoff, kp, vv) do { _Pragma("unroll") for (int _i = 0; _i < 2; ++_i) \
        __builtin_amdgcn_global_load_lds((const unsigned*)((const char*)(kp) + (vv)[_i]), (LAS unsigned*)(lds + (bufoff) + ldsw + _i * 8192), 16, 0, 0); } while (0)
#define PG8_STA_CUR(bufoff, kp, h) do { if (GATHER) PG8_STG(bufoff, kp, gA[h]); else PG8_STAGE(bufoff, (kp) + (h) * hstep, voffA); } while (0)
#define PG8_STA_NX(bufoff, kp, h) do { if (GATHER) { unsigned _v[2] = {last ? nG[h][0] : gA[h][0], last ? nG[h][1] : gA[h][1]}; PG8_STG(bufoff, kp, _v); } else PG8_STAGE(bufoff, (kp) + (h) * hstep, voffA); } while (0)
#define PG8_LDA(dst, b, h) do { _Pragma("unroll") for (int m = 0; m < 4; ++m) { const v4i _l = *(const LAS v4i*)(lds + PG8_SA(b, h) + aoff + m * 2048), _h = *(const LAS v4i*)(lds + PG8_SA(b, h) + aoff + m * 2048 + 1024); \
        dst[m] = __builtin_shufflevector(_l, _h, 0, 1, 2, 3, 4, 5, 6, 7); } } while (0)
#define PG8_LDB(dst, b, h) do { _Pragma("unroll") for (int n = 0; n < 2; ++n) { const v4i _l = *(const LAS v4i*)(lds + PG8_SB(b, h) + boff + n * 2048), _h = *(const LAS v4i*)(lds + PG8_SB(b, h) + boff + n * 2048 + 1024); \
        dst[n] = __builtin_shufflevector(_l, _h, 0, 1, 2, 3, 4, 5, 6, 7); } } while (0)
#define PG8_H(v, k) __builtin_bit_cast(bf16x8, __builtin_shufflevector(v, v, 4 * (k), 4 * (k) + 1, 4 * (k) + 2, 4 * (k) + 3))
#define PG8_H4(v, k) __builtin_shufflevector(v, v, 4 * (k), 4 * (k) + 1, 4 * (k) + 2, 4 * (k) + 3)
#define PG8_MMA(ai, bj, At, Bt) do { __builtin_amdgcn_s_setprio(1); _Pragma("unroll") for (int m = 0; m < 4; ++m) _Pragma("unroll") for (int n = 0; n < 2; ++n) { \
        if (FP8) asm volatile("v_mfma_f32_16x16x128_f8f6f4 %0, %1, %2, %0" : "+v"(acc[ai][bj][m][n]) : "v"(Bt[n]), "v"(At[m])); \
        else if (I8) { v4i c_ = __builtin_bit_cast(v4i, acc[ai][bj][m][n]); \
               c_ = __builtin_amdgcn_mfma_i32_16x16x64_i8(PG8_H4(Bt[n], 0), PG8_H4(At[m], 0), c_, 0, 0, 0); c_ = __builtin_amdgcn_mfma_i32_16x16x64_i8(PG8_H4(Bt[n], 1), PG8_H4(At[m], 1), c_, 0, 0, 0); \
               acc[ai][bj][m][n] = __builtin_bit_cast(f32x4, c_); } \
        else { acc[ai][bj][m][n] = __builtin_amdgcn_mfma_f32_16x16x32_bf16(PG8_H(Bt[n], 0), PG8_H(At[m], 0), acc[ai][bj][m][n], 0, 0, 0); \
               acc[ai][bj][m][n] = __builtin_amdgcn_mfma_f32_16x16x32_bf16(PG8_H(Bt[n], 1), PG8_H(At[m], 1), acc[ai][bj][m][n], 0, 0, 0); } } \
        __builtin_amdgcn_s_setprio(0); } while (0)
#define PG8_WAIT_V(n) asm volatile("s_waitcnt vmcnt(" #n ")" ::: "memory")
#define PG8_WAIT_L(n) asm volatile("s_waitcnt lgkmcnt(" #n ")" ::: "memory")
#define PG8_BAR __builtin_amdgcn_s_barrier()
#define PG8_SCHED __builtin_amdgcn_sched_barrier(0)
    Unit cur, nxt; int ui = 0;
    if (!S.next(0, cur)) return;
    f32x4 acc[2][2][4][2];
#pragma unroll
    for (int a = 0; a < 2; ++a)
#pragma unroll
        for (int b = 0; b < 2; ++b)
#pragma unroll
            for (int m = 0; m < 4; ++m)
#pragma unroll
                for (int n = 0; n < 2; ++n) acc[a][b][m][n] = (f32x4){0.f, 0.f, 0.f, 0.f};
    v8i At[4], B0[2], B1[2];
    unsigned gA[2][2], nG[2][2]; int gR[2], gC[2];
#pragma unroll
    for (int i = 0; i < 2; ++i) { stage_rc(tid * 16 + i * 8192, gR[i], gC[i]); gC[i] *= 2; }
    LAS int* gidx = (LAS int*)(lds + 131072 + 2048);
#pragma unroll
    for (int h = 0; h < 2; ++h)
#pragma unroll
        for (int i = 0; i < 2; ++i) { gA[h][i] = GATHER ? (unsigned)(g.idx[cur.pm * 256 + h * 128 + gR[i]] * KB + gC[i]) : 0u; nG[h][i] = 0u; }
    const char* cA = (const char*)g.A + (GATHER ? (size_t)0 : (size_t)cur.pm * tstep) + (size_t)cur.kt0 * kstep; const char* cB = (const char*)g.Bt + cur.boff + (size_t)cur.pn * tstep + (size_t)cur.kt0 * kstep;
    if (GEMM_SP2) {
        PG8_STAGE(PG8_SB(0, 0), cB, voffB); PG8_STAGE(PG8_SB(0, 1), cB + hstep, voffB); PG8_STA_CUR(PG8_SA(0, 0), cA, 0); PG8_STA_CUR(PG8_SA(0, 1), cA, 1);
        if (wr == 1) PG8_BAR;
        PG8_WAIT_V(2); PG8_BAR;
        PG8_STAGE(PG8_SB(1, 0), cB + kstep, voffB); PG8_STA_CUR(PG8_SA(1, 0), cA + kstep, 0); PG8_STAGE(PG8_SB(1, 1), cB + hstep + kstep, voffB);
        PG8_WAIT_V(6); PG8_BAR;
    } else {
    PG8_STAGE(PG8_SB(0, 0), cB, voffB); PG8_STAGE(PG8_SA(0, 0), cA, voffA); PG8_STAGE(PG8_SB(0, 1), cB + hstep, voffB); PG8_STAGE(PG8_SA(0, 1), cA + hstep, voffA);
    if (wr == 1) PG8_BAR;
    PG8_WAIT_V(4); PG8_BAR;
    PG8_STAGE(PG8_SB(1, 0), cB + kstep, voffB); PG8_STAGE(PG8_SA(1, 0), cA + kstep, voffA); PG8_STAGE(PG8_SB(1, 1), cB + hstep + kstep, voffB);
    PG8_WAIT_V(6); PG8_BAR;
    }
    for (;;) {
        const bool has_next = S.next(ui + 1, nxt);
        const char* nA = has_next ? (const char*)g.A + (GATHER ? (size_t)0 : (size_t)nxt.pm * tstep) + (size_t)nxt.kt0 * kstep : cA;
        if (GATHER && has_next) __builtin_amdgcn_global_load_lds((const unsigned*)(g.idx + nxt.pm * 256 + (wid & 3) * 64 + lane), (LAS unsigned*)(gidx + (wid & 3) * 64), 4, 0, 0); const char* nB = has_next ? (const char*)g.Bt + nxt.boff + (size_t)nxt.pn * tstep + (size_t)nxt.kt0 * kstep : cB;
        const int nt = cur.nt;
        for (int t = 0; t < nt; t += 2) {
            const bool last = (t == nt - 2);
            if (GATHER && last && has_next) {
#pragma unroll
                for (int h = 0; h < 2; ++h)
#pragma unroll
                    for (int i = 0; i < 2; ++i) nG[h][i] = (unsigned)(gidx[h * 128 + gR[i]] * KB + gC[i]); }
            const char* a1 = cA + (size_t)(t + 1) * kstep;
            const char* a2 = last ? nA : cA + (size_t)(t + 2) * kstep; const char* b2 = last ? nB : cB + (size_t)(t + 2) * kstep;
            const char* a3 = a2 + kstep; const char* b3 = b2 + kstep;
            if (GEMM_SP2) {
            PG8_LDB(B0, 0, 0); PG8_LDB(B1, 0, 1); PG8_SCHED; PG8_LDA(At, 0, 0); PG8_STA_CUR(PG8_SA(1, 1), a1, 1);
            PG8_WAIT_V(8); PG8_WAIT_L(0); PG8_BAR; PG8_MMA(0, 0, At, B0); PG8_MMA(0, 1, At, B1); PG8_BAR; PG8_SCHED;
            PG8_LDA(At, 0, 1); PG8_STAGE(PG8_SB(0, 0), b2, voffB); PG8_STAGE(PG8_SB(0, 1), b2 + hstep, voffB); PG8_STA_NX(PG8_SA(0, 0), a2, 0);
            PG8_WAIT_V(8); PG8_WAIT_L(0); PG8_BAR; PG8_MMA(1, 0, At, B0); PG8_MMA(1, 1, At, B1); PG8_BAR; PG8_SCHED;
            PG8_LDB(B0, 1, 0); PG8_LDB(B1, 1, 1); PG8_SCHED; PG8_LDA(At, 1, 0); PG8_STA_NX(PG8_SA(0, 1), a2, 1);
            PG8_WAIT_V(8); PG8_WAIT_L(0); PG8_BAR; PG8_MMA(0, 0, At, B0); PG8_MMA(0, 1, At, B1); PG8_BAR; PG8_SCHED;
            PG8_LDA(At, 1, 1); PG8_STAGE(PG8_SB(1, 0), b3, voffB); PG8_STAGE(PG8_SB(1, 1), b3 + hstep, voffB); PG8_STA_NX(PG8_SA(1, 0), a3, 0);
            PG8_WAIT_V(8); PG8_WAIT_L(0); PG8_BAR; PG8_MMA(1, 0, At, B0); PG8_MMA(1, 1, At, B1); PG8_BAR; PG8_SCHED;
            } else {
            PG8_LDB(B0, 0, 0); PG8_SCHED; PG8_LDA(At, 0, 0); PG8_STAGE(PG8_SA(1, 1), a1 + hstep, voffA);
            PG8_WAIT_L(8); PG8_BAR; PG8_WAIT_L(0); PG8_MMA(0, 0, At, B0); PG8_BAR; PG8_SCHED;
            PG8_LDB(B1, 0, 1); PG8_STAGE(PG8_SB(0, 0), b2, voffB);
            PG8_BAR; PG8_WAIT_L(0); PG8_MMA(0, 1, At, B1); PG8_BAR;
            PG8_LDA(At, 0, 1); PG8_STAGE(PG8_SA(0, 0), a2, voffA);
            PG8_BAR; PG8_WAIT_L(0); PG8_MMA(1, 0, At, B0); PG8_BAR; PG8_SCHED;
            PG8_STAGE(PG8_SB(0, 1), b2 + hstep, voffB);
            PG8_WAIT_V(6); PG8_BAR; PG8_MMA(1, 1, At, B1); PG8_BAR;
            PG8_LDB(B0, 1, 0); PG8_SCHED; PG8_LDA(At, 1, 0); PG8_STAGE(PG8_SA(0, 1), a2 + hstep, voffA);
            PG8_WAIT_L(8); PG8_BAR; PG8_WAIT_L(0); PG8_MMA(0, 0, At, B0); PG8_BAR; PG8_SCHED;
            PG8_LDB(B1, 1, 1); PG8_STAGE(PG8_SB(1, 0), b3, voffB);
            PG8_BAR; PG8_WAIT_L(0); PG8_MMA(0, 1, At, B1); PG8_BAR;
            PG8_LDA(At, 1, 1); PG8_STAGE(PG8_SA(1, 0), a3, voffA);
            PG8_BAR; PG8_WAIT_L(0); PG8_MMA(1, 0, At, B0); PG8_BAR; PG8_SCHED;
            PG8_STAGE(PG8_SB(1, 1), b3 + hstep, voffB);
            PG8_WAIT_V(6); PG8_BAR; PG8_MMA(1, 1, At, B1); PG8_BAR;
            }
        }
        if (GEMM_ALIGN) { if (wr == 0) PG8_BAR; }
        if (FP8) asm volatile("s_nop 15\n\ts_nop 15" ::: "memory");
        if (I8) {
#pragma unroll
            for (int a = 0; a < 2; ++a)
#pragma unroll
                for (int b = 0; b < 2; ++b)
#pragma unroll
                    for (int m = 0; m < 4; ++m)
#pragma unroll
                        for (int n = 0; n < 2; ++n) acc[a][b][m][n] = __builtin_convertvector(__builtin_bit_cast(v4i, acc[a][b][m][n]), f32x4); }
        E(acc, cur, wr, wc, fr, fq);
        if (!has_next) break;
#pragma unroll
        for (int a = 0; a < 2; ++a)
#pragma unroll
            for (int b = 0; b < 2; ++b)
#pragma unroll
                for (int m = 0; m < 4; ++m)
#pragma unroll
                    for (int n = 0; n < 2; ++n) acc[a][b][m][n] = (f32x4){0.f, 0.f, 0.f, 0.f};
        cur = nxt; cA = nA; cB = nB; ++ui;
        if (GATHER) {
#pragma unroll
            for (int h = 0; h < 2; ++h)
#pragma unroll
                for (int i = 0; i < 2; ++i) gA[h][i] = nG[h][i]; }
        if (GEMM_ALIGN) { if (wr == 1) PG8_BAR; }
    }
    PG8_WAIT_V(0);
    if (!GEMM_ALIGN) { if (wr == 0) PG8_BAR; }
    PG8_BAR;
#undef PG8_SA
#undef PG8_SB
#undef PG8_STAGE
#undef PG8_STG
#undef PG8_STA_CUR
#undef PG8_STA_NX
#undef PG8_LDA
#undef PG8_LDB
#undef PG8_MMA
#undef PG8_H
#undef PG8_H4
#undef PG8_WAIT_V
#undef PG8_WAIT_L
#undef PG8_BAR
#undef PG8_SCHED
}
}

template <int L> __device__ __forceinline__ void phase_attn(ArgsP a, LAS unsigned char* lds, int gw, int ngw, int wave, int lane) {
    const bf16_t* QKV = (const bf16_t*)(a->ws + WS_QKV); bf16_t* ATT = (bf16_t*)(a->ws + WS_ATT);
    const float lambda_init = L == 0 ? 0.2f : 0.8f - 0.6f * 0.74081822068171786607f;
    {
      const float L2T = 13.287712379549449f; LAS f32x2* tg = (LAS f32x2*)(lds + 73728); LAS f32x2* td = tg + 64 * 32;
      for (int i = threadIdx.x; i < 64 * 32 + 64 * 16; i += NTHREADS) { float s_, c_;
        if (i < 64 * 32) { sincosf((float)(i >> 5) * exp2f(-(float)(i & 31) * (1.f / 32.f) * L2T), &s_, &c_); tg[i] = (f32x2){c_, s_}; }
        else { const int q_ = i - 64 * 32; sincosf((float)(q_ >> 4) * exp2f(-(float)(q_ & 15) * (1.f / 16.f) * L2T), &s_, &c_); td[q_] = (f32x2){c_, s_}; } }
      __syncthreads(); }
    {
    int nu = 0; const int gslot = (blockIdx.x >> 3) % 5;
#define CVT_GAP() do { if (nu == gslot) { __syncthreads(); convert_quads(a, (LAS float*)(wave < 7 ? lds + wave * 8448 : lds + 98304), gw, ngw, lane, CVT_Q_DENSE + L * (CVT_Q_MOE / 2), CVT_Q_MOE / 2); __syncthreads(); } ++nu; } while (0)
    constexpr int REP2 = ((PROBE_DUP >> 2) & 1) + 1, NUQ = 512 + (L == 0 ? 48 : 0);
    for (int uu = blockIdx.x; uu < NUQ * REP2; uu += gridDim.x) { const int u = REP2 == 1 ? uu : uu % NUQ; CVT_GAP();
        int seq; size_t qrow, krow; int qcol, kcol, vcol, ocol, qproc = 0, trow0 = 0;
        if (u < 512) { const int grp = u & 7, idx = u >> 3, b = grp >> 1, hq = (grp & 1) * 4 + (idx & 3), kvh = hq >> 2; seq = TPB; qrow = (size_t)b * TPB + (idx >> 2) * 256; krow = (size_t)b * TPB; qproc = 2; trow0 = (idx >> 2) * 256;
            qcol = 1536 + hq * 128; kcol = 2560 + kvh * 128; vcol = 2816 + kvh * 128; ocol = 512 + hq * 128; }
        else if (u < 544) { const int v = u - 512, b = v >> 3, hq = v & 7, kvh = hq >> 2; seq = CTX; qrow = (size_t)b * TPB + SEQ; krow = qrow; qproc = 1;
            qcol = 1536 + hq * 128; kcol = 2560 + kvh * 128; vcol = 2816 + kvh * 128; ocol = 512 + hq * 128; }
        else { const int v = u - 544, b = v >> 2, h = v & 3; seq = CTX; qrow = (size_t)b * TPB + SEQ; krow = qrow; qcol = h * 128; kcol = 512 + h * 128; vcol = 1024 + h * 128; ocol = h * 128; }
        att::attn_body<0>(QKV + qrow * INW + qcol, QKV + krow * INW + kcol, QKV + krow * INW + vcol, ATT + qrow * D + ocol, seq, lds, 0.f, 0.f, nullptr, 0, 0, qproc, a->in[I_QNORM] + L * 128, trow0);
    }
    float lam;
    { const int ln = threadIdx.x & 63; const float d1 = wave_sum(a->in[I_LQ1][L * 64 + ln] * a->in[I_LK1][L * 64 + ln]), d2 = wave_sum(a->in[I_LQ2][L * 64 + ln] * a->in[I_LK2][L * 64 + ln]); lam = __expf(d1) - __expf(d2) + lambda_init; lam = __int_as_float(__builtin_amdgcn_readfirstlane(__float_as_int(lam))); }
    constexpr int NUD = 512 + (L == 0 ? 64 : 0);
    for (int uu = blockIdx.x; uu < NUD * REP2; uu += gridDim.x) { const int u = REP2 == 1 ? uu : uu % NUD; CVT_GAP();
        int seq; size_t qrow, krow; int h, qproc = 0, trow0 = 0;
        if (u < 512) { const int idx = u >> 3, grp = (u & 7) + 8 * (idx >> 5), b = grp >> 2; h = grp & 3; seq = TPB; qrow = (size_t)b * TPB + (idx & 31) * 128; krow = (size_t)b * TPB; qproc = 2; trow0 = (idx & 31) * 128; }
        else { const int v = u - 544; if (v < 0) continue; const int b = v >> 3; h = (v >> 1) & 3; seq = CTX; krow = (size_t)b * TPB + SEQ; qrow = krow + (v & 1) * 128; }
        att::attn_body<1>(QKV + qrow * INW + 3072 + h * 128, QKV + krow * INW + 3584 + h * 128, QKV + krow * INW + 4096 + h * 128, ATT + qrow * D + 1536 + h * 128, seq, lds, lam, 1.f - lambda_init, a->in[I_SUBLN] + L * 128, 0, 0, qproc, nullptr, trow0);
    }
    constexpr int REP3 = ((PROBE_DUP >> 3) & 1) + 1;
    for (int uu = blockIdx.x; uu < 256 * REP3; uu += gridDim.x) { const int u = uu & 255; CVT_GAP();
        const int grp = u & 15, b = grp >> 2, h = grp & 3, r0 = (u >> 4) * 4, R0 = min(max(r0 - 4, 0), 52);
        const size_t qrow = (size_t)b * TPB + r0 * 64, krow = (size_t)b * TPB;
        att::attn_body<2>(QKV + qrow * INW + h * 128, QKV + krow * INW + 512 + h * 128, QKV + krow * INW + 1024 + h * 128, ATT + qrow * D + h * 128, 1024, lds, 0.f, 0.f, a->in[I_RPB] + (size_t)(L * 4 + h) * 465, r0, R0);
    }
    if (nu <= gslot) { nu = gslot; CVT_GAP(); }
#undef CVT_GAP
    }
    __syncthreads();
}

template <int L> __device__ __forceinline__ void layer_program(LAS unsigned char* lds, const XcdBarrier& bar, int lo, int hi) {
    constexpr int P = 2 + 9 * L; const int G = gridDim.x, cid = blockIdx.x;
#define PHASE_IDS const int tid = fresh_tid(), lane = tid & 63, wave = __builtin_amdgcn_readfirstlane(tid >> 6), gw = blockIdx.x * NWAVES + wave, ngw = gridDim.x * NWAVES; (void)lane; (void)gw; (void)ngw
#define IN(k) (lo <= (k) && (k) < hi)
#define SEAM(k) do { if (IN(k) && IN((k) + 1)) xcd_barrier(bar); STAMP((k) + 1); } while (0)
    if (IN(P + 0)) DUP(1) { ArgsP a = get_args(); unsigned char* ws = a->ws;
        pg8::Gemm g{ws + WS_H, (const bf16_t*)(ws + WS_WIN) + (size_t)L * INW * D, INT8_QKV ? D : 2 * D}; pg8::StaticOrder<false> S; S.init(NR / 256, INW / 256, G, cid, INT8_QKV ? D / 128 : D / 64);
        pg8::EpiBf16T<(INT8_QKV != 0)> E{(bf16_t*)(ws + WS_QKV), INW, INT8_QKV ? 1.f / (I8_SH * I8_SW) : 1.f}; pg8::gemm_phase<false, false, (INT8_QKV != 0)>(lds, g, S, E); }
    SEAM(P + 0);
    if (IN(P + 1)) { ArgsP a = get_args(); PHASE_IDS; phase_qkpost<L>(a, lds, gw, ngw, tid, lane); }
    SEAM(P + 1);
    if (IN(P + 2)) { ArgsP a = get_args(); PHASE_IDS; phase_attn<L>(a, lds, gw, ngw, wave, lane); }
    SEAM(P + 2);
    if (INT8_OUT && IN(P + 3)) { { ArgsP a = get_args(); PHASE_IDS; phase_attq<L>(a, gw, ngw, lane); } if (hi - lo > 1) xcd_barrier(bar); }
    if (INT8_OUT && IN(P + 3)) { ArgsP a = get_args(); unsigned char* ws = a->ws;
        pg8::Gemm g{ws + WS_ATT8, (const bf16_t*)(ws + WS_WOUT) + (size_t)L * D * D, D}; pg8::EpiOutI8 E{(bf16_t*)(ws + WS_O), (bf16_t*)(ws + WS_PART_A), (const float*)(ws + WS_RS)};
        if (L == 0) { pg8::SplitCtxOrder S; S.init(G, cid, D / 128); pg8::gemm_phase<false, false, true>(lds, g, S, E); }
        else { pg8::StaticOrder<true> S; S.init(NTOK / 256, D / 256, G, cid, D / 128); pg8::gemm_phase<false, false, true>(lds, g, S, E); } }
    if (!INT8_OUT && IN(P + 3)) DUP(4) { ArgsP a = get_args(); unsigned char* ws = a->ws;
        pg8::Gemm g{ws + WS_ATT, (const bf16_t*)(ws + WS_WOUT) + (size_t)L * D * D, 2 * D};
        if (L == 0) { pg8::EpiBf16OrPart E{(bf16_t*)(ws + WS_O), D, (bf16_t*)(ws + WS_PART_A)}; pg8::SplitCtxOrder S; S.init(G, cid, D / 64); pg8::gemm_phase<false>(lds, g, S, E); }
        else { pg8::EpiBf16 E{(bf16_t*)(ws + WS_O), D, 1.f}; pg8::StaticOrder<true> S; S.init(NTOK / 256, D / 256, G, cid, D / 64); pg8::gemm_phase<false>(lds, g, S, E); } }
    SEAM(P + 3);
    if (IN(P + 4)) { ArgsP a = get_args(); PHASE_IDS; phase_row_mid<L>(a, lds, gw, ngw, tid, lane); }
    SEAM(P + 4);
    if (IN(P + 5)) { if (L == 1) { ArgsP a = get_args(); PHASE_IDS; phase_moe_slots(a, lds, gw, ngw, tid, lane); } }
    if (L == 1) SEAM(P + 5); else STAMP(P + 6);
    if (IN(P + 6)) DUP(5) { ArgsP a = get_args(); unsigned char* ws = a->ws;
        if (L == 0 && FP8_UP0 && FP8_DOWN0) { pg8::EpiSwigluF8 E{ws + WS_ACT, DFF}; pg8::Gemm g{ws + WS_H8, ws + WS_W13, D}; pg8::StaticOrder<false> S; S.init(NR / 256, 2 * DFF / 256, G, cid, D / 128); pg8::gemm_phase<!INT8_UP, false, INT8_UP>(lds, g, S, E); }
        else if (L == 0 && FP8_UP0) { pg8::EpiSwigluT<true> E{(bf16_t*)(ws + WS_ACT), DFF}; pg8::Gemm g{ws + WS_H8, ws + WS_W13, D}; pg8::StaticOrder<false> S; S.init(NR / 256, 2 * DFF / 256, G, cid, D / 128); pg8::gemm_phase<!INT8_UP, false, INT8_UP>(lds, g, S, E); }
        else if (L == 0) { pg8::EpiSwiglu E{(bf16_t*)(ws + WS_ACT), DFF}; pg8::Gemm g{ws + WS_H, ws + WS_W13, 2 * D}; pg8::StaticOrder<false> S; S.init(NR / 256, 2 * DFF / 256, G, cid, D / 64); pg8::gemm_phase<false>(lds, g, S, E); }
        else { LAS int* toff = moe_offsets(a, lds, fresh_tid()); pg8::EpiSwigluF8 E{ws + WS_ACT, DFF}; pg8::Gemm g{ws + WS_H8, ws + WS_MW13, D, (const int*)(ws + WS_IDX)}; pg8::MoeOrder S; S.init(toff, 2 * DFF / 256, G, cid, (size_t)2 * DFF * D, D / 128); pg8::gemm_phase<!INT8_UP, true, INT8_UP>(lds, g, S, E); }
    }
    SEAM(P + 6);
    if (IN(P + 7)) DUP(6) { ArgsP a = get_args(); unsigned char* ws = a->ws;
        if (L == 0 && FP8_UP0 && FP8_DOWN0) { pg8::EpiBf16OrPartS E{(bf16_t*)(ws + WS_Y), D, (bf16_t*)(ws + WS_PART_B), 1.f / (F8_SA * F8_SW)}; pg8::Gemm g{ws + WS_ACT, ws + WS_W2, DFF}; pg8::SplitCtxOrder S; S.init(G, cid, DFF / 128); pg8::gemm_phase<true>(lds, g, S, E); }
        else if (L == 0) { pg8::EpiBf16OrPart E{(bf16_t*)(ws + WS_Y), D, (bf16_t*)(ws + WS_PART_B)}; pg8::Gemm g{ws + WS_ACT, ws + WS_W2, 2 * DFF}; pg8::SplitCtxOrder S; S.init(G, cid, DFF / 64); pg8::gemm_phase<false>(lds, g, S, E); }
        else { LAS int* toff = moe_offsets(a, lds, fresh_tid()); pg8::EpiMoeDown E{(bf16_t*)(ws + WS_Y), (bf16_t*)(ws + WS_PART_M), 1.f / (F8_SA * F8_SW)}; pg8::Gemm g{ws + WS_ACT, ws + WS_MW2, DFF}; pg8::MoeOrderT<true> S; S.init(toff, D / 256, G, cid, (size_t)D * DFF, DFF / 128); pg8::gemm_phase<true>(lds, g, S, E); }
    }
    SEAM(P + 7);
    if (IN(P + 8)) { ArgsP a = get_args(); PHASE_IDS; phase_row_end<L>(a, gw, ngw, lane); }
    if (L == 0) SEAM(P + 8);
#undef IN
#undef SEAM
}
constexpr int NPHASE = 20;


__global__ void __launch_bounds__(NTHREADS, 2) fwd_kernel(Args kargs_unused) {
    extern __shared__ __attribute__((aligned(16))) unsigned char lds_raw[];
    LAS unsigned char* lds = (LAS unsigned char*)lds_raw;
    volatile LAS unsigned* xbw = (volatile LAS unsigned*)(lds + LDS_BYTES - 16);
    { const int t0 = fresh_tid(); if (t0 < 4) xbw[t0] = 0u; }
    __syncthreads();
    STAMP(0); const unsigned long long probe_c0 = PROBE_STAMP == 100 ? (unsigned long long)clock64() : 0ull;
    int lo, hi; XcdBarrier bar;
    { ArgsP a = get_args(); lo = a->lo; hi = a->hi; bar.bar = (unsigned*)(a->ws + WS_CTL) + CW_BAR; bar.x = 0; bar.st = xbw;
      if (hi - lo > 1) bar = xcd_barrier_post((unsigned*)(a->ws + WS_CTL) + CW_BAR, xbw); }
#define IN(k) (lo <= (k) && (k) < hi)
    { const int tid = fresh_tid(), lane = tid & 63, wave = __builtin_amdgcn_readfirstlane(tid >> 6), gw = blockIdx.x * NWAVES + wave, ngw = gridDim.x * NWAVES;
      if (IN(0)) DUP(0) { ArgsP a = get_args(); phase_adaln(a, lds, tid, wave, lane); phase_convert(a, lds, gw, ngw, wave, lane); __syncthreads(); }
      if (IN(0) && IN(1)) xcd_barrier(bar);
      STAMP(1);
      if (IN(1)) { ArgsP a = get_args(); phase_row_entry(a, gw, ngw, lane); }
      if (IN(1) && IN(2)) xcd_barrier(bar);
      STAMP(2); }
#undef IN
    layer_program<0>(lds, bar, lo, hi);
    layer_program<1>(lds, bar, lo, hi);
    if (PROBE_STAMP >= 0 && blockIdx.x == 0 && threadIdx.x == 0) {
        STAMP(NPHASE);
        volatile LAS unsigned long long* st = (volatile LAS unsigned long long*)(lds + 131072 + 1024);
        const unsigned long long d = PROBE_STAMP == 100 ? ((unsigned long long)clock64() - probe_c0) / 20ull : (PROBE_STAMP >= 200 ? (st[32 + PROBE_STAMP - 200 + 1] - st[32 + PROBE_STAMP - 200]) / 20ull : st[PROBE_STAMP + 1] - st[PROBE_STAMP]);
        const unsigned long long t0 = (unsigned long long)wall_clock64();
        while ((unsigned long long)wall_clock64() - t0 < d) __builtin_amdgcn_s_sleep(10);
    }
}

#ifndef MK_PER_PHASE
#define MK_PER_PHASE 0
#endif
extern "C" void kernel_launch(void* const* d_in, const int* in_sizes, int n_in, void* d_out, int out_size, void* d_ws, size_t ws_size, hipStream_t stream) {
    static int grid = 0;
    if (grid == 0) {
        if (n_in != 27 || out_size != NB * SEQ * D || ws_size < WS_H8 + (size_t)NR * D) { fprintf(stderr, "kernel_launch: unexpected shapes: n_in %d out %d ws %zu (need %zu)\n", n_in, out_size, ws_size, (size_t)WS_END); grid = -1; return; }
        int dev = 0, cus = 0, per_cu = 0;
        if (hipGetDevice(&dev) != hipSuccess || hipDeviceGetAttribute(&cus, hipDeviceAttributeMultiprocessorCount, dev) != hipSuccess) { grid = -1; return; }
        if (hipFuncSetAttribute((const void*)fwd_kernel, hipFuncAttributeMaxDynamicSharedMemorySize, LDS_BYTES) != hipSuccess) { fprintf(stderr, "kernel_launch: hipFuncSetAttribute failed\n"); grid = -1; return; }
        if (hipOccupancyMaxActiveBlocksPerMultiprocessor(&per_cu, (const void*)fwd_kernel, NTHREADS, LDS_BYTES) != hipSuccess || per_cu < 1) fprintf(stderr, "kernel_launch: occupancy query says %d\n", per_cu);
        (void)hipGetLastError();
        grid = cus;
    }
    if (grid < 0) return;
    (void)hipMemsetAsync((char*)d_ws + WS_CTL, 0, CTL_ZERO_BYTES, stream);
    Args a{};
    for (int i = 0; i < 27; ++i) a.in[i] = (const float*)d_in[i];
    a.out = (float*)d_out; a.ws = (unsigned char*)d_ws;
#if MK_PER_PHASE
    for (int p = 0; p < NPHASE; ++p) { if (p == 7) continue; a.lo = p; a.hi = p + 1; hipLaunchKernelGGL(fwd_kernel, dim3(grid), dim3(NTHREADS), LDS_BYTES, stream, a); }
#else
    a.lo = 0; a.hi = NPHASE; hipLaunchKernelGGL(fwd_kernel, dim3(grid), dim3(NTHREADS), LDS_BYTES, stream, a);
#endif
}
```
